# Optimizing an MI355X kernel written in HIP

```python
import math
import jax, jax.numpy as jnp
from jax import lax
import numpy as np

D_MODEL = 1024
BATCH = 8
SEQ = 2048
DEPTH = 1
DEC_BATCH = 128
DEC_SEQ = 4
PAST_LEN = 2048
PAGE_SIZE = 128

RWKV_HEAD = 64
D_RWKV = D_MODEL
RWKV_HEADS = D_RWKV // RWKV_HEAD
R_DECAY = 64
R_ICL = 64
LNX_EPS = 64e-5
ATT_HEAD = 64
D_ATT = D_MODEL
ATT_HEADS = D_ATT // ATT_HEAD
ATT_KV_HEADS = 2
ATT_GROUP = ATT_HEADS // ATT_KV_HEADS
IDX_HEADS = 8
IDX_DIM = 64
TOPK_MAX = 256
QBLOCK = 128
REL_BUCKETS = 32
REL_MAX_DIST = 128
NORM_EPS = 1e-6
POOL_FACTOR = 1.25

RWKV_SIZES = (D_RWKV, D_RWKV, D_RWKV, D_RWKV, R_DECAY, R_ICL)
RWKV_COLS = sum(RWKV_SIZES)
ATT_SIZES = (D_ATT, ATT_KV_HEADS * ATT_HEAD, ATT_KV_HEADS * ATT_HEAD,
             IDX_HEADS * IDX_DIM, IDX_DIM, IDX_HEADS, D_ATT)
ATT_COLS = sum(ATT_SIZES)
GATE_SIZES = (D_MODEL, D_MODEL)
N_COLS = RWKV_COLS + ATT_COLS + sum(GATE_SIZES)

kernel_name = 'rwkv7_dsa_gated_hybrid_step'


def _split(z, sizes):
    idx = np.cumsum(sizes)[:-1].tolist()
    return jnp.split(z, idx, axis=-1)


def _rmsnorm(x, g, eps):
    xf = x.astype(jnp.float32)
    y = xf * lax.rsqrt(jnp.mean(xf * xf, axis=-1, keepdims=True) + eps)
    return (y * g.astype(jnp.float32)).astype(x.dtype)


def _t5_bucket(dist):
    max_exact = REL_BUCKETS // 2
    d = jnp.maximum(dist, 0)
    df = jnp.maximum(d, 1).astype(jnp.float32)
    large = max_exact + (jnp.log(df / max_exact) / math.log(REL_MAX_DIST / max_exact)
                         * (REL_BUCKETS - max_exact)).astype(jnp.int32)
    large = jnp.minimum(large, REL_BUCKETS - 1)
    return jnp.where(d < max_exact, d, large)


def _wkv7_scan(r, w, k, v, kk, a, s0):
    def step(s, inp):
        r_t, w_t, k_t, v_t, kk_t, a_t = inp
        sa = jnp.einsum('bhij,bhj->bhi', s, -kk_t)
        s = (s * w_t[:, :, None, :] + sa[..., None] * (kk_t * a_t)[:, :, None, :]
             + v_t[..., None] * k_t[:, :, None, :])
        return s, jnp.einsum('bhij,bhj->bhi', s, r_t)
    xs = tuple(jnp.swapaxes(t, 0, 1) for t in (r, w, k, v, kk, a))
    s_T, out = lax.scan(step, s0, xs)
    return jnp.swapaxes(out, 0, 1), s_T


def _rwkv_branch(zr, shift_prev, s0, mu, w0, w2, a0, a2, k_k, k_a, r_k, lnx_g, lnx_b):
    B, T, _ = zr.shape
    f32 = jnp.float32
    prev = jnp.concatenate([shift_prev[:, None, :].astype(zr.dtype), zr[:, :-1]], axis=1)
    zs = zr + (prev - zr) * mu
    r, k, v, g, wd, ad = _split(zs, RWKV_SIZES)
    heads = lambda t: t.astype(f32).reshape(B, T, RWKV_HEADS, RWKV_HEAD)
    w_log = -jax.nn.softplus(-(w0 + jnp.tanh(wd) @ w2).astype(f32)) - 0.5
    decay = jnp.exp(-jnp.exp(w_log))
    a = jax.nn.sigmoid((a0 + ad @ a2).astype(f32))
    kk = heads(k * k_k)
    kk = kk / jnp.maximum(jnp.sqrt(jnp.sum(kk * kk, axis=-1, keepdims=True)), 1e-12)
    k_mod = heads(k.astype(f32) * (1.0 + (a - 1.0) * k_a.astype(f32)))
    r_h, v_h, a_h = heads(r), heads(v), heads(a)
    out, s_T = _wkv7_scan(r_h, heads(decay), k_mod, v_h, kk, a_h, s0.astype(f32))
    mean = jnp.mean(out, axis=-1, keepdims=True)
    var = jnp.mean(jnp.square(out - mean), axis=-1, keepdims=True)
    o = ((out - mean) * lax.rsqrt(var + LNX_EPS)).reshape(B, T, D_RWKV)
    o = o * lnx_g.astype(f32) + lnx_b.astype(f32)
    bonus = jnp.sum(r_h * k_mod * r_k.astype(f32), axis=-1, keepdims=True) * v_h
    o = (o + bonus.reshape(B, T, D_RWKV)) * jax.nn.silu(g.astype(f32))
    return o.astype(zr.dtype), s_T.astype(s0.dtype), zr[:, -1]


def _sparse_attend_block(q, qi, wi, qpos, k, v, ki, topk, rel_bias):
    B, Tq = q.shape[:2]
    L = k.shape[1]
    f32 = jnp.float32
    idx_logits = jnp.einsum('bthd,bsd->bths', qi.astype(f32), ki.astype(f32))
    score = jnp.einsum('bths,bth->bts', jax.nn.relu(idx_logits), wi.astype(f32))
    kpos = jnp.arange(L, dtype=jnp.int32)
    visible = kpos[None, :] <= qpos[:, None]
    score = jnp.where(visible[None], score, -jnp.inf)
    _, sel = lax.top_k(score, topk)
    gather = jax.vmap(lambda rows, ids: rows[ids])
    k_sel = gather(k, sel)
    v_sel = gather(v, sel)
    qg = q.reshape(B, Tq, ATT_KV_HEADS, ATT_GROUP, ATT_HEAD)
    logits = jnp.einsum('btkgd,btskd->btkgs', qg.astype(f32), k_sel.astype(f32)) * (ATT_HEAD ** -0.5)
    dist = qpos[None, :, None] - sel
    bias = rel_bias.astype(f32)[_t5_bucket(dist)]
    bias = bias.reshape(B, Tq, topk, ATT_KV_HEADS, ATT_GROUP).transpose(0, 1, 3, 4, 2)
    valid = (dist >= 0)[:, :, None, None, :]
    logits = jnp.where(valid, logits + bias, -jnp.inf)
    p = jax.nn.softmax(logits, axis=-1)
    o = jnp.einsum('btkgs,btskd->btkgd', p, v_sel.astype(f32))
    return o.reshape(B, Tq, D_ATT).astype(q.dtype)


def _attn_branch(za, k_past, v_past, ki_past, pos0, topk, qn_g, kn_g, rel_bias):
    B, T, _ = za.shape
    q, kn, vn, qi, kin, wi, g = _split(za, ATT_SIZES)
    q = _rmsnorm(q.reshape(B, T, ATT_HEADS, ATT_HEAD), qn_g, NORM_EPS)
    kn = _rmsnorm(kn.reshape(B, T, ATT_KV_HEADS, ATT_HEAD), kn_g, NORM_EPS)
    vn = vn.reshape(B, T, ATT_KV_HEADS, ATT_HEAD)
    qi = qi.reshape(B, T, IDX_HEADS, IDX_DIM) * (IDX_DIM ** -0.5)
    wi = wi * (IDX_HEADS ** -0.5)
    if k_past is None:
        k_all, v_all, ki_all = kn, vn, kin
    else:
        k_all = jnp.concatenate([k_past.astype(kn.dtype), kn], axis=1)
        v_all = jnp.concatenate([v_past.astype(vn.dtype), vn], axis=1)
        ki_all = jnp.concatenate([ki_past.astype(kin.dtype), kin], axis=1)
    blk = min(QBLOCK, T)
    nblk = T // blk
    qpos = pos0 + jnp.arange(T, dtype=jnp.int32)

    def to_blocks(t):
        return jnp.moveaxis(t.reshape(B, nblk, blk, *t.shape[2:]), 1, 0)

    def body(args):
        qb, qib, wib, pb = args
        return _sparse_attend_block(qb, qib, wib, pb, k_all, v_all, ki_all, topk, rel_bias)

    ob = lax.map(body, (to_blocks(q), to_blocks(qi), to_blocks(wi), qpos.reshape(nblk, blk)))
    o = jnp.moveaxis(ob, 0, 1).reshape(B, T, D_ATT)
    return o * jax.nn.silu(g), kn, vn, kin


def _layer(x, shift_prev, s0, k_past, v_past, ki_past, pos0, topk,
           norm_g, w_in, mu, w0, w2, a0, a2, k_k, k_a, r_k, lnx_g, lnx_b,
           qn_g, kn_g, rel_bias, w_pa, w_pb, w_out):
    xn = _rmsnorm(x, norm_g, NORM_EPS)
    z = xn @ w_in
    zr, za, zg = _split(z, (RWKV_COLS, ATT_COLS, sum(GATE_SIZES)))
    oa, s_T, last = _rwkv_branch(zr, shift_prev, s0, mu, w0, w2, a0, a2, k_k, k_a, r_k, lnx_g, lnx_b)
    ob, kn, vn, kin = _attn_branch(za, k_past, v_past, ki_past, pos0, topk, qn_g, kn_g, rel_bias)
    ga, gb = _split(zg, GATE_SIZES)
    merged = jax.nn.sigmoid(ga) * (oa @ w_pa) + jax.nn.sigmoid(gb) * (ob @ w_pb)
    return x + merged @ w_out, (kn, vn, kin, s_T, last)


def setup_inputs(seed: int = 0) -> dict:
    key = jax.random.key(seed)
    ks = jax.random.split(key, 32)
    f32 = jnp.float32
    n_pages = PAST_LEN // PAGE_SIZE
    n_phys = int(math.ceil(POOL_FACTOR * DEC_BATCH * n_pages))
    nrm = lambda k, shape, s: jax.random.normal(k, shape, f32) * s
    x_prompt = nrm(ks[0], (BATCH, SEQ, D_MODEL), 1.0)
    x_sample = nrm(ks[1], (DEC_BATCH, DEC_SEQ, D_MODEL), 1.0)
    cache_k = nrm(ks[2], (DEPTH, n_phys, PAGE_SIZE, ATT_KV_HEADS, ATT_HEAD), 1.0)
    cache_v = nrm(ks[3], (DEPTH, n_phys, PAGE_SIZE, ATT_KV_HEADS, ATT_HEAD), 1.0)
    cache_kidx = nrm(ks[4], (DEPTH, n_phys, PAGE_SIZE, IDX_DIM), 1.0)
    state_wkv = nrm(ks[5], (DEPTH, DEC_BATCH, RWKV_HEADS, RWKV_HEAD, RWKV_HEAD), 0.3)
    state_shift = nrm(ks[6], (DEPTH, DEC_BATCH, RWKV_COLS), 1.0)
    page_table = jax.random.permutation(ks[7], n_phys)[:DEC_BATCH * n_pages]
    page_table = page_table.reshape(DEC_BATCH, n_pages).astype(jnp.int32)
    norm_g = 1.0 + nrm(ks[8], (DEPTH, D_MODEL), 0.02)
    w_in = nrm(ks[9], (DEPTH, D_MODEL, N_COLS), D_MODEL ** -0.5)
    shift_mu = jax.random.uniform(ks[10], (DEPTH, RWKV_COLS), f32, 0.1, 0.9)
    w0 = jax.random.uniform(ks[11], (DEPTH, D_RWKV), f32, -5.0, 1.0)
    w2 = nrm(ks[12], (DEPTH, R_DECAY, D_RWKV), 0.1 * R_DECAY ** -0.5)
    a0 = nrm(ks[13], (DEPTH, D_RWKV), 0.1)
    a2 = nrm(ks[14], (DEPTH, R_ICL, D_RWKV), 0.5 * R_ICL ** -0.5)
    k_k = 0.85 + nrm(ks[15], (DEPTH, D_RWKV), 0.02)
    k_a = 1.0 + nrm(ks[16], (DEPTH, D_RWKV), 0.02)
    r_k = nrm(ks[17], (DEPTH, RWKV_HEADS, RWKV_HEAD), 0.1)
    lnx_g = 1.0 + nrm(ks[18], (DEPTH, D_RWKV), 0.02)
    lnx_b = nrm(ks[19], (DEPTH, D_RWKV), 0.02)
    q_norm_g = 1.0 + nrm(ks[20], (DEPTH, ATT_HEAD), 0.02)
    k_norm_g = 1.0 + nrm(ks[21], (DEPTH, ATT_HEAD), 0.02)
    rel_bias = nrm(ks[22], (REL_BUCKETS, ATT_HEADS), 0.5)
    w_pa = nrm(ks[23], (DEPTH, D_RWKV, D_MODEL), D_RWKV ** -0.5)
    w_pb = nrm(ks[24], (DEPTH, D_ATT, D_MODEL), D_ATT ** -0.5)
    w_out = nrm(ks[25], (DEPTH, D_MODEL, D_MODEL), D_MODEL ** -0.5)
    return {'x_prompt': x_prompt, 'x_sample': x_sample, 'cache_k': cache_k, 'cache_v': cache_v,
            'cache_kidx': cache_kidx, 'state_wkv': state_wkv, 'state_shift': state_shift,
            'page_table': page_table, 'norm_g': norm_g, 'w_in': w_in, 'shift_mu': shift_mu,
            'w0': w0, 'w2': w2, 'a0': a0, 'a2': a2, 'k_k': k_k, 'k_a': k_a, 'r_k': r_k,
            'lnx_g': lnx_g, 'lnx_b': lnx_b, 'q_norm_g': q_norm_g, 'k_norm_g': k_norm_g,
            'rel_bias': rel_bias, 'w_pa': w_pa, 'w_pb': w_pb, 'w_out': w_out}


def reference(x_prompt, x_sample, cache_k, cache_v, cache_kidx, state_wkv, state_shift, page_table,
              norm_g, w_in, shift_mu, w0, w2, a0, a2, k_k, k_a, r_k, lnx_g, lnx_b,
              q_norm_g, k_norm_g, rel_bias, w_pa, w_pb, w_out):
    bsz, seq = x_prompt.shape[0], x_prompt.shape[1]
    dec_bsz, dec_seq = x_sample.shape[0], x_sample.shape[1]
    past_len = page_table.shape[1] * cache_k.shape[2]
    topk_p = min(TOPK_MAX, seq // 4)
    topk_s = min(TOPK_MAX, (past_len + dec_seq) // 4)
    zero_shift = jnp.zeros((bsz, RWKV_COLS), x_prompt.dtype)
    zero_wkv = jnp.zeros((bsz, RWKV_HEADS, RWKV_HEAD, RWKV_HEAD), x_prompt.dtype)
    hp, hs = x_prompt, x_sample
    outs_p, outs_s = [], []
    for l in range(DEPTH):
        params = (norm_g[l], w_in[l], shift_mu[l], w0[l], w2[l], a0[l], a2[l], k_k[l], k_a[l], r_k[l],
                  lnx_g[l], lnx_b[l], q_norm_g[l], k_norm_g[l], rel_bias, w_pa[l], w_pb[l], w_out[l])
        hp, st_p = _layer(hp, zero_shift, zero_wkv, None, None, None, 0, topk_p, *params)
        gather_past = lambda pool: pool[l][page_table].reshape(dec_bsz, past_len, *pool.shape[3:])
        hs, st_s = _layer(hs, state_shift[l], state_wkv[l], gather_past(cache_k), gather_past(cache_v),
                          gather_past(cache_kidx), past_len, topk_s, *params)
        outs_p.append(st_p)
        outs_s.append(st_s)
    stk = lambda outs, i: jnp.stack([o[i] for o in outs], axis=0)
    return (hp, hs,
            stk(outs_p, 0), stk(outs_p, 1), stk(outs_p, 2), stk(outs_p, 3), stk(outs_p, 4),
            stk(outs_s, 0), stk(outs_s, 1), stk(outs_s, 2), stk(outs_s, 3), stk(outs_s, 4))
```

```cpp
#include <hip/hip_runtime.h>
#include <cstdio>
#include <cstdint>

#ifndef MK_N_LAUNCHES
#define MK_N_LAUNCHES 1
#endif
#define PROBE_DUP -1
#define PROBE_SUB 15
#define PROBE_SKIPD 0
#define PROBE_PRE2 0
#define PROBE_SEQ2 0
#define PROBE_AT 0
#define PROBE_CH 0
#define PROBE_SKIPA 0
#define PROBE_SA 0
#define PROBE_SKIPC 0
#define REPS(k) (PROBE_DUP == (k) ? 2 : 1)

__device__ __forceinline__ int lane_now() { int l; asm volatile("v_mbcnt_lo_u32_b32 %0, -1, 0\n\tv_mbcnt_hi_u32_b32 %0, -1, %0" : "=v"(l)); return l; }
namespace pg8 {
#define PG8_LAS __attribute__((address_space(3)))
typedef unsigned short bf16_t;
typedef short bf16x8 __attribute__((ext_vector_type(8)));
typedef float f32x4 __attribute__((ext_vector_type(4)));
typedef unsigned u32x4 __attribute__((ext_vector_type(4)));
constexpr int BM = 256, BK = 64, HALF = 128, HTB = HALF * BK * 2  , STAGE_BYTES = 8 * HTB, NXCD = 8, WGM = 8;

__host__ __device__ __forceinline__ int lds_byte(int r, int c) { const int st = (r >> 4) * 2 + (c >> 5), rr = r & 15, cc = c & 31, ob = rr * 64 + cc * 2; return st * 1024 + (ob ^ (((ob >> 9) & 1) << 5)); }
__host__ __device__ __forceinline__ void stage_rc(int b, int& R, int& C) { const int st = b / 1024, sb = b % 1024, swz = sb ^ (((sb >> 9) & 1) << 5); R = (st >> 1) * 16 + swz / 64; C = (st & 1) * 32 + (swz % 64) / 2; }
__host__ __device__ __forceinline__ int perm32(int rho) { const int n = rho >> 4, i = rho & 15; return 8 * (i >> 2) + 4 * n + (i & 3); }

struct Unit { int pm, pn, half; };
struct Gemm { const bf16_t* A; const bf16_t* Bt; int M, N, K, lda, ldb; const bf16_t* A2; const bf16_t* Bt2; };

struct StaticOrder {
    int nM, nN, nwg, G, c;
    __host__ __device__ void init(int M, int N, int G_, int c_) { nM = M / BM; nN = N / BM; nwg = nM * nN; G = G_; c = c_; }
    __host__ __device__ bool next(int i, Unit& u) const {
        const long L = (long)i * G + c; if (L >= nwg) return false;
        int wgid = (int)L; { const int q = nwg / NXCD, r = nwg % NXCD, xcd = wgid % NXCD, off = wgid / NXCD; wgid = (xcd < r ? xcd * (q + 1) : r * (q + 1) + (xcd - r) * q) + off; }
        const int nig = WGM * nN, gid = wgid / nig, fm = gid * WGM, gsz = (nM - fm) < WGM ? (nM - fm) : WGM;
        u.pm = fm + ((wgid % nig) % gsz); u.pn = (wgid % nig) / gsz; u.half = 0; return true;
    }
    __device__ __forceinline__ void a_ready(const Unit&) const {}
    __device__ __forceinline__ void done(const Unit&) const {}
};
struct OneUnit {
    int pm, pn;
    __host__ __device__ bool next(int i, Unit& u) const { if (i != 0) return false; u.pm = pm; u.pn = pn; u.half = 0; return true; }
    __device__ __forceinline__ void a_ready(const Unit&) const {}
    __device__ __forceinline__ void done(const Unit&) const {}
};
struct TwoHalfOrder : StaticOrder {
    __host__ __device__ bool next(int i, Unit& u) const { if (!StaticOrder::next(i >> 1, u)) return false; u.half = i & 1; return true; }
};

__device__ __forceinline__ unsigned cvt_pk_bf16(float lo, float hi) { unsigned r; asm volatile("v_cvt_pk_bf16_f32 %0, %1, %2" : "=v"(r) : "v"(lo), "v"(hi)); return r; }

template <class Epi, class Sched>
__device__ __forceinline__ void gemm_phase(PG8_LAS unsigned char* lds, const Gemm g, const Sched& S, const Epi& E, int wave_) {
    const int wid = wave_, lane = lane_now(), tid = wid * 64 + lane,
              wr = wid >> 2, wc = wid & 3, fr = lane & 15, fq = lane >> 4;
    const int K = g.K, nt = K / BK;
    unsigned voffA[2], voffB[2];
#pragma unroll
    for (int i = 0; i < 2; ++i) { int R, C; stage_rc(tid * 16 + i * 8192, R, C); const int Rb = Epi::PERM ? ((R & ~31) + perm32(R & 31)) : R;
        voffA[i] = (unsigned)(R * g.lda + C) * 2u; voffB[i] = (unsigned)(Rb * g.ldb + C) * 2u; }
    const size_t kstep = (size_t)(BK * 2);
    const size_t hstepA = (size_t)HALF * g.lda * 2, hstepB = (size_t)HALF * g.ldb * 2;
    const size_t tstepA = 2 * hstepA, tstepB = 2 * hstepB;
    const unsigned ldsw = (unsigned)wid * 1024u;
    const int aoff = lds_byte(wr * 64 + fr, fq * 8), boff = lds_byte(wc * 32 + fr, fq * 8);
#define PG8_SA(b, h) (((b) * 2 + (h)) * HTB)
#define PG8_SB(b, h) ((4 + (b) * 2 + (h)) * HTB)
#define PG8_STAGE(bufoff, gbase, voff) do { _Pragma("unroll") for (int _i = 0; _i < 2; ++_i) \
        __builtin_amdgcn_global_load_lds((const unsigned*)((const char*)(gbase) + (voff)[_i]), (PG8_LAS unsigned*)(lds + (bufoff) + ldsw + _i * 8192), 16, 0, 0); } while (0)
#define PG8_LDA(dst, b, h) do { _Pragma("unroll") for (int m = 0; m < 4; ++m) _Pragma("unroll") for (int k = 0; k < 2; ++k) dst[m][k] = *(const PG8_LAS bf16x8*)(lds + PG8_SA(b, h) + aoff + m * 2048 + k * 1024); } while (0)
#define PG8_LDB(dst, b, h) do { _Pragma("unroll") for (int n = 0; n < 2; ++n) _Pragma("unroll") for (int k = 0; k < 2; ++k) dst[n][k] = *(const PG8_LAS bf16x8*)(lds + PG8_SB(b, h) + boff + n * 2048 + k * 1024); } while (0)
#define PG8_MMA(ai, bj, At, Bt) do { __builtin_amdgcn_s_setprio(1); _Pragma("unroll") for (int m = 0; m < 4; ++m) _Pragma("unroll") for (int n = 0; n < 2; ++n) _Pragma("unroll") for (int k = 0; k < 2; ++k) \
        acc[ai][bj][m][n] = __builtin_amdgcn_mfma_f32_16x16x32_bf16(Bt[n][k], At[m][k], acc[ai][bj][m][n], 0, 0, 0); __builtin_amdgcn_s_setprio(0); } while (0)
#define PG8_WAIT_V(n) asm volatile("s_waitcnt vmcnt(" #n ")" ::: "memory")
#define PG8_WAIT_L(n) asm volatile("s_waitcnt lgkmcnt(" #n ")" ::: "memory")
#define PG8_BAR __builtin_amdgcn_s_barrier()
#define PG8_SCHED __builtin_amdgcn_sched_barrier(0)
    Unit cur, nxt; int ui = 0;
    if (!S.next(0, cur)) return;
    f32x4 acc[2][2][4][2];
#pragma unroll
    for (int a = 0; a < 2; ++a)
#pragma unroll
        for (int b = 0; b < 2; ++b)
#pragma unroll
            for (int m = 0; m < 4; ++m)
#pragma unroll
                for (int n = 0; n < 2; ++n) acc[a][b][m][n] = (f32x4){0.f, 0.f, 0.f, 0.f};
    bf16x8 At[4][2], B0[2][2], B1[2][2];
    const char* cA = (const char*)(cur.half ? g.A2 : g.A) + (size_t)cur.pm * tstepA; const char* cB = (const char*)(cur.half ? g.Bt2 : g.Bt) + (size_t)cur.pn * tstepB;
    S.a_ready(cur);
    PG8_STAGE(PG8_SB(0, 0), cB, voffB); PG8_STAGE(PG8_SA(0, 0), cA, voffA); PG8_STAGE(PG8_SB(0, 1), cB + hstepB, voffB); PG8_STAGE(PG8_SA(0, 1), cA + hstepA, voffA);
    if (wr == 1) PG8_BAR;
    PG8_WAIT_V(4); PG8_BAR;
    PG8_STAGE(PG8_SB(1, 0), cB + kstep, voffB); PG8_STAGE(PG8_SA(1, 0), cA + kstep, voffA); PG8_STAGE(PG8_SB(1, 1), cB + hstepB + kstep, voffB);
    PG8_WAIT_V(6); PG8_BAR;
    for (;;) {
        const bool has_next = S.next(ui + 1, nxt);
        const char* nA = has_next ? (const char*)(nxt.half ? g.A2 : g.A) + (size_t)nxt.pm * tstepA : cA; const char* nB = has_next ? (const char*)(nxt.half ? g.Bt2 : g.Bt) + (size_t)nxt.pn * tstepB : cB;
        for (int t = 0; t < nt; t += 2) {
            const bool last = (t == nt - 2);
            const char* a1 = cA + (size_t)(t + 1) * kstep;
            const char* a2 = last ? nA : cA + (size_t)(t + 2) * kstep; const char* b2 = last ? nB : cB + (size_t)(t + 2) * kstep;
            const char* a3 = a2 + kstep; const char* b3 = b2 + kstep;
            if (last && has_next) S.a_ready(nxt);
            PG8_LDB(B0, 0, 0); PG8_SCHED; PG8_LDA(At, 0, 0); PG8_STAGE(PG8_SA(1, 1), a1 + hstepA, voffA);
            PG8_WAIT_L(8); PG8_BAR; PG8_WAIT_L(0); PG8_MMA(0, 0, At, B0); PG8_BAR; PG8_SCHED;
            PG8_LDB(B1, 0, 1); PG8_STAGE(PG8_SB(0, 0), b2, voffB);
            PG8_BAR; PG8_WAIT_L(0); PG8_MMA(0, 1, At, B1); PG8_BAR;
            PG8_LDA(At, 0, 1); PG8_STAGE(PG8_SA(0, 0), a2, voffA);
            PG8_BAR; PG8_WAIT_L(0); PG8_MMA(1, 0, At, B0); PG8_BAR; PG8_SCHED;
            PG8_STAGE(PG8_SB(0, 1), b2 + hstepB, voffB);
            if (Epi::NST == 16) { const int fl = __builtin_amdgcn_readfirstlane((ui > 0 && t == 0) ? 1 : 0); asm volatile("s_cmp_eq_u32 %0, 1\n\ts_cbranch_scc1 .Lwv_a%=\n\ts_waitcnt vmcnt(6)\n\ts_branch .Lwv_b%=\n.Lwv_a%=:\n\ts_waitcnt vmcnt(24)\n.Lwv_b%=:" :: "s"(fl) : "memory", "scc"); } else PG8_WAIT_V(6);
            PG8_BAR; PG8_MMA(1, 1, At, B1); PG8_BAR;
            PG8_LDB(B0, 1, 0); PG8_SCHED; PG8_LDA(At, 1, 0); PG8_STAGE(PG8_SA(0, 1), a2 + hstepA, voffA);
            PG8_WAIT_L(8); PG8_BAR; PG8_WAIT_L(0); PG8_MMA(0, 0, At, B0); PG8_BAR; PG8_SCHED;
            PG8_LDB(B1, 1, 1); PG8_STAGE(PG8_SB(1, 0), b3, voffB);
            PG8_BAR; PG8_WAIT_L(0); PG8_MMA(0, 1, At, B1); PG8_BAR;
            PG8_LDA(At, 1, 1); PG8_STAGE(PG8_SA(1, 0), a3, voffA);
            PG8_BAR; PG8_WAIT_L(0); PG8_MMA(1, 0, At, B0); PG8_BAR; PG8_SCHED;
            PG8_STAGE(PG8_SB(1, 1), b3 + hstepB, voffB);
            PG8_WAIT_V(6); PG8_BAR; PG8_MMA(1, 1, At, B1); PG8_BAR;
        }
        if (Epi::NST > 0 && has_next) { PG8_STAGE(PG8_SA(1, 1), nA + kstep + hstepA, voffA); }
        E(acc, cur, wr, wc, fr, fq); S.done(cur);
        if (!has_next) break;
        if (!(Epi::MID && cur.half == 0))
#pragma unroll
        for (int a = 0; a < 2; ++a)
#pragma unroll
            for (int b = 0; b < 2; ++b)
#pragma unroll
                for (int m = 0; m < 4; ++m)
#pragma unroll
                    for (int n = 0; n < 2; ++n) acc[a][b][m][n] = (f32x4){0.f, 0.f, 0.f, 0.f};
        cur = nxt; cA = nA; cB = nB; ++ui;
    }
    PG8_WAIT_V(0);
    if (wr == 0) PG8_BAR;
    PG8_BAR;
#undef PG8_SA
#undef PG8_SB
#undef PG8_STAGE
#undef PG8_LDA
#undef PG8_LDB
#undef PG8_MMA
#undef PG8_WAIT_V
#undef PG8_WAIT_L
#undef PG8_BAR
#undef PG8_SCHED
}
}

constexpr int D = 1024, NB = 8, SEQ = 2048, DB = 128, DS = 4, PAST = 2048, PAGE = 128, NPAGES = 16;
constexpr int MP = NB * SEQ;
constexpr int MS = DB * DS;
constexpr int M = MP + MS;
constexpr int NCOLS = 9160, NZ = 9216;
constexpr int RW_COLS = 4224;
constexpr int C_R = 0, C_K = 1024, C_V = 2048, C_G = 3072, C_WD = 4096, C_AD = 4160;
constexpr int C_Q = 4224, C_AK = 5248, C_AV = 5376, C_QI = 5504, C_KI = 6016, C_AG = 6080, C_GA = 7104, C_GB = 8128, C_WI = 9152;
constexpr int TOPK = 256;
constexpr float NORM_EPS = 1e-6f, LNX_EPS = 64e-5f;

constexpr size_t O_Y = 0;
constexpr size_t O_KP = (size_t)M * D;
constexpr size_t O_VP = O_KP + (size_t)MP * 128;
constexpr size_t O_KIP = O_VP + (size_t)MP * 128;
constexpr size_t O_WKVP = O_KIP + (size_t)MP * 64;
constexpr size_t O_SHP = O_WKVP + (size_t)NB * 16 * 64 * 64;
constexpr size_t O_KS = O_SHP + (size_t)NB * RW_COLS;
constexpr size_t O_VS = O_KS + (size_t)MS * 128;
constexpr size_t O_KIS = O_VS + (size_t)MS * 128;
constexpr size_t O_WKVS = O_KIS + (size_t)MS * 64;
constexpr size_t O_SHS = O_WKVS + (size_t)DB * 16 * 64 * 64;
constexpr size_t O_END = O_SHS + (size_t)DB * RW_COLS;
static_assert(O_END == 32195584, "output size");

constexpr size_t MiB = 1u << 20;
constexpr size_t WS_CTL = 0, CTL_ZERO_BYTES = 64 * 1024;
constexpr size_t WS_WIN = 2 * MiB;
constexpr size_t WS_WPAB = 20 * MiB;
constexpr size_t WS_WOUT = 24 * MiB;
constexpr size_t WS_W2T = 26 * MiB;
constexpr size_t WS_A2T = 26 * MiB + 128 * 1024;
constexpr size_t WS_XN = 32 * MiB;
constexpr size_t WS_Z = 66 * MiB;
constexpr size_t WS_KN = 364 * MiB;
constexpr size_t WS_OAB = 370 * MiB;
constexpr size_t WS_T1 = 436 * MiB;
constexpr size_t WS_MG = 502 * MiB;
constexpr size_t WS_VN = 536 * MiB;
constexpr size_t WS_KIN = 542 * MiB;
constexpr size_t WS_END = 546 * MiB;
constexpr int CW_TMO = 0, CW_QUEUE = 64, CW_BAR = 4096;
static_assert((CW_BAR + 2 * 3456) * 4 <= (int)CTL_ZERO_BYTES, "control words inside the zeroed region");

constexpr int RING_OFF = 0, RING_BYTES = 131072;
constexpr int SROW = 2068;
constexpr int L_S = 0;
constexpr int L_SEL = 132352;
constexpr int L_CNT = L_SEL + 8192;
constexpr int L_HIST = L_CNT + 64;
constexpr int LDS_BYTES = 160 * 1024;
constexpr int L_MISC = LDS_BYTES - 128;
constexpr int L_LUT = L_MISC - 2112;
constexpr int L_BIAS = L_LUT - 2048;
constexpr int L_M0 = L_BIAS - 64;
static_assert(L_HIST + 16 * 1040 <= L_M0, "LDS map");
constexpr int TC = 16;
#define GAS __attribute__((address_space(1)))
#define LAS __attribute__((address_space(3)))
typedef unsigned short bf16;
typedef unsigned v4u __attribute__((ext_vector_type(4)));
typedef unsigned v2u __attribute__((ext_vector_type(2)));
typedef float f32x4 __attribute__((ext_vector_type(4)));
typedef float f32x2 __attribute__((ext_vector_type(2)));
typedef short bf16x8 __attribute__((ext_vector_type(8)));
typedef short s16x4 __attribute__((ext_vector_type(4)));
typedef GAS unsigned gu32;
#define RLX_AGENT __ATOMIC_RELAXED, __HIP_MEMORY_SCOPE_AGENT
#define LDS_WAIT() asm volatile("s_waitcnt lgkmcnt(0)" ::: "memory")
#define VM_WAIT() asm volatile("s_waitcnt vmcnt(0)" ::: "memory")
typedef __bf16 bf16x2_t __attribute__((ext_vector_type(2)));
__device__ __forceinline__ unsigned pk2(float lo, float hi) { const f32x2 v = {lo, hi}; return __builtin_bit_cast(unsigned, __builtin_convertvector(v, bf16x2_t)); }
__device__ __forceinline__ unsigned f2bf(float f) { return pk2(f, 0.f) & 0xffffu; }
__device__ __forceinline__ float bf_lo(unsigned w) { return __builtin_bit_cast(float, w << 16); }
__device__ __forceinline__ float bf_hi(unsigned w) { return __builtin_bit_cast(float, w & 0xffff0000u); }
__device__ __forceinline__ float bf1(bf16 h) { return __builtin_bit_cast(float, (unsigned)h << 16); }
__device__ __forceinline__ float sigmoidf_(float x) { return __builtin_amdgcn_rcpf(1.0f + __expf(-x)); }

#define XB_TMO      128
#define XB_XCNT(j)  (256  + 64 * (j))
#define XB_XSUB(j)  (1280 + 64 * (j))
#define XB_XGEN(j)  (2304 + 64 * (j))
#define XB_TOP      3328
#define XB_TOPGEN   3392
#define XCD_BAR_WORDS 3456
#define XB_SPIN_CAP (1u << 22)
__device__ __forceinline__ unsigned xb_ld(unsigned* p)              { return __hip_atomic_load(p, __ATOMIC_RELAXED, __HIP_MEMORY_SCOPE_AGENT); }
__device__ __forceinline__ unsigned xb_add(unsigned* p, unsigned v) { return __hip_atomic_fetch_add(p, v, __ATOMIC_RELAXED, __HIP_MEMORY_SCOPE_AGENT); }
__device__ __forceinline__ unsigned xb_xcc_id() { return (unsigned)__builtin_amdgcn_s_getreg((3 << 11) | 20) & 0xFu; }
#define XB_SPIN(cond, bar) do { unsigned _sp = 0; while (cond) { __builtin_amdgcn_s_sleep(1); \
    if ((++_sp & 255u) == 0u) { if (xb_ld(&(bar)[XB_TMO])) break; if (_sp > XB_SPIN_CAP) { atomicAdd(&(bar)[XB_TMO], 1u); break; } } } } while (0)
struct XcdBarrier { unsigned* bar; unsigned x; volatile LAS unsigned* st; int wave; };
__device__ __forceinline__ XcdBarrier xcd_barrier_post(unsigned* bar, volatile LAS unsigned* st, int wave) {
    XcdBarrier b; b.bar = bar; b.x = xb_xcc_id(); b.st = st; b.wave = wave;
    if (wave == 0 && lane_now() == 0) (void)xb_add(&bar[XB_XCNT(b.x)], 1u);
    return b;
}
__device__ __forceinline__ void xcd_barrier_complete(unsigned* bar, unsigned x, unsigned& nloc, unsigned& nx) {
    const unsigned G = gridDim.x * gridDim.y * gridDim.z;
    unsigned sum, cnt, mine, sp = 0u;
    for (;;) {
        sum = 0u; cnt = 0u; mine = 0u;
#pragma unroll
        for (unsigned j = 0; j < 16; ++j) { const unsigned c = xb_ld(&bar[XB_XCNT(j)]); sum += c; cnt += (c > 0u) ? 1u : 0u; mine = (j == x) ? c : mine; }
        if (sum == G) break;
        __builtin_amdgcn_s_sleep(1);
        if ((++sp & 255u) == 0u) { if (xb_ld(&bar[XB_TMO])) break; if (sp > XB_SPIN_CAP) { atomicAdd(&bar[XB_TMO], 1u); break; } }
    }
    nloc = mine > 0u ? mine : 1u; nx = cnt > 0u ? cnt : 1u;
}
template <bool FENCE = true, bool ACQ = true>
__device__ __forceinline__ void xcd_barrier(const XcdBarrier& b) {
    asm volatile("s_waitcnt vmcnt(0)" ::: "memory");
    __syncthreads();
    if (b.wave == 0 && lane_now() == 0) {
        unsigned* bar = b.bar;
        __builtin_amdgcn_s_waitcnt(0);
        unsigned nloc = b.st[0], nx = b.st[1];
        if (nloc == 0u) { xcd_barrier_complete(bar, b.x, nloc, nx); b.st[0] = nloc; b.st[1] = nx; }
        const unsigned old = xb_add(&bar[XB_XSUB(b.x)], 1u);
        const unsigned gen = old / nloc;
        if (old + 1u == (gen + 1u) * nloc) {
            if (FENCE) __builtin_amdgcn_fence(__ATOMIC_RELEASE, "agent");
            asm volatile("s_waitcnt vmcnt(0)" ::: "memory");
            const unsigned og = xb_add(&bar[XB_TOP], 1u);
            const unsigned tg = og / nx;
            if (og + 1u == (tg + 1u) * nx) xb_add(&bar[XB_TOPGEN], 1u);
            else XB_SPIN(xb_ld(&bar[XB_TOPGEN]) == tg, bar);
            if (ACQ) __builtin_amdgcn_fence(__ATOMIC_ACQUIRE, "agent"); else asm volatile("" ::: "memory");
            xb_add(&bar[XB_XGEN(b.x)], 1u);
            asm volatile("s_waitcnt vmcnt(0)" ::: "memory");
        } else {
            XB_SPIN(xb_ld(&bar[XB_XGEN(b.x)]) == gen, bar);
            if (ACQ) __builtin_amdgcn_fence(__ATOMIC_ACQUIRE, "agent"); else asm volatile("" ::: "memory");
            asm volatile("s_waitcnt vmcnt(0)" ::: "memory");
        }
    }
    __syncthreads();
}

constexpr int NWAVES = 8;
struct Args { const float* in[26]; float* out; unsigned char* ws; int ph_lo, ph_hi, li, pad; };
enum { I_XP = 0, I_XS, I_CK, I_CV, I_CKI, I_SWKV, I_SSH, I_PT, I_NG, I_WIN, I_MU, I_W0, I_W2, I_A0, I_A2, I_KK, I_KA, I_RK, I_LG, I_LB, I_QG, I_KG, I_RB, I_WPA, I_WPB, I_WOUT };

struct Frame {
    LAS unsigned char* lds;
    volatile LAS unsigned* MISC;
    gu32* ctl;
    int wave, vcu, G;
};
#define FTID(F_) ((F_).wave * 64 + lane_now())
#define FLANE() lane_now()

__device__ __forceinline__ float wave_sum(float v) {
#pragma unroll
    for (int o = 1; o < 64; o <<= 1) v += __shfl_xor(v, o);
    return v;
}

__device__ __forceinline__ int win_src_col(int n) { return n < C_AG ? n : (n < C_WI ? n + 8 : (n < NCOLS ? n - C_WI + 6080 : -1)); }
__device__ __forceinline__ void p0_transpose_item(const float* W, int ldw, bool remap, bf16* WT, int ldd, int dcol0, int nblk, LAS float* scr, int item, int lane) {
    const int kb = item / nblk, nb = item % nblk, k0 = 64 * kb, n0 = 32 * nb;
    const int nsrc = remap ? win_src_col(n0 + (lane & 31)) : n0 + (lane & 31);
    const float* wp = W + (size_t)(k0 + (lane >> 5)) * ldw + (nsrc < 0 ? 0 : nsrc);
    float wv[32];
#pragma unroll
    for (int i = 0; i < 32; ++i) { wv[i] = wp[(size_t)(2 * i) * ldw]; }
#pragma unroll
    for (int i = 0; i < 32; ++i) { const int kk = 2 * i + (lane >> 5); scr[kk * 33 + (lane & 31)] = nsrc >= 0 ? wv[i] : 0.f; }
    LDS_WAIT(); asm volatile("" ::: "memory");
    const int c = lane & 7;
#pragma unroll
    for (int j = 0; j < 4; ++j) { const int n = (lane >> 3) + 8 * j; const LAS float* s = scr + (8 * c) * 33 + n;
        v4u o; o.x = pk2(s[0 * 33], s[1 * 33]); o.y = pk2(s[2 * 33], s[3 * 33]); o.z = pk2(s[4 * 33], s[5 * 33]); o.w = pk2(s[6 * 33], s[7 * 33]);
        *(GAS v4u*)(WT + (size_t)(n0 + n) * ldd + dcol0 + k0 + 8 * c) = o; }
    LDS_WAIT(); asm volatile("" ::: "memory");
}
__device__ __forceinline__ void p0_prologue(Frame& F, const Args& a) {
    const int lane0 = FLANE();
    LAS float* scr = (LAS float*)(F.lds + RING_OFF + F.wave * 16384);
    const int gw = F.vcu * NWAVES + F.wave, NGW = F.G * NWAVES;
    unsigned char* ws = a.ws;
    constexpr int I_IN = (D / 64) * (NZ / 32), I_SQ = (D / 64) * (D / 32), I_LR = (D / 32);
    constexpr int NITEMS = I_IN + 3 * I_SQ + 2 * I_LR;
    for (int it = gw; it < NITEMS; it += NGW) {
        int r = it;
        if (r < I_IN) { p0_transpose_item(a.in[I_WIN], NCOLS, true, (bf16*)(ws + WS_WIN), D, 0, NZ / 32, scr, r, lane0); continue; } r -= I_IN;
        if (r < I_SQ) { p0_transpose_item(a.in[I_WPA], D, false, (bf16*)(ws + WS_WPAB), 2 * D, 0, D / 32, scr, r, lane0); continue; } r -= I_SQ;
        if (r < I_SQ) { p0_transpose_item(a.in[I_WPB], D, false, (bf16*)(ws + WS_WPAB), 2 * D, D, D / 32, scr, r, lane0); continue; } r -= I_SQ;
        if (r < I_SQ) { p0_transpose_item(a.in[I_WOUT], D, false, (bf16*)(ws + WS_WOUT), D, 0, D / 32, scr, r, lane0); continue; } r -= I_SQ;
        if (r < I_LR) { p0_transpose_item(a.in[I_W2], D, false, (bf16*)(ws + WS_W2T), 64, 0, D / 32, scr, r, lane0); continue; } r -= I_LR;
        p0_transpose_item(a.in[I_A2], D, false, (bf16*)(ws + WS_A2T), 64, 0, D / 32, scr, r, lane0);
    }
    const GAS f32x4* g4 = (const GAS f32x4*)a.in[I_NG] + lane0;
    f32x4 gv[4];
#pragma unroll
    for (int j = 0; j < 4; ++j) gv[j] = g4[64 * j];
    for (int m0 = gw; m0 < M; m0 += 4 * NGW) {
        f32x4 v[4][4];
#pragma unroll
        for (int k = 0; k < 4; ++k) { const int m = m0 + k * NGW;
            if (m < M) { const float* xrow = m < MP ? a.in[I_XP] + (size_t)m * D : a.in[I_XS] + (size_t)(m - MP) * D; const GAS f32x4* xr = (const GAS f32x4*)xrow + lane0;
#pragma unroll
                for (int j = 0; j < 4; ++j) v[k][j] = xr[64 * j]; } }
#pragma unroll
        for (int k = 0; k < 4; ++k) { const int m = m0 + k * NGW;
            if (m < M) {
                float s = 0.f;
#pragma unroll
                for (int j = 0; j < 4; ++j) s += (v[k][j].x * v[k][j].x + v[k][j].y * v[k][j].y) + (v[k][j].z * v[k][j].z + v[k][j].w * v[k][j].w);
                const float rs = 1.f / sqrtf(wave_sum(s) * (1.f / D) + NORM_EPS);
                GAS unsigned long long* o8 = (GAS unsigned long long*)((bf16*)(ws + WS_XN) + (size_t)m * D) + lane0;
#pragma unroll
                for (int j = 0; j < 4; ++j) { const f32x4 y = v[k][j] * rs * gv[j]; o8[64 * j] = (unsigned long long)pk2(y.x, y.y) | ((unsigned long long)pk2(y.z, y.w) << 32); }
            } }
    }
}

#define ST_AGENT32(p_, v_) __hip_atomic_store((unsigned*)(p_), __builtin_bit_cast(unsigned, (v_)), __ATOMIC_RELAXED, __HIP_MEMORY_SCOPE_AGENT)
#define ST_AGENT64(p_, v_) __hip_atomic_store((unsigned long long*)(p_), __builtin_bit_cast(unsigned long long, (v_)), __ATOMIC_RELAXED, __HIP_MEMORY_SCOPE_AGENT)
#define ST_AGENT128(p_, v_) asm volatile("global_store_dwordx4 %0, %1, off sc1\n\ts_nop 1" :: "v"(p_), "v"(v_) : "memory")

template <bool WT>
struct EpiZT {
    static constexpr bool PERM = true, MID = false; static constexpr int NST = 16;
    bf16* O;
    __device__ __forceinline__ void operator()(const f32x4 (&acc)[2][2][4][2], const pg8::Unit& u, int wr, int wc, int fr, int fq) const {
        const int row0 = u.pm * 256 + wr * 64 + fr, col0 = u.pn * 256 + wc * 32 + 8 * fq;
#pragma unroll
        for (int ai = 0; ai < 2; ++ai)
#pragma unroll
            for (int m = 0; m < 4; ++m) { bf16* rowp = O + (size_t)(row0 + ai * 128 + m * 16) * NZ + col0;
#pragma unroll
                for (int bj = 0; bj < 2; ++bj) { f32x4 v0 = acc[ai][bj][m][0], v1 = acc[ai][bj][m][1];
                    const int cb = u.pn * 256 + bj * 128 + wc * 32;
                    if (cb >= C_GA && cb < C_WI) {
#pragma unroll
                        for (int e = 0; e < 4; ++e) { v0[e] = sigmoidf_(v0[e]); v1[e] = sigmoidf_(v1[e]); } }
                    v4u w; w.x = pg8::cvt_pk_bf16(v0[0], v0[1]); w.y = pg8::cvt_pk_bf16(v0[2], v0[3]); w.z = pg8::cvt_pk_bf16(v1[0], v1[1]); w.w = pg8::cvt_pk_bf16(v1[2], v1[3]);
                    if (WT) ST_AGENT128(rowp + bj * 128, w); else *(v4u*)(rowp + bj * 128) = w; } }
    }
};
typedef EpiZT<false> EpiZ;
struct EpiMerge {
    static constexpr bool PERM = true, MID = true; static constexpr int NST = -1;
    const bf16* Zb; bf16* O;
    __device__ __forceinline__ void operator()(f32x4 (&acc)[2][2][4][2], const pg8::Unit& u, int wr, int wc, int fr, int fq) const {
        const int row0 = u.pm * 256 + wr * 64 + fr, col0 = u.pn * 256 + wc * 32 + 8 * fq;
        if (u.half == 0) {
#pragma unroll
            for (int ai = 0; ai < 2; ++ai)
#pragma unroll
                for (int m = 0; m < 4; ++m) { const bf16* zr = Zb + (size_t)(row0 + ai * 128 + m * 16) * NZ + col0;
#pragma unroll
                    for (int bj = 0; bj < 2; ++bj) { const v4u ga = *(const v4u*)(zr + C_GA + bj * 128), gb = *(const v4u*)(zr + C_GB + bj * 128);
#define RT_(a_, b_) ((a_) * __builtin_amdgcn_rcpf(b_))
                        f32x4& v0 = acc[ai][bj][m][0]; f32x4& v1 = acc[ai][bj][m][1];
                        v0[0] *= RT_(bf_lo(ga.x), bf_lo(gb.x)); v0[1] *= RT_(bf_hi(ga.x), bf_hi(gb.x)); v0[2] *= RT_(bf_lo(ga.y), bf_lo(gb.y)); v0[3] *= RT_(bf_hi(ga.y), bf_hi(gb.y));
                        v1[0] *= RT_(bf_lo(ga.z), bf_lo(gb.z)); v1[1] *= RT_(bf_hi(ga.z), bf_hi(gb.z)); v1[2] *= RT_(bf_lo(ga.w), bf_lo(gb.w)); v1[3] *= RT_(bf_hi(ga.w), bf_hi(gb.w));
#undef RT_
                    } }
        } else {
#pragma unroll
            for (int ai = 0; ai < 2; ++ai)
#pragma unroll
                for (int m = 0; m < 4; ++m) { const size_t row = (size_t)(row0 + ai * 128 + m * 16);
#pragma unroll
                    for (int bj = 0; bj < 2; ++bj) { const v4u gz = *(const v4u*)(Zb + row * NZ + C_GB + col0 + bj * 128);
                        const f32x4 v0 = acc[ai][bj][m][0], v1 = acc[ai][bj][m][1];
                        v4u w; w.x = pg8::cvt_pk_bf16(v0[0] * bf_lo(gz.x), v0[1] * bf_hi(gz.x)); w.y = pg8::cvt_pk_bf16(v0[2] * bf_lo(gz.y), v0[3] * bf_hi(gz.y));
                        w.z = pg8::cvt_pk_bf16(v1[0] * bf_lo(gz.z), v1[1] * bf_hi(gz.z)); w.w = pg8::cvt_pk_bf16(v1[2] * bf_lo(gz.w), v1[3] * bf_hi(gz.w));
                        *(v4u*)(O + row * D + col0 + bj * 128) = w; } }
        }
    }
};
struct EpiOut {
    static constexpr bool PERM = false, MID = false; static constexpr int NST = -1;
    const float* xp; const float* xs; float* Y;
    __device__ __forceinline__ void operator()(const f32x4 (&acc)[2][2][4][2], const pg8::Unit& u, int wr, int wc, int fr, int fq) const {
        const int row0 = u.pm * 256 + wr * 64 + fr, col0 = u.pn * 256 + wc * 32 + 4 * fq;
        const float* xb = u.pm < MP / 256 ? xp : xs - (size_t)MP * D;
#pragma unroll
        for (int ai = 0; ai < 2; ++ai)
#pragma unroll
            for (int m = 0; m < 4; ++m) { const size_t off = (size_t)(row0 + ai * 128 + m * 16) * D + col0;
#pragma unroll
                for (int bj = 0; bj < 2; ++bj)
#pragma unroll
                    for (int n = 0; n < 2; ++n) { const f32x4 xv = *(const f32x4*)(xb + off + bj * 128 + n * 16); *(f32x4*)(Y + off + bj * 128 + n * 16) = xv + acc[ai][bj][m][n]; } }
    }
};

__device__ __forceinline__ void p2_rows(const Args& a, int mbeg, int mend, int rbeg, int rend, int gw, int NGW, int lane) {
    const bf16* Z = (const bf16*)(a.ws + WS_Z); bf16* KN = (bf16*)(a.ws + WS_KN); bf16* VN = (bf16*)(a.ws + WS_VN); bf16* KIN = (bf16*)(a.ws + WS_KIN);
    const float kg0 = a.in[I_KG][(lane & 31) * 2], kg1 = a.in[I_KG][(lane & 31) * 2 + 1];
    for (int m0 = mbeg + gw; m0 < mend; m0 += 9 * NGW) {
        unsigned kw4[9], vw4[9]; bf16 ki4[9];
#pragma unroll
        for (int k = 0; k < 9; ++k) { const int m = m0 + k * NGW;
            if (m < mend) { const bf16* zr = Z + (size_t)m * NZ; kw4[k] = *(const unsigned*)(zr + C_AK + 2 * lane); vw4[k] = *(const unsigned*)(zr + C_AV + 2 * lane); ki4[k] = zr[C_KI + lane]; } }
#pragma unroll
        for (int k = 0; k < 9; ++k) { const int m = m0 + k * NGW;
            if (m < mend) {
                float* ok = m < MP ? a.out + O_KP + (size_t)m * 128 : a.out + O_KS + (size_t)(m - MP) * 128;
                float* ov = m < MP ? a.out + O_VP + (size_t)m * 128 : a.out + O_VS + (size_t)(m - MP) * 128;
                float* oi = m < MP ? a.out + O_KIP + (size_t)m * 64 : a.out + O_KIS + (size_t)(m - MP) * 64;
                const float k0 = bf_lo(kw4[k]), k1 = bf_hi(kw4[k]);
                float s = k0 * k0 + k1 * k1;
#pragma unroll
                for (int o = 1; o < 32; o <<= 1) s += __shfl_xor(s, o);
                const float rs = 1.f / sqrtf(s * (1.f / 64.f) + NORM_EPS);
                const float y0 = k0 * rs * kg0, y1 = k1 * rs * kg1;
                ST_AGENT64(ok + 2 * lane, ((f32x2){y0, y1}));
                ST_AGENT32(KN + (size_t)m * 128 + 2 * lane, pk2(y0, y1));
                ST_AGENT64(ov + 2 * lane, ((f32x2){bf_lo(vw4[k]), bf_hi(vw4[k])}));
                ST_AGENT32(VN + (size_t)m * 128 + 2 * lane, vw4[k]);
                ST_AGENT32(oi + lane, bf1(ki4[k])); __hip_atomic_store((unsigned short*)(KIN + (size_t)m * 64 + lane), (unsigned short)ki4[k], __ATOMIC_RELAXED, __HIP_MEMORY_SCOPE_AGENT);
            } }
    }
    for (int r = rbeg + gw; r < rend; r += NGW) {
        const size_t m = r < NB ? (size_t)r * SEQ + SEQ - 1 : (size_t)MP + (size_t)(r - NB) * DS + DS - 1;
        const bf16* zr = Z + m * NZ; float* os = r < NB ? a.out + O_SHP + (size_t)r * RW_COLS : a.out + O_SHS + (size_t)(r - NB) * RW_COLS;
        unsigned w[33];
#pragma unroll
        for (int i = 0; i < 33; ++i) w[i] = *(const unsigned*)(zr + 2 * lane + 128 * i);
#pragma unroll
        for (int i = 0; i < 33; ++i) *(f32x2*)(os + 2 * lane + 128 * i) = (f32x2){bf_lo(w[i]), bf_hi(w[i])};
    }
}

#define DPP_ADD(x, ctrl) (x) += __builtin_bit_cast(float, __builtin_amdgcn_mov_dpp(__builtin_bit_cast(int, (x)), (ctrl), 0xF, 0xF, true))
__device__ __forceinline__ float sum8(float x) { DPP_ADD(x, 0xB1); DPP_ADD(x, 0x4E); DPP_ADD(x, 0x141); return x; }
__device__ __forceinline__ float half_sum(float v) {
#pragma unroll
    for (int o = 1; o < 32; o <<= 1) v += __shfl_xor(v, o);
    return v;
}

__device__ __forceinline__ float wsum(float x) {
    DPP_ADD(x, 0xB1); DPP_ADD(x, 0x4E); DPP_ADD(x, 0x141); DPP_ADD(x, 0x140);
    const int xi = __builtin_bit_cast(int, x);
    return (__builtin_bit_cast(float, __builtin_amdgcn_readlane(xi, 0)) + __builtin_bit_cast(float, __builtin_amdgcn_readlane(xi, 16)))
         + (__builtin_bit_cast(float, __builtin_amdgcn_readlane(xi, 32)) + __builtin_bit_cast(float, __builtin_amdgcn_readlane(xi, 48)));
}
__device__ __forceinline__ float fast_tanh(float x) { const float e = __expf(2.f * x); return 1.f - 2.f * __builtin_amdgcn_rcpf(e + 1.f); }

__device__ __forceinline__ bf16x8 pack8(const f32x4 lo, const f32x4 hi) {
    v4u w; w.x = pk2(lo[0], lo[1]); w.y = pk2(lo[2], lo[3]); w.z = pk2(hi[0], hi[1]); w.w = pk2(hi[2], hi[3]); return __builtin_bit_cast(bf16x8, w);
}
__device__ __forceinline__ unsigned sortable(float x) { const unsigned b = __builtin_bit_cast(unsigned, x); return b ^ ((b >> 31) ? 0xFFFFFFFFu : 0x80000000u); }
constexpr int PA = 136, PS = 160, PY = 72;
constexpr int CR_A = 0, CR_B = 16 * PA, CR_P = 32 * PA, CR_YO = CR_P  , CR_BN = CR_YO + 64 * PY, CR_KS = CR_BN + 16 * PS, CR_VS = CR_KS + 16 * PS, CR_GC = CR_VS + 16 * PS, CR_BYTES = CR_GC + 256;
constexpr int LC_CS = 8 * CR_BYTES, LC_XS = LC_CS + 13 * 256, CS_SAMPLE = 11 * 256;
static_assert(CR_BYTES == 16896 && LC_XS + 16384 <= L_M0 && LC_CS + 8 * CS_SAMPLE <= L_M0, "chain LDS map");
enum { CS_MU = 0  , CS_KK = 6, CS_KA = 7, CS_RK = 8, CS_W0 = 9, CS_A0 = 10, CS_LG = 11, CS_LB = 12 };

__device__ __forceinline__ float rowsum16(float x) { DPP_ADD(x, 0xB1); DPP_ADD(x, 0x4E); DPP_ADD(x, 0x141); DPP_ADD(x, 0x140); return x; }
__device__ __forceinline__ f32x4 up4(v2u w) { return (f32x4){bf_lo(w.x), bf_hi(w.x), bf_lo(w.y), bf_hi(w.y)}; }
__device__ __forceinline__ v2u dn4(f32x4 v) { v2u w; w.x = pk2(v[0], v[1]); w.y = pk2(v[2], v[3]); return w; }
__device__ __forceinline__ bf16x8 pk4z(f32x4 v) { v4u w; w.x = pk2(v[0], v[1]); w.y = pk2(v[2], v[3]); w.z = 0u; w.w = 0u; return __builtin_bit_cast(bf16x8, w); }
__device__ __forceinline__ bf16x8 cat8(v2u lo, v2u hi) { v4u w; w.x = lo.x; w.y = lo.y; w.z = hi.x; w.w = hi.y; return __builtin_bit_cast(bf16x8, w); }
__device__ __forceinline__ f32x4 exp4(f32x4 v) { return (f32x4){__expf(v[0]), __expf(v[1]), __expf(v[2]), __expf(v[3])}; }
__device__ __forceinline__ f32x4 sig4(f32x4 v) { return (f32x4){sigmoidf_(v[0]), sigmoidf_(v[1]), sigmoidf_(v[2]), sigmoidf_(v[3])}; }
#define MFMA16(A_, B_, C_) __builtin_amdgcn_mfma_f32_16x16x32_bf16((A_), (B_), (C_), 0, 0, 0)
#define ZERO4 ((f32x4){0.f, 0.f, 0.f, 0.f})

__device__ __forceinline__ void wkv_load_raw(v2u (&raw)[5][6], const bf16* Z, size_t row0, int T, int tc0, int h, bool sample, const float* shift_row, int fr, int fq) {
    const int segcol[6] = {C_R + h * 64, C_K + h * 64, C_V + h * 64, C_G + h * 64, C_WD, C_AD};
#pragma unroll
    for (int k = 0; k < 5; ++k) { int tg = tc0 + 4 * fq + k - 1; const bool first = tg < 0; tg = tg < 0 ? 0 : (tg >= T ? T - 1 : tg); const bf16* zr = Z + (row0 + tg) * NZ + 4 * fr;
#pragma unroll
        for (int s = 0; s < 6; ++s) {
            if (first) { if (sample) { const f32x4 x = *(const f32x4*)(shift_row + segcol[s] + 4 * fr); raw[k][s] = dn4(x); } else raw[k][s] = (v2u){0u, 0u}; }
            else raw[k][s] = *(const v2u*)(zr + segcol[s]); } }
}

template <bool GLOBALW>
__device__ __forceinline__ void wkv_pre(LAS unsigned char* R, const LAS float* CS, const LAS unsigned char* W2l, const LAS unsigned char* A2l, const bf16* W2g, const bf16* A2g, const v2u (&raw)[5][6], int tvalid, v2u (&vkp)[4], v2u (&gkp)[4], float (&bon)[4], int fr, int fq) {
    f32x4 zk[4];
    {
        f32x4 mu[6];
#pragma unroll
        for (int s = 0; s < 6; ++s) mu[s] = *(const LAS f32x4*)(CS + (CS_MU + s) * 64 + 4 * fr);
#pragma unroll
        for (int r = 0; r < 4; ++r) {
            f32x4 z[6];
#pragma unroll
            for (int s = 0; s < 6; ++s) { const f32x4 cur = up4(raw[r + 1][s]), prv = up4(raw[r][s]); z[s] = cur + (prv - cur) * mu[s]; }
            zk[r] = z[1]; vkp[r] = dn4(z[2]); gkp[r] = dn4(z[3]);
            *(LAS f32x2*)(R + CR_KS + (4 * fq + r) * PS + 8 * fr) = (f32x2){z[0][0], z[0][1]}; *(LAS f32x2*)(R + CR_VS + (4 * fq + r) * PS + 8 * fr) = (f32x2){z[0][2], z[0][3]};
            const f32x4 zw = {fast_tanh(z[4][0]), fast_tanh(z[4][1]), fast_tanh(z[4][2]), fast_tanh(z[4][3])};
            *(LAS v2u*)(R + CR_A + (4 * fq + r) * PA + 8 * fr) = dn4(zw); *(LAS v2u*)(R + CR_B + (4 * fq + r) * PA + 8 * fr) = dn4(z[5]);
        }
#pragma unroll
        for (int r = 0; r < 4; ++r) asm volatile("" : "+v"(zk[r]), "+v"(vkp[r]), "+v"(gkp[r]));
    }
    f32x4 lw[4], av[4];
    {
        const bf16x8 Aw0 = *(const LAS bf16x8*)(R + CR_A + fr * PA + fq * 16), Aw1 = *(const LAS bf16x8*)(R + CR_A + fr * PA + 64 + fq * 16);
        const bf16x8 Aa0 = *(const LAS bf16x8*)(R + CR_B + fr * PA + fq * 16), Aa1 = *(const LAS bf16x8*)(R + CR_B + fr * PA + 64 + fq * 16);
        f32x4 cw[4], ca[4];
#pragma unroll
        for (int nt = 0; nt < 4; ++nt) {
            bf16x8 Bw0, Bw1, Ba0, Ba1;
            if (GLOBALW) { const bf16* w2 = W2g + (size_t)(4 * fr + nt) * 64 + fq * 8; const bf16* a2 = A2g + (size_t)(4 * fr + nt) * 64 + fq * 8;
                Bw0 = *(const bf16x8*)w2; Bw1 = *(const bf16x8*)(w2 + 32); Ba0 = *(const bf16x8*)a2; Ba1 = *(const bf16x8*)(a2 + 32); }
            else { const LAS unsigned char* w2 = W2l + (4 * fr + nt) * 128; const LAS unsigned char* a2 = A2l + (4 * fr + nt) * 128;
                Bw0 = *(const LAS bf16x8*)(w2 + 16 * (fq ^ (fr & 7))); Bw1 = *(const LAS bf16x8*)(w2 + 16 * ((4 + fq) ^ (fr & 7)));
                Ba0 = *(const LAS bf16x8*)(a2 + 16 * (fq ^ (fr & 7))); Ba1 = *(const LAS bf16x8*)(a2 + 16 * ((4 + fq) ^ (fr & 7))); }
            cw[nt] = MFMA16(Aw0, Bw0, ZERO4); cw[nt] = MFMA16(Aw1, Bw1, cw[nt]);
            ca[nt] = MFMA16(Aa0, Ba0, ZERO4); ca[nt] = MFMA16(Aa1, Ba1, ca[nt]);
        }
        const f32x4 w0 = *(const LAS f32x4*)(CS + CS_W0 * 64 + 4 * fr), a0 = *(const LAS f32x4*)(CS + CS_A0 * 64 + 4 * fr);
#pragma unroll
        for (int r = 0; r < 4; ++r) { const f32x4 dw = {cw[0][r], cw[1][r], cw[2][r], cw[3][r]}, da = {ca[0][r], ca[1][r], ca[2][r], ca[3][r]};
            lw[r] = sig4(w0 + dw) * (-0.6065306597f); av[r] = sig4(a0 + da); }
    }
    f32x4 cl[4];
    {
#pragma unroll
        for (int r = 0; r < 4; ++r) if (4 * fq + r >= tvalid) lw[r] = ZERO4;
        f32x4 c[4]; c[0] = lw[0]; c[1] = c[0] + lw[1]; c[2] = c[1] + lw[2]; c[3] = c[2] + lw[3];
        f32x4 e = ZERO4;
#pragma unroll
        for (int j = 0; j < 4; ++j) { const float t1 = __shfl_up(c[3][j], 16), t2 = __shfl_up(c[3][j], 32), t3 = __shfl_up(c[3][j], 48); e[j] = (fq >= 1 ? t1 : 0.f) + (fq >= 2 ? t2 : 0.f) + (fq >= 3 ? t3 : 0.f); }
#pragma unroll
        for (int r = 0; r < 4; ++r) cl[r] = c[r] + e;
        if (fq == 3) *(LAS f32x4*)(R + CR_GC + 16 * fr) = exp4(cl[3]);
    }
    {
        const f32x4 kkc = *(const LAS f32x4*)(CS + CS_KK * 64 + 4 * fr), kac = *(const LAS f32x4*)(CS + CS_KA * 64 + 4 * fr), rkc = *(const LAS f32x4*)(CS + CS_RK * 64 + 4 * fr);
#pragma unroll
        for (int r = 0; r < 4; ++r) {
            const bool ok = 4 * fq + r < tvalid;
            const f32x4 kk = zk[r] * kkc; const float ss = rowsum16((kk[0] * kk[0] + kk[1] * kk[1]) + (kk[2] * kk[2] + kk[3] * kk[3]));
            const float rn = ok ? __builtin_amdgcn_rcpf(fmaxf(__builtin_amdgcn_sqrtf(ss), 1e-12f)) : 0.f;
            const f32x4 kkn = kk * rn;
            const f32x4 km = ok ? zk[r] * ((av[r] - 1.f) * kac + 1.f) : ZERO4;
            const f32x2 zlo = *(const LAS f32x2*)(R + CR_KS + (4 * fq + r) * PS + 8 * fr), zhi = *(const LAS f32x2*)(R + CR_VS + (4 * fq + r) * PS + 8 * fr);
            const f32x4 rr = ok ? (f32x4){zlo.x, zlo.y, zhi.x, zhi.y} : ZERO4;
            const f32x4 bt = rr * km * rkc; bon[r] = rowsum16((bt[0] + bt[1]) + (bt[2] + bt[3]));
            const f32x4 gi = exp4(-cl[r]);
            const f32x4 Amv = exp4(cl[r] - lw[r]) * kkn, Vmv = ok ? up4(vkp[r]) : ZERO4;
            const f32x4 Bmv = kkn * av[r] * gi, Kmv = km * gi, Pmv = exp4(cl[r]) * rr;
            *(LAS v2u*)(R + CR_A + (4 * fq + r) * PA + 8 * fr) = dn4(Amv); *(LAS v2u*)(R + CR_B + (4 * fq + r) * PA + 8 * fr) = dn4(Bmv); *(LAS v2u*)(R + CR_P + (4 * fq + r) * PA + 8 * fr) = dn4(Pmv);
            *(LAS v2u*)(R + CR_BN + (4 * fq + r) * PS + 8 * fr) = dn4(-Bmv); *(LAS v2u*)(R + CR_KS + (4 * fq + r) * PS + 8 * fr) = dn4(Kmv); *(LAS v2u*)(R + CR_VS + (4 * fq + r) * PS + 8 * fr) = dn4(Vmv);
        }
    }
    f32x4 G, Lm, G2, H1, H2;
    {
        const bf16x8 fA0 = *(const LAS bf16x8*)(R + CR_A + fr * PA + fq * 16), fA1 = *(const LAS bf16x8*)(R + CR_A + fr * PA + 64 + fq * 16);
        const bf16x8 fB0 = *(const LAS bf16x8*)(R + CR_B + fr * PA + fq * 16), fB1 = *(const LAS bf16x8*)(R + CR_B + fr * PA + 64 + fq * 16);
        const bf16x8 fK0 = *(const LAS bf16x8*)(R + CR_KS + fr * PS + fq * 16), fK1 = *(const LAS bf16x8*)(R + CR_KS + fr * PS + 64 + fq * 16);
        const bf16x8 fP0 = *(const LAS bf16x8*)(R + CR_P + fr * PA + fq * 16), fP1 = *(const LAS bf16x8*)(R + CR_P + fr * PA + 64 + fq * 16);
        G = MFMA16(fB0, fA0, ZERO4); G = MFMA16(fB1, fA1, G);
        Lm = MFMA16(fA0, fB0, ZERO4); Lm = MFMA16(fA1, fB1, Lm);
        G2 = MFMA16(fK0, fA0, ZERO4); G2 = MFMA16(fK1, fA1, G2);
        H1 = MFMA16(fB0, fP0, ZERO4); H1 = MFMA16(fB1, fP1, H1);
        H2 = MFMA16(fK0, fP0, ZERO4); H2 = MFMA16(fK1, fP1, H2);
#pragma unroll
        for (int r = 0; r < 4; ++r) { const int s = 4 * fq + r, t = fr;
            G[r] = s < t ? G[r] : 0.f; Lm[r] = s > t ? Lm[r] : 0.f; G2[r] = s < t ? G2[r] : 0.f; H1[r] = s <= t ? H1[r] : 0.f; H2[r] = s <= t ? H2[r] : 0.f; }
    }
    f32x4 Tm;
    {
        f32x4 Id;
#pragma unroll
        for (int r = 0; r < 4; ++r) Id[r] = (4 * fq + r == fr) ? 1.f : 0.f;
        const f32x4 Gs = MFMA16(pk4z(Lm), pk4z(G), ZERO4), Ls = MFMA16(pk4z(G), pk4z(Lm), ZERO4);
        const f32x4 Gq = MFMA16(pk4z(Ls), pk4z(Gs), ZERO4), Lq = MFMA16(pk4z(Gs), pk4z(Ls), ZERO4);
        const f32x4 Go = MFMA16(pk4z(Lq), pk4z(Gq), ZERO4);
        const f32x4 M1 = MFMA16(pk4z(Id + Lq), pk4z(Id + Go), ZERO4);
        const f32x4 M2 = MFMA16(pk4z(Id + Ls), pk4z(M1), ZERO4);
        Tm = MFMA16(pk4z(Id - Lm), pk4z(M2), ZERO4);
    }
    {
        const bf16x8 aT = pk4z(Tm), aG2 = pk4z(G2), aH1n = pk4z(-H1), aH2 = pk4z(H2);
        f32x4 Am[4], Pm[4], Vm[4];
#pragma unroll
        for (int r = 0; r < 4; ++r) { Am[r] = up4(*(const LAS v2u*)(R + CR_A + (4 * fq + r) * PA + 8 * fr)); Pm[r] = up4(*(const LAS v2u*)(R + CR_P + (4 * fq + r) * PA + 8 * fr)); Vm[r] = (4 * fq + r < tvalid) ? up4(vkp[r]) : ZERO4; }
        asm volatile("" ::: "memory");
#pragma unroll
        for (int nt = 0; nt < 4; ++nt) {
            const f32x4 amc = {Am[0][nt], Am[1][nt], Am[2][nt], Am[3][nt]}, vmc = {Vm[0][nt], Vm[1][nt], Vm[2][nt], Vm[3][nt]}, pmc = {Pm[0][nt], Pm[1][nt], Pm[2][nt], Pm[3][nt]};
            const f32x4 At = MFMA16(aT, pk4z(amc), ZERO4);
            const f32x4 Q = MFMA16(aG2, pk4z(vmc), ZERO4);
            const f32x4 Yt = MFMA16(aT, pk4z(Q), ZERO4);
            const f32x4 Pt = MFMA16(aH1n, pk4z(At), pmc);
            f32x4 Ol = MFMA16(aH2, pk4z(vmc), ZERO4); Ol = MFMA16(aH1n, pk4z(Yt), Ol);
#pragma unroll
            for (int r = 0; r < 4; ++r) {
                *(LAS unsigned short*)(R + CR_A + (4 * fq + r) * PA + (4 * fr + nt) * 2) = (unsigned short)f2bf(At[r]);
                *(LAS unsigned short*)(R + CR_B + (4 * fq + r) * PA + (4 * fr + nt) * 2) = (unsigned short)f2bf(Pt[r]); }
            *(LAS v2u*)(R + CR_YO + (4 * fr + nt) * PY + 8 * fq) = dn4(Yt); *(LAS v2u*)(R + CR_YO + (4 * fr + nt) * PY + 32 + 8 * fq) = dn4(Ol);
        }
    }
}

struct SeqOps { bf16x8 At0, At1, Pt0, Pt1; v2u yv, ov, vt; };
__device__ __forceinline__ v2u tr_read(const LAS unsigned char* p) { return __builtin_bit_cast(v2u, __builtin_amdgcn_ds_read_tr16_b64_v4i16((LAS s16x4*)p)); }
__device__ __forceinline__ void wkv_seq_load(const LAS unsigned char* R, SeqOps& o, int cb, int fr, int fq) {
    const int ic = 16 * cb + fr;
    const LAS unsigned char* ar = R + CR_A + fr * PA + 8 * fq; const LAS unsigned char* pr = R + CR_B + fr * PA + 8 * fq;
    o.At0 = cat8(*(const LAS v2u*)ar, *(const LAS v2u*)(ar + 32)); o.At1 = cat8(*(const LAS v2u*)(ar + 64), *(const LAS v2u*)(ar + 96));
    o.Pt0 = cat8(*(const LAS v2u*)pr, *(const LAS v2u*)(pr + 32)); o.Pt1 = cat8(*(const LAS v2u*)(pr + 64), *(const LAS v2u*)(pr + 96));
    const LAS unsigned char* yo = R + CR_YO + ic * PY;
    o.yv = *(const LAS v2u*)(yo + 8 * fq); o.ov = *(const LAS v2u*)(yo + 32 + 8 * fq);
    o.vt = tr_read(R + CR_VS + (4 * fq + (fr >> 2)) * PS + (16 * cb + 4 * (fr & 3)) * 2);
}
__device__ __forceinline__ void wkv_seq_step(LAS unsigned char* R, const SeqOps& o, f32x4 (&X)[4], int cb, int fr, int fq) {
    f32x4 gc[4]; bf16x8 Aj[4];
    const LAS unsigned char* trb = R + (4 * fq + (fr >> 2)) * PS + 4 * (fr & 3) * 2;
#pragma unroll
    for (int jt = 0; jt < 4; ++jt) { Aj[jt] = cat8(tr_read(trb + CR_BN + 32 * jt), tr_read(trb + CR_KS + 32 * jt)); gc[jt] = *(const LAS f32x4*)(R + CR_GC + (16 * jt + 4 * fq) * 4); }
    const bf16x8 Bx0 = pack8(X[0], X[1]), Bx1 = pack8(X[2], X[3]);
    const f32x4 U0 = MFMA16(o.At0, Bx0, up4(o.yv)), U1 = MFMA16(o.At1, Bx1, ZERO4);
    f32x4 O = MFMA16(o.Pt0, Bx0, up4(o.ov)); O = MFMA16(o.Pt1, Bx1, O);
    const bf16x8 Bu = cat8(dn4(U0 + U1), o.vt);
#pragma unroll
    for (int jt = 0; jt < 4; ++jt) X[jt] = MFMA16(Aj[jt], Bu, X[jt]) * gc[jt];
    *(LAS v2u*)(R + CR_YO + (16 * cb + fr) * PY + 8 * fq) = dn4(O);
}
__device__ __forceinline__ void wkv_seq(LAS unsigned char* R, f32x4 (&X)[4], int cb, int fr, int fq) { SeqOps o; wkv_seq_load(R, o, cb, fr, fq); asm volatile("" ::: "memory"); wkv_seq_step(R, o, X, cb, fr, fq); }

__device__ __forceinline__ void wkv_post(const LAS unsigned char* R, const f32x4 lg, const f32x4 lb, const v2u (&vkp)[4], const v2u (&gkp)[4], const float (&bon)[4], int tvalid, bf16* oab_row0, int fr, int fq) {
    f32x4 o[4];
#pragma unroll
    for (int nt = 0; nt < 4; ++nt) { const f32x4 c = up4(*(const LAS v2u*)(R + CR_YO + (4 * fr + nt) * PY + 8 * fq)); o[0][nt] = c[0]; o[1][nt] = c[1]; o[2][nt] = c[2]; o[3][nt] = c[3]; }
#pragma unroll
    for (int r = 0; r < 4; ++r) {
        const float mean = rowsum16((o[r][0] + o[r][1]) + (o[r][2] + o[r][3])) * (1.f / 64.f); const f32x4 d = o[r] - mean;
        const float var = rowsum16((d[0] * d[0] + d[1] * d[1]) + (d[2] * d[2] + d[3] * d[3])) * (1.f / 64.f);
        const f32x4 gv = up4(gkp[r]);
        f32x4 y = d * __builtin_amdgcn_rsqf(var + LNX_EPS) * lg + lb + up4(vkp[r]) * bon[r];
        y = y * gv * sig4(gv);
        if (4 * fq + r < tvalid) *(v2u*)(oab_row0 + (size_t)(4 * fq + r) * (2 * D) + 4 * fr) = dn4(y);
    }
}

__device__ __forceinline__ void wkv_consts(LAS float* CS, const Args& a, int h, int tid, int nthreads, int nrows) {
    const int segcol[6] = {C_R + h * 64, C_K + h * 64, C_V + h * 64, C_G + h * 64, C_WD, C_AD};
    for (int e = tid; e < nrows * 64; e += nthreads) { const int row = e >> 6, c = e & 63; float v;
        if (row < 6) v = a.in[I_MU][segcol[row] + c];
        else { const float* src = row == CS_KK ? a.in[I_KK] : row == CS_KA ? a.in[I_KA] : row == CS_RK ? a.in[I_RK] : row == CS_W0 ? a.in[I_W0] : row == CS_A0 ? a.in[I_A0] : row == CS_LG ? a.in[I_LG] : a.in[I_LB]; v = src[h * 64 + c]; }
        CS[e] = v; }
}

__device__ __forceinline__ void wkv_consts_wave(LAS float* CS, const Args& a, int h, int lane) {
    const int segcol[6] = {C_R + h * 64, C_K + h * 64, C_V + h * 64, C_G + h * 64, C_WD, C_AD};
    float v[11];
#pragma unroll
    for (int i = 0; i < 6; ++i) v[i] = a.in[I_MU][segcol[i] + lane];
    v[CS_KK] = a.in[I_KK][h * 64 + lane]; v[CS_KA] = a.in[I_KA][h * 64 + lane]; v[CS_RK] = a.in[I_RK][h * 64 + lane]; v[CS_W0] = a.in[I_W0][h * 64 + lane]; v[CS_A0] = a.in[I_A0][h * 64 + lane];
#pragma unroll
    for (int i = 0; i < 11; ++i) CS[i * 64 + lane] = v[i];
}

__device__ __forceinline__ void chain_item(Frame& F, const Args& a, int b, int h, int rep) {
    int tidv = FTID(F); asm volatile("" : "+v"(tidv));
    const int tid = tidv, lane = tidv & 63, wave = __builtin_amdgcn_readfirstlane(tidv >> 6), fr = lane & 15, fq = lane >> 4;
    const bf16* Z = (const bf16*)(a.ws + WS_Z); bf16* OAB = (bf16*)(a.ws + WS_OAB);
    const size_t row0 = (size_t)b * SEQ;
    LAS unsigned char* L = F.lds; LAS float* CS = (LAS float*)(L + LC_CS); LAS unsigned char* R = L + wave * CR_BYTES;
    wkv_consts(CS, a, h, tid, NWAVES * 64, 13);
    v2u raw[5][6];
    wkv_load_raw(raw, Z, row0, SEQ, wave * 16, h, false, nullptr, fr, fq);
    if (wave < 4) { LAS f32x4* xs = (LAS f32x4*)(L + LC_XS + wave * 4096) + lane;
#pragma unroll
        for (int jt = 0; jt < 4; ++jt) xs[64 * jt] = ZERO4; }
    __syncthreads();
    for (int grp = 0; grp < SEQ / (16 * NWAVES); ++grp) {
        const int c = grp * NWAVES + wave;
        v2u vk[4], gk[4]; float bon[4];
        int lg_ = lane; asm volatile("" : "+v"(lg_)); const int frg = lg_ & 15, fqg = lg_ >> 4;
        unsigned lb = (unsigned)(size_t)L; asm volatile("" : "+s"(lb));
        LAS unsigned char* Lg = (LAS unsigned char*)(size_t)lb; const LAS float* CSg = (const LAS float*)(Lg + LC_CS); LAS unsigned char* Rg = Lg + wave * CR_BYTES;
        unsigned long long wp_ = (unsigned long long)(size_t)((const bf16*)(a.ws + WS_W2T) + (size_t)h * 64 * 64); asm volatile("" : "+s"(wp_));
        const bf16* w2g = (const bf16*)(size_t)wp_;
        if (!((PROBE_CH & 1) && rep == 1)) wkv_pre<true>(Rg, CSg, nullptr, nullptr, w2g, w2g + (WS_A2T - WS_W2T) / 2, raw, 16, vk, gk, bon, frg, fqg);
        else { for (int r_ = 0; r_ < 4; ++r_) { vk[r_] = raw[r_][0]; gk[r_] = raw[r_][1]; bon[r_] = 0.f; } }
        asm volatile("" ::: "memory");
        if (grp + 1 < SEQ / (16 * NWAVES)) wkv_load_raw(raw, Z, row0, SEQ, (c + NWAVES) * 16, h, false, nullptr, frg, fqg);
        LDS_WAIT(); __builtin_amdgcn_s_barrier(); asm volatile("" ::: "memory");
        if (wave < 4) {
            LAS f32x4* xs = (LAS f32x4*)(Lg + LC_XS + wave * 4096) + lg_;
            f32x4 X[4];
#pragma unroll
            for (int jt = 0; jt < 4; ++jt) X[jt] = xs[64 * jt];
            if (!((PROBE_CH & 2) && rep == 1)) {
                SeqOps oa, ob;
                wkv_seq_load(Lg, oa, wave, frg, fqg);
#pragma unroll 1
                for (int cc = 0; cc < NWAVES; cc += 2) {
                    wkv_seq_load(Lg + (cc + 1) * CR_BYTES, ob, wave, frg, fqg);
                    wkv_seq_step(Lg + cc * CR_BYTES, oa, X, wave, frg, fqg);
                    if (cc + 2 < NWAVES) wkv_seq_load(Lg + (cc + 2) * CR_BYTES, oa, wave, frg, fqg);
                    wkv_seq_step(Lg + (cc + 1) * CR_BYTES, ob, X, wave, frg, fqg);
                }
            }
#pragma unroll
            for (int jt = 0; jt < 4; ++jt) xs[64 * jt] = X[jt];
        }
        LDS_WAIT(); __builtin_amdgcn_s_barrier(); asm volatile("" ::: "memory");
        if (!((PROBE_CH & 4) && rep == 1)) wkv_post(Rg, *(const LAS f32x4*)(CSg + CS_LG * 64 + 4 * frg), *(const LAS f32x4*)(CSg + CS_LB * 64 + 4 * frg), vk, gk, bon, (PROBE_CH && rep == 1) ? 0 : 16, OAB + (row0 + (size_t)c * 16) * (2 * D) + h * 64, frg, fqg);
    }
    if (wave < 4 && !(PROBE_CH && rep == 1)) { float* st = a.out + O_WKVP + ((size_t)(b * 16 + h) * 64 + 16 * wave + fr) * 64 + 4 * fq; const LAS f32x4* xs = (const LAS f32x4*)(L + LC_XS + wave * 4096) + lane;
#pragma unroll
        for (int jt = 0; jt < 4; ++jt) *(f32x4*)(st + 16 * jt) = xs[64 * jt]; }
}

__device__ __forceinline__ void sample_chain_item(Frame& F, const Args& a, int seq, int hh) {
    int tidv = FTID(F); asm volatile("" : "+v"(tidv));
    const int lane = tidv & 63, wave = __builtin_amdgcn_readfirstlane(tidv >> 6), fr = lane & 15, fq = lane >> 4;
    const int h = hh * 8 + wave;
    const bf16* Z = (const bf16*)(a.ws + WS_Z); bf16* OAB = (bf16*)(a.ws + WS_OAB);
    const size_t row0 = (size_t)MP + (size_t)seq * DS;
    LAS unsigned char* R = F.lds + wave * CR_BYTES; LAS float* CS = (LAS float*)(F.lds + LC_CS + wave * CS_SAMPLE);
    const f32x4 lgv = *(const f32x4*)(a.in[I_LG] + h * 64 + 4 * fr), lbv = *(const f32x4*)(a.in[I_LB] + h * 64 + 4 * fr);
    wkv_consts_wave(CS, a, h, lane);
    v2u raw[5][6];
    wkv_load_raw(raw, Z, row0, DS, 0, h, true, a.in[I_SSH] + (size_t)seq * RW_COLS, fr, fq);
    v2u vk[4], gk[4]; float bon[4];
    wkv_pre<true>(R, CS, nullptr, nullptr, (const bf16*)(a.ws + WS_W2T) + (size_t)h * 64 * 64, (const bf16*)(a.ws + WS_A2T) + (size_t)h * 64 * 64, raw, DS, vk, gk, bon, fr, fq);
    {
        const float* si = a.in[I_SWKV] + ((size_t)(seq * 16 + h) * 64 + fr) * 64 + 4 * fq; float* so = a.out + O_WKVS + ((size_t)(seq * 16 + h) * 64 + fr) * 64 + 4 * fq;
        f32x4 X[4][4];
#pragma unroll
        for (int cb = 0; cb < 4; ++cb)
#pragma unroll
            for (int jt = 0; jt < 4; ++jt) X[cb][jt] = *(const f32x4*)(si + (size_t)cb * 16 * 64 + 16 * jt);
#pragma unroll
        for (int cb = 0; cb < 4; ++cb) {
            wkv_seq(R, X[cb], cb, fr, fq);
#pragma unroll
            for (int jt = 0; jt < 4; ++jt) *(f32x4*)(so + (size_t)cb * 16 * 64 + 16 * jt) = X[cb][jt];
        }
    }
    wkv_post(R, lgv, lbv, vk, gk, bon, DS, OAB + row0 * (2 * D) + h * 64, fr, fq);
}


template <bool SAMPLE>
__device__ __forceinline__ void attn_item(Frame& F, const Args& a, int seq, int qb, int rep) {
    int tidv = FTID(F); asm volatile("" : "+v"(tidv));
    const int lane = tidv & 63, wave = __builtin_amdgcn_readfirstlane(tidv >> 6), fr = lane & 15, fq = lane >> 4;
    const bf16* Z = (const bf16*)(a.ws + WS_Z); const bf16* KN = (const bf16*)(a.ws + WS_KN);
    bf16* OAB = (bf16*)(a.ws + WS_OAB);
    LAS int* PT = (LAS int*)(F.lds + L_MISC + 64);
    if (SAMPLE) { if (tidv < NPAGES) PT[tidv] = ((const int*)a.in[I_PT])[seq * NPAGES + tidv]; __syncthreads(); }
    LAS float* S = (LAS float*)(F.lds + L_S); LAS unsigned short* SEL = (LAS unsigned short*)(F.lds + L_SEL); LAS int* CNT = (LAS int*)(F.lds + L_CNT);
    const LAS float* BIAS = (const LAS float*)(F.lds + L_BIAS); const LAS unsigned char* LUT = (const LAS unsigned char*)(F.lds + L_LUT);
    constexpr int NQ = SAMPLE ? DS : 16;
    const size_t qrow0 = SAMPLE ? (size_t)MP + (size_t)seq * DS : (size_t)seq * SEQ + (size_t)qb * 16;
    const size_t krow0 = SAMPLE ? (size_t)MP + (size_t)seq * DS : (size_t)seq * SEQ;
    const int ntiles = SAMPLE ? (PAST + DS + 15) / 16 : qb + 1;
    {
        bf16x8 Aq[8][2];
        { const int qr = fr < NQ ? fr : NQ - 1; const bf16* zq = Z + (qrow0 + qr) * NZ + C_QI + fq * 8;
#pragma unroll
          for (int hh = 0; hh < 8; ++hh) { Aq[hh][0] = *(const bf16x8*)(zq + hh * 64); Aq[hh][1] = *(const bf16x8*)(zq + hh * 64 + 32); } }
        float wi[4][8];
#pragma unroll
        for (int r = 0; r < 4; ++r) { const int q = (4 * fq + r) < NQ ? (4 * fq + r) : NQ - 1; const v4u w = *(const v4u*)(Z + (qrow0 + q) * NZ + C_WI);
            const float sc = 0.04419417382f;
            wi[r][0] = bf_lo(w.x) * sc; wi[r][1] = bf_hi(w.x) * sc; wi[r][2] = bf_lo(w.y) * sc; wi[r][3] = bf_hi(w.y) * sc;
            wi[r][4] = bf_lo(w.z) * sc; wi[r][5] = bf_hi(w.z) * sc; wi[r][6] = bf_lo(w.w) * sc; wi[r][7] = bf_hi(w.w) * sc; }
        f32x4 Rp[4][4];
        auto ld_tile = [&](int kt, f32x4 (&R)[4]) {
            const int key = kt * 16 + fr;
            const int knew = (key - PAST) < DS ? (key - PAST) : DS - 1;
            const float* kp = (key >= PAST ? a.out + O_KIS + ((size_t)seq * DS + knew) * 64 : a.in[I_CKI] + ((size_t)PT[(key < PAST ? key : 0) >> 7] * PAGE + (key & (PAGE - 1))) * 64) + fq * 8;
            R[0] = *(const f32x4*)kp; R[1] = *(const f32x4*)(kp + 4); R[2] = *(const f32x4*)(kp + 32); R[3] = *(const f32x4*)(kp + 36);
        };
#pragma unroll
        for (int i = 0; i < 4; ++i) { const int kt = wave + NWAVES * i; if (kt < ntiles) ld_tile(kt, Rp[i]); }
        if (!((PROBE_SA & 1) && rep == 1))
        for (int kt0 = wave; kt0 < ntiles; kt0 += 4 * NWAVES) {
#pragma unroll
            for (int i = 0; i < 4; ++i) { const int kt = kt0 + NWAVES * i;
                if (kt < ntiles) {
                    const bf16x8 Bk0 = pack8(Rp[i][0], Rp[i][1]), Bk1 = pack8(Rp[i][2], Rp[i][3]);
                    if (kt + 4 * NWAVES < ntiles) ld_tile(kt + 4 * NWAVES, Rp[i]);
                    f32x4 sc = {0.f, 0.f, 0.f, 0.f};
#pragma unroll
                    for (int hh = 0; hh < 8; ++hh) { f32x4 c = {0.f, 0.f, 0.f, 0.f};
                        c = __builtin_amdgcn_mfma_f32_16x16x32_bf16(Aq[hh][0], Bk0, c, 0, 0, 0); c = __builtin_amdgcn_mfma_f32_16x16x32_bf16(Aq[hh][1], Bk1, c, 0, 0, 0);
#pragma unroll
                        for (int r = 0; r < 4; ++r) sc[r] += wi[r][hh] * fmaxf(c[r], 0.f); }
#pragma unroll
                    for (int r = 0; r < 4; ++r) S[(4 * fq + r) * SROW + kt * 16 + fr] = sc[r] + 0.0f;
                } }
        }
    }
    __syncthreads();
    {
        const int nqw = SAMPLE ? (wave < DS ? 1 : 0) : 2;
        for (int qq = 0; qq < nqw; ++qq) {
            const int q = SAMPLE ? wave : 2 * wave + qq;
            const int n = SAMPLE ? PAST + q + 1 : qb * 16 + q + 1;
            LAS unsigned short* sel = SEL + q * TOPK;
            if (n <= TOPK || ((PROBE_SA & 2) && rep == 1)) {
#pragma unroll
                for (int i = 0; i < 4; ++i) { const int idx = lane + 64 * i; if (idx < n) sel[idx] = (unsigned short)idx; }
                if (lane == 0) CNT[q] = n < TOPK ? n : TOPK;
            } else {
                unsigned u[33];
#pragma unroll
                for (int i = 0; i < 33; ++i) { const int idx = lane + 64 * i; float x = S[q * SROW + (idx < SROW ? idx : SROW - 1)]; asm volatile("" : "+v"(x));
                    u[i] = idx < n ? sortable(x) : 0u; }
                unsigned Tv = 0u;
                for (int bit = 31; bit >= 0; --bit) {
                    const unsigned cand = Tv | (1u << bit); int c = 0;
#pragma unroll
                    for (int i = 0; i < 33; ++i) c += __popcll(__ballot(u[i] >= cand));
                    if (c >= TOPK) Tv = cand;
                }
                int G = 0;
#pragma unroll
                for (int i = 0; i < 33; ++i) G += __popcll(__ballot(u[i] > Tv));
                const int need = TOPK - G;
                int base = 0, tb = 0;
#pragma unroll
                for (int i = 0; i < 33; ++i) {
                    const bool gt = u[i] > Tv, eq = u[i] == Tv;
                    const unsigned long long meq = __ballot(eq);
                    const int trank = tb + (int)__builtin_amdgcn_mbcnt_hi((unsigned)(meq >> 32), __builtin_amdgcn_mbcnt_lo((unsigned)meq, 0u));
                    const bool take = gt || (eq && trank < need);
                    const unsigned long long mt = __ballot(take);
                    const int pos = base + (int)__builtin_amdgcn_mbcnt_hi((unsigned)(mt >> 32), __builtin_amdgcn_mbcnt_lo((unsigned)mt, 0u));
                    if (take) sel[pos] = (unsigned short)(lane + 64 * i);
                    base += __popcll(mt); tb += __popcll(meq);
                }
                if (lane == 0) CNT[q] = TOPK;
            }
        }
    }
    __syncthreads();
    LAS unsigned char* VST = F.lds + L_S + wave * 8192;
    if (!((PROBE_SA & 4) && rep == 1))
    for (int un = wave; un < NQ * 2; un += NWAVES) {
        const int q = un >> 1, g = un & 1;
        const int cnt = __builtin_amdgcn_readfirstlane(CNT[q]); const int pos = SAMPLE ? PAST + q : qb * 16 + q;
        const size_t qrow = qrow0 + q;
        const int head = g * 8 + (fr & 7);
        const LAS unsigned short* sel = SEL + q * TOPK;
        bf16x8 Bq0, Bq1;
        { const bf16* qp = Z + qrow * NZ + C_Q + head * 64 + fq * 8; const v4u w0 = *(const v4u*)qp, w1 = *(const v4u*)(qp + 32);
          float x[16] = {bf_lo(w0.x), bf_hi(w0.x), bf_lo(w0.y), bf_hi(w0.y), bf_lo(w0.z), bf_hi(w0.z), bf_lo(w0.w), bf_hi(w0.w),
                         bf_lo(w1.x), bf_hi(w1.x), bf_lo(w1.y), bf_hi(w1.y), bf_lo(w1.z), bf_hi(w1.z), bf_lo(w1.w), bf_hi(w1.w)};
          float ss = 0.f;
#pragma unroll
          for (int j = 0; j < 16; ++j) ss += x[j] * x[j];
          ss += __shfl_xor(ss, 16); ss += __shfl_xor(ss, 32);
          const float rs = (0.125f * 1.44269504089f) / sqrtf(ss * (1.f / 64.f) + NORM_EPS);
          const f32x4 g0 = *(const f32x4*)(a.in[I_QG] + fq * 8), g1 = *(const f32x4*)(a.in[I_QG] + fq * 8 + 4), g2 = *(const f32x4*)(a.in[I_QG] + 32 + fq * 8), g3 = *(const f32x4*)(a.in[I_QG] + 36 + fq * 8);
          Bq0 = pack8((f32x4){x[0] * rs * g0[0], x[1] * rs * g0[1], x[2] * rs * g0[2], x[3] * rs * g0[3]}, (f32x4){x[4] * rs * g1[0], x[5] * rs * g1[1], x[6] * rs * g1[2], x[7] * rs * g1[3]});
          Bq1 = pack8((f32x4){x[8] * rs * g2[0], x[9] * rs * g2[1], x[10] * rs * g2[2], x[11] * rs * g2[3]}, (f32x4){x[12] * rs * g3[0], x[13] * rs * g3[1], x[14] * rs * g3[2], x[15] * rs * g3[3]}); }
        f32x4 RB[16];
        float alpha[4]; bf16x8 Pf[4][2];
        float mrun = -INFINITY, sum = 0.f;
#define SA_FENCE asm volatile("" ::: "memory"); __builtin_amdgcn_sched_barrier(0)
#define SA_LDK(j, s) do { const int slot_ = (j) * 16 + fr; const int key_ = sel[slot_ < cnt ? slot_ : cnt - 1]; \
            const float* kp_ = (key_ >= PAST ? a.out + O_KS + ((size_t)seq * DS + (key_ - PAST)) * 128 : a.in[I_CK] + ((size_t)PT[(key_ < PAST ? key_ : 0) >> 7] * PAGE + (key_ & (PAGE - 1))) * 128) + g * 64 + fq * 8; \
            RB[4 * (s)] = *(const f32x4*)kp_; RB[4 * (s) + 1] = *(const f32x4*)(kp_ + 4); RB[4 * (s) + 2] = *(const f32x4*)(kp_ + 32); RB[4 * (s) + 3] = *(const f32x4*)(kp_ + 36); } while (0)
#define SA_LDV(i, p) do { const int r_ = (lane >> 3) + 8 * ((i) & 7); const int slot_ = ((i) >> 3) * 64 + r_; const int key_ = sel[slot_ < cnt ? slot_ : cnt - 1]; \
            const float* vp_ = (key_ >= PAST ? a.out + O_VS + ((size_t)seq * DS + (key_ - PAST)) * 128 : a.in[I_CV] + ((size_t)PT[(key_ < PAST ? key_ : 0) >> 7] * PAGE + (key_ & (PAGE - 1))) * 128) + g * 64 + (lane & 7) * 8; \
            RB[2 * (p)] = *(const f32x4*)vp_; RB[2 * (p) + 1] = *(const f32x4*)(vp_ + 4); } while (0)
#define SA_VPAIR(i) ((i) & 7)
#pragma unroll
        for (int j = 0; j < 4; ++j) SA_LDK(j, j);
        SA_FENCE;
        {
            float lg[4][4];
#pragma unroll
            for (int j = 0; j < 16; ++j) {
                const int t4 = j & 3, ch = j >> 2, sl = j & 3, sb = j * 16;
                const bf16x8 Ak0 = pack8(RB[4 * sl], RB[4 * sl + 1]), Ak1 = pack8(RB[4 * sl + 2], RB[4 * sl + 3]);
                f32x4 c = {0.f, 0.f, 0.f, 0.f};
                c = __builtin_amdgcn_mfma_f32_16x16x32_bf16(Ak0, Bq0, c, 0, 0, 0); c = __builtin_amdgcn_mfma_f32_16x16x32_bf16(Ak1, Bq1, c, 0, 0, 0);
                SA_FENCE;
                if (j + 4 < 16) SA_LDK(j + 4, sl); else { SA_LDV(2 * (j - 12), 2 * sl); SA_LDV(2 * (j - 12) + 1, 2 * sl + 1); }
                SA_FENCE;
                const v2u kw = *(const LAS v2u*)(sel + sb + 4 * fq);
                const int k4[4] = {(int)(kw.x & 0xffffu), (int)(kw.x >> 16), (int)(kw.y & 0xffffu), (int)(kw.y >> 16)};
#pragma unroll
                for (int r = 0; r < 4; ++r) { const bool ok = (sb + 4 * fq + r) < cnt; const int dist = ok ? pos - k4[r] : 0;
                    float bv = BIAS[(int)LUT[dist] * 16 + head]; asm volatile("" : "+v"(bv));
                    lg[t4][r] = ok ? c[r] + bv : -INFINITY; }
                if (t4 == 3) {
                    float mx = mrun;
#pragma unroll
                    for (int u4 = 0; u4 < 4; ++u4)
#pragma unroll
                        for (int r = 0; r < 4; ++r) mx = fmaxf(mx, lg[u4][r]);
                    mx = fmaxf(mx, __shfl_xor(mx, 16)); mx = fmaxf(mx, __shfl_xor(mx, 32));
                    alpha[ch] = __builtin_amdgcn_exp2f(mrun - mx); mrun = mx;
                    float ps = 0.f;
#pragma unroll
                    for (int u4 = 0; u4 < 4; ++u4)
#pragma unroll
                        for (int r = 0; r < 4; ++r) { lg[u4][r] = __builtin_amdgcn_exp2f(lg[u4][r] - mx); ps += lg[u4][r]; }
                    sum = sum * alpha[ch] + ps;
#pragma unroll
                    for (int k2 = 0; k2 < 2; ++k2) Pf[ch][k2] = pack8((f32x4){lg[2 * k2][0], lg[2 * k2][1], lg[2 * k2][2], lg[2 * k2][3]}, (f32x4){lg[2 * k2 + 1][0], lg[2 * k2 + 1][1], lg[2 * k2 + 1][2], lg[2 * k2 + 1][3]});
                }
            }
        }
        f32x4 ao[4];
#pragma unroll
        for (int dt = 0; dt < 4; ++dt) ao[dt] = (f32x4){0.f, 0.f, 0.f, 0.f};
#pragma unroll
        for (int i = 0; i < 32; ++i) {
            const int ch = i >> 3, pr = SA_VPAIR(i);
            { const int r = (lane >> 3) + 8 * (i & 7), c16 = lane & 7;
              *(LAS v4u*)(VST + r * 128 + 16 * (c16 ^ (r & 7))) = __builtin_bit_cast(v4u, pack8(RB[2 * pr], RB[2 * pr + 1])); }
            SA_FENCE;
            if (i + 8 < 32) SA_LDV(i + 8, pr);
            SA_FENCE;
            if ((i & 7) == 7) {
#pragma unroll
                for (int dt = 0; dt < 4; ++dt) ao[dt] = ao[dt] * alpha[ch];
#pragma unroll
                for (int k2 = 0; k2 < 2; ++k2) { const int ra = k2 * 32 + 4 * fq + (fr >> 2), rb = ra + 16;
#pragma unroll
                    for (int dt = 0; dt < 4; ++dt) { const int c16 = 2 * dt + ((fr & 3) >> 1), sub = 8 * (fr & 1);
                        const s16x4 va = __builtin_amdgcn_ds_read_tr16_b64_v4i16((LAS s16x4*)(VST + ra * 128 + 16 * (c16 ^ (ra & 7)) + sub));
                        const s16x4 vb = __builtin_amdgcn_ds_read_tr16_b64_v4i16((LAS s16x4*)(VST + rb * 128 + 16 * (c16 ^ (rb & 7)) + sub));
                        const bf16x8 Av = {va[0], va[1], va[2], va[3], vb[0], vb[1], vb[2], vb[3]};
                        ao[dt] = __builtin_amdgcn_mfma_f32_16x16x32_bf16(Av, Pf[ch][k2], ao[dt], 0, 0, 0); } }
                SA_FENCE;
            }
        }
#undef SA_FENCE
#undef SA_LDK
#undef SA_LDV
#undef SA_VPAIR
        sum += __shfl_xor(sum, 16); sum += __shfl_xor(sum, 32);
        if (fr < 8) {
            const float inv = 1.0f / sum;
#pragma unroll
            for (int dt = 0; dt < 4; ++dt) { const int col = head * 64 + dt * 16 + 4 * fq;
                const v2u gw = *(const v2u*)(Z + qrow * NZ + C_AG + col);
                const float g0 = bf_lo(gw.x), g1 = bf_hi(gw.x), g2 = bf_lo(gw.y), g3 = bf_hi(gw.y);
                v2u o; o.x = pk2(ao[dt][0] * inv * g0 * sigmoidf_(g0), ao[dt][1] * inv * g1 * sigmoidf_(g1)); o.y = pk2(ao[dt][2] * inv * g2 * sigmoidf_(g2), ao[dt][3] * inv * g3 * sigmoidf_(g3));
                if (!(PROBE_SA && rep == 1)) *(v2u*)(OAB + qrow * (2 * D) + D + col) = o; }
        }
    }
}

__device__ __forceinline__ int kv_rowpos(int key, int g) { return key * 2 + (g ^ (((key >> 2) ^ (key >> 3)) & 1)); }
__device__ __forceinline__ int kv_sw(int key) { return 2 * (key & 3) + ((key >> 3) & 1); }

__device__ __forceinline__ void att_dma(LAS unsigned char* stw, const bf16* kt, const bf16* vt, const unsigned (&goff)[2]) {
#pragma unroll
    for (int i = 0; i < 2; ++i) {
        __builtin_amdgcn_global_load_lds((const unsigned*)(kt + goff[i]), (LAS unsigned*)(stw + i * 1024), 16, 0, 0);
        __builtin_amdgcn_global_load_lds((const unsigned*)(vt + goff[i]), (LAS unsigned*)(stw + 16384 + i * 1024), 16, 0, 0); }
}
constexpr int BMP = 65, MT_OFFW = 16 * BMP;
static_assert((MT_OFFW * 4) % 32 == 0 && MT_OFFW * 4 + 4096 <= 8192 + 64, "mask images");
__device__ __forceinline__ void att_mask_tile(const LAS unsigned* BM, int kt, int wave, int lane) {
    const int key = wave * 8 + (lane >> 3), qp = lane & 7;
    const unsigned w0 = BM[(2 * qp) * BMP + kt * 2 + (key >> 5)], w1 = BM[(2 * qp + 1) * BMP + kt * 2 + (key >> 5)];
    const unsigned b0 = (w0 >> (key & 31)) & 1u, b1 = (w1 >> (key & 31)) & 1u;
    ((LAS unsigned*)BM)[MT_OFFW + (kt & 1) * 512 + key * 8 + qp] = (b0 ? 0u : 0xC76Au) | (b1 ? 0u : 0xC76A0000u);
}
template <bool FAR>
__device__ __forceinline__ void att_tile(int kt, int nt64, int qb, int g, int qq, int fr, int fq, int head, float bias_far, float m0h, LAS unsigned char* ST, const LAS unsigned* BM, const LAS float* BIAS, const LAS unsigned char* LUT,
                                         const bf16* kt0, const bf16* vt0, const unsigned (&goff)[2], unsigned ldsw,
                                         const bf16x8 (&Bq)[2][2], const bf16x8 (&Bmk)[2], f32x4 (&ao)[2][4], f32x4 (&lsum)[2]) {
    LAS unsigned char* Kb = ST + (kt & 3) * 32768; LAS unsigned char* Vb = Kb + 16384;
    if (kt + 3 < nt64) att_dma(ST + ((kt + 3) & 3) * 32768 + ldsw, kt0 + (size_t)(kt + 3) * 8192, vt0 + (size_t)(kt + 3) * 8192, goff);
    if (kt + 1 < nt64) att_mask_tile(BM, kt + 1, g * 4 + qq, fq * 16 + fr);
    const LAS unsigned char* MTb = (const LAS unsigned char*)(BM + MT_OFFW) + (kt & 1) * 2048;
    f32x4 cq[2][4];
    {
        bf16x8 Ak[4][2], Am[4];
#pragma unroll
        for (int sub = 0; sub < 4; ++sub) { const int krw = sub * 16 + fr; const int rp = kv_rowpos(krw, g) * 128;
            Ak[sub][0] = *(const LAS bf16x8*)(Kb + rp + 16 * (fq ^ kv_sw(krw))); Ak[sub][1] = *(const LAS bf16x8*)(Kb + rp + 16 * ((4 + fq) ^ kv_sw(krw)));
            Am[sub] = *(const LAS bf16x8*)(MTb + krw * 32 + 16 * (fq & 1)); }
#pragma unroll
        for (int nt = 0; nt < 2; ++nt) {
            const int ql = 4 * qq + 2 * nt + (fr >> 3);
#pragma unroll
            for (int sub = 0; sub < 4; ++sub) {
                f32x4 cin;
#pragma unroll
                for (int r = 0; r < 4; ++r) {
                    float bv = bias_far;
                    if (!FAR) { const int dd = qb * 16 + ql - (kt * 64 + sub * 16 + 4 * fq) - r; bv = BIAS[(int)LUT[dd < 0 ? 0 : dd] * 16 + head]; asm volatile("" : "+v"(bv)); bv -= m0h; }
                    cin[r] = bv;
                }
                cq[nt][sub] = __builtin_amdgcn_mfma_f32_16x16x32_bf16(Am[sub], Bmk[nt], cin, 0, 0, 0);
                cq[nt][sub] = __builtin_amdgcn_mfma_f32_16x16x32_bf16(Ak[sub][0], Bq[nt][0], cq[nt][sub], 0, 0, 0);
            }
        }
#pragma unroll
        for (int sub = 0; sub < 4; ++sub)
#pragma unroll
            for (int nt = 0; nt < 2; ++nt) cq[nt][sub] = __builtin_amdgcn_mfma_f32_16x16x32_bf16(Ak[sub][1], Bq[nt][1], cq[nt][sub], 0, 0, 0);
    }
    bf16x8 Pf[2][2];
#pragma unroll
    for (int nt = 0; nt < 2; ++nt) {
#pragma unroll
        for (int sub = 0; sub < 4; ++sub) {
#pragma unroll
            for (int r = 0; r < 4; ++r) cq[nt][sub][r] = __builtin_amdgcn_exp2f(cq[nt][sub][r]);
            lsum[nt] += cq[nt][sub]; }
#pragma unroll
        for (int k2 = 0; k2 < 2; ++k2) Pf[nt][k2] = pack8(cq[nt][2 * k2], cq[nt][2 * k2 + 1]);
    }
#pragma unroll
    for (int k2 = 0; k2 < 2; ++k2) {
        const int ra = k2 * 32 + 4 * fq + (fr >> 2), rb = ra + 16;
        const int pa = kv_rowpos(ra, g) * 128, pb = kv_rowpos(rb, g) * 128;
#pragma unroll
        for (int dt = 0; dt < 4; ++dt) { const int c16 = 2 * dt + ((fr & 3) >> 1), sub8 = 8 * (fr & 1);
            const s16x4 va = __builtin_amdgcn_ds_read_tr16_b64_v4i16((LAS s16x4*)(Vb + pa + 16 * (c16 ^ kv_sw(ra)) + sub8));
            const s16x4 vb = __builtin_amdgcn_ds_read_tr16_b64_v4i16((LAS s16x4*)(Vb + pb + 16 * (c16 ^ kv_sw(rb)) + sub8));
            const bf16x8 Av = {va[0], va[1], va[2], va[3], vb[0], vb[1], vb[2], vb[3]};
            ao[0][dt] = __builtin_amdgcn_mfma_f32_16x16x32_bf16(Av, Pf[0][k2], ao[0][dt], 0, 0, 0);
            ao[1][dt] = __builtin_amdgcn_mfma_f32_16x16x32_bf16(Av, Pf[1][k2], ao[1][dt], 0, 0, 0); }
    }
    if (kt + 3 < nt64) asm volatile("s_waitcnt vmcnt(8)" ::: "memory"); else if (kt + 2 < nt64) asm volatile("s_waitcnt vmcnt(4)" ::: "memory"); else asm volatile("s_waitcnt vmcnt(0)" ::: "memory");
    LDS_WAIT(); __builtin_amdgcn_s_barrier(); asm volatile("" ::: "memory");
}

constexpr int Q_P2P_ = MP / 256, Q_PCH_ = NB * 16, Q_P2S_ = 8, Q_PA1_ = 56, Q_SAT_ = DB, Q_SCH_ = DB * 2, Q_PAT_ = NB * (SEQ / 16), Q_SG_ = 2 * (NZ / 256);
constexpr int QB_PCH_ = Q_P2P_, QB_P2S_ = QB_PCH_ + Q_PCH_, QB_PA1_ = QB_P2S_ + Q_P2S_, QB_SAT_ = QB_PA1_ + Q_PA1_, QB_SCH_ = QB_SAT_ + Q_SAT_, QB_PA2_ = QB_SCH_ + Q_SCH_, Q_TOTAL_ = QB_PA2_ + Q_PAT_ - Q_PA1_;
__device__ __forceinline__ int q_pa_index(int it) { return (it >= QB_PA1_ && it < QB_SAT_) ? it - QB_PA1_ : ((it >= QB_PA2_ && it < Q_TOTAL_) ? it - QB_PA2_ + Q_PA1_ : -1); }
constexpr int CW_P1A = 1024, CW_P1B = 1088, CW_P2P = 1152, CW_P2S = 1216, CW_P1X = 1280  ;
constexpr int QI_PITCH = 1040;
__device__ __forceinline__ void attn_prompt_item(Frame& F, const Args& a, int b, int qb, int rep, int staged, unsigned* qctr) {
    int tidv = FTID(F); asm volatile("" : "+v"(tidv));
    const int tid = tidv, lane = tidv & 63, wave = __builtin_amdgcn_readfirstlane(tidv >> 6), fr = lane & 15, fq = lane >> 4;
    const bf16* Z = (const bf16*)(a.ws + WS_Z); const bf16* KN = (const bf16*)(a.ws + WS_KN);
    bf16* OAB = (bf16*)(a.ws + WS_OAB);
    LAS float* S = (LAS float*)(F.lds + L_S); LAS unsigned* BM = (LAS unsigned*)(F.lds + L_SEL);
    const LAS float* BIAS = (const LAS float*)(F.lds + L_BIAS); const LAS unsigned char* LUT = (const LAS unsigned char*)(F.lds + L_LUT);
    const size_t qrow0 = (size_t)b * SEQ + (size_t)qb * 16, krow0 = (size_t)b * SEQ;
    const int ntiles = qb + 1;
    const int g = wave >> 2, qq = wave & 3, head = g * 8 + (fr & 7);
    const int nt64 = (qb * 16 + 16 + 63) >> 6;
    LAS unsigned char* ST = F.lds + L_S;
    unsigned goff[2];
#pragma unroll
    for (int i = 0; i < 2; ++i) { const int o = 2048 * wave + 1024 * i + 16 * lane, row = o >> 7, key = row >> 1, gg = (row & 1) ^ (((key >> 2) ^ (key >> 3)) & 1), c8 = ((o >> 4) & 7) ^ kv_sw(key);
        goff[i] = (unsigned)(key * 128 + gg * 64 + c8 * 8); }
    const unsigned ldsw = 2048u * (unsigned)wave;
    const bf16* kt0 = KN + krow0 * 128; const bf16* vt0 = (const bf16*)(a.ws + WS_VN) + krow0 * 128;
    v4u qraw[2][2]; v2u gwv[2][4];
    const f32x4 g0 = *(const f32x4*)(a.in[I_QG] + fq * 8), g1 = *(const f32x4*)(a.in[I_QG] + fq * 8 + 4), g2 = *(const f32x4*)(a.in[I_QG] + 32 + fq * 8), g3 = *(const f32x4*)(a.in[I_QG] + 36 + fq * 8);
#pragma unroll
    for (int nt = 0; nt < 2; ++nt) { const bf16* zrow = Z + (qrow0 + 4 * qq + 2 * nt + (fr >> 3)) * NZ;
        qraw[nt][0] = *(const v4u*)(zrow + C_Q + head * 64 + fq * 8); qraw[nt][1] = *(const v4u*)(zrow + C_Q + head * 64 + fq * 8 + 32);
#pragma unroll
        for (int dt = 0; dt < 4; ++dt) gwv[nt][dt] = *(const v2u*)(zrow + C_AG + head * 64 + dt * 16 + 4 * fq); }
    {
        bf16x8 Aq[8][2];
        if (staged) { const LAS unsigned char* zq = F.lds + L_HIST + fr * QI_PITCH + fq * 16;
#pragma unroll
          for (int hh = 0; hh < 8; ++hh) { Aq[hh][0] = *(const LAS bf16x8*)(zq + hh * 128); Aq[hh][1] = *(const LAS bf16x8*)(zq + hh * 128 + 64); } }
        else { const bf16* zq = Z + (qrow0 + fr) * NZ + C_QI + fq * 8;
#pragma unroll
          for (int hh = 0; hh < 8; ++hh) { Aq[hh][0] = *(const bf16x8*)(zq + hh * 64); Aq[hh][1] = *(const bf16x8*)(zq + hh * 64 + 32); } }
        float wi[4][8];
#pragma unroll
        for (int r = 0; r < 4; ++r) { const v4u w = *(const v4u*)(Z + (qrow0 + 4 * fq + r) * NZ + C_WI);
            const float sc = 0.04419417382f;
            wi[r][0] = bf_lo(w.x) * sc; wi[r][1] = bf_hi(w.x) * sc; wi[r][2] = bf_lo(w.y) * sc; wi[r][3] = bf_hi(w.y) * sc;
            wi[r][4] = bf_lo(w.z) * sc; wi[r][5] = bf_hi(w.z) * sc; wi[r][6] = bf_lo(w.w) * sc; wi[r][7] = bf_hi(w.w) * sc; }
        const bf16* kbase = (const bf16*)(a.ws + WS_KIN) + krow0 * 64 + (size_t)fr * 64 + fq * 8;
        bf16x8 Bp[4][2];
#pragma unroll
        for (int i = 0; i < 4; ++i) { const int kt = wave + NWAVES * i; if (kt < ntiles) { Bp[i][0] = *(const bf16x8*)(kbase + (size_t)kt * 1024); Bp[i][1] = *(const bf16x8*)(kbase + (size_t)kt * 1024 + 32); } }
        if (!((PROBE_AT & 1) && rep == 1))
        for (int kt0 = wave; kt0 < ntiles; kt0 += 4 * NWAVES) {
#pragma unroll
            for (int i = 0; i < 4; ++i) { const int kt = kt0 + NWAVES * i;
                if (kt < ntiles) {
                    const bf16x8 Bk0 = Bp[i][0], Bk1 = Bp[i][1];
                    const int kn = kt + 4 * NWAVES; if (kn < ntiles) { Bp[i][0] = *(const bf16x8*)(kbase + (size_t)kn * 1024); Bp[i][1] = *(const bf16x8*)(kbase + (size_t)kn * 1024 + 32); }
                    f32x4 sc = {0.f, 0.f, 0.f, 0.f};
#pragma unroll
                    for (int hh = 0; hh < 8; ++hh) { f32x4 c = {0.f, 0.f, 0.f, 0.f};
                        c = __builtin_amdgcn_mfma_f32_16x16x32_bf16(Aq[hh][0], Bk0, c, 0, 0, 0); c = __builtin_amdgcn_mfma_f32_16x16x32_bf16(Aq[hh][1], Bk1, c, 0, 0, 0);
#pragma unroll
                        for (int r = 0; r < 4; ++r) sc[r] += wi[r][hh] * fmaxf(c[r], 0.f); }
#pragma unroll
                    for (int r = 0; r < 4; ++r) S[(4 * fq + r) * SROW + kt * 16 + fr] = sc[r] + 0.0f;
                } }
        }
    }
    __syncthreads();
    unsigned nxt_draw = 0u;
    {
        if (tid == 0) nxt_draw = __hip_atomic_fetch_add(qctr, 1u, RLX_AGENT);
        LAS unsigned* hist = (LAS unsigned*)(F.lds + L_HIST + wave * 2048);
        const int q0 = 2 * wave, n0 = qb * 16 + q0 + 1, n1 = n0 + 1;
        LAS unsigned* bm0 = BM + q0 * BMP; LAS unsigned* bm1 = bm0 + BMP;
        const bool all = n1 <= TOPK;
        unsigned u0[32], u1[32];
        const int nb = (n1 + 511) >> 9;
#pragma unroll
        for (int i = 0; i < 32; ++i) { u0[i] = 0u; u1[i] = 0u; }
        if (!all) {
#pragma unroll
            for (int i = 0; i < 32; ++i) if ((i >> 3) < nb) { const int idx = lane + 64 * i;
                float x0 = S[q0 * SROW + idx], x1 = S[(q0 + 1) * SROW + idx]; asm volatile("" : "+v"(x0), "+v"(x1));
                u0[i] = idx < n0 ? sortable(x0) : 0u; u1[i] = idx < n1 ? sortable(x1) : 0u; }
        }
        LDS_WAIT(); __builtin_amdgcn_s_barrier(); asm volatile("" ::: "memory");
#pragma unroll
        for (int t = 0; t < 3; ++t) if (t < nt64) att_dma(ST + t * 32768 + ldsw, kt0 + (size_t)t * 8192, vt0 + (size_t)t * 8192, goff);
        if ((PROBE_AT & 2) && rep == 1) {} else
        if (all) {
#pragma unroll
            for (int i = 0; i < 4; ++i) { const unsigned long long m0 = __ballot(lane + 64 * i < n0), m1 = __ballot(lane + 64 * i < n1);
                if (lane == 0) { bm0[2 * i] = (unsigned)m0; bm0[2 * i + 1] = (unsigned)(m0 >> 32); bm1[2 * i] = (unsigned)m1; bm1[2 * i + 1] = (unsigned)(m1 >> 32); } }
            if (lane < 56) { bm0[8 + lane] = 0u; bm1[8 + lane] = 0u; }
        } else {
            unsigned pf0 = 0u, pf1 = 0u; int need0 = TOPK, need1 = TOPK, cb0 = 0, cb1 = 0;
            {
                unsigned d0 = 0u, d1 = 0u;
#pragma unroll 1
                for (int bit = 7; bit >= 0; --bit) {
                    const unsigned c0 = (d0 | (1u << bit)) << 24, c1 = (d1 | (1u << bit)) << 24; int k0 = 0, k1 = 0;
#pragma unroll
                    for (int i = 0; i < 32; ++i) if ((i >> 3) < nb) { k0 += __popcll(__ballot(u0[i] >= c0)); k1 += __popcll(__ballot(u1[i] >= c1)); }
                    if (k0 >= TOPK) d0 |= 1u << bit; if (k1 >= TOPK) d1 |= 1u << bit;
                }
                int a0 = 0, a1 = 0; const unsigned e0 = (d0 + 1u) << 24, e1 = (d1 + 1u) << 24;
#pragma unroll
                for (int i = 0; i < 32; ++i) if ((i >> 3) < nb) { a0 += __popcll(__ballot(u0[i] >= e0)); a1 += __popcll(__ballot(u1[i] >= e1)); }
                need0 -= a0; need1 -= a1; pf0 = d0; pf1 = d1;
            }
#pragma unroll 1
            for (int p = 1; p < 4; ++p) {
                const int sh = 24 - 8 * p;
                *(LAS v4u*)(hist + 4 * lane) = (v4u){0u, 0u, 0u, 0u}; *(LAS v4u*)(hist + 256 + 4 * lane) = (v4u){0u, 0u, 0u, 0u};
#pragma unroll
                for (int i = 0; i < 32; ++i) if ((i >> 3) < nb) {
                    const bool m0 = (u0[i] >> (sh + 8)) == pf0, m1 = (u1[i] >> (sh + 8)) == pf1;
                    if (m0) (void)__hip_atomic_fetch_add(hist + ((u0[i] >> sh) & 255u), 1u, __ATOMIC_RELAXED, __HIP_MEMORY_SCOPE_WORKGROUP);
                    if (m1) (void)__hip_atomic_fetch_add(hist + 256 + ((u1[i] >> sh) & 255u), 1u, __ATOMIC_RELAXED, __HIP_MEMORY_SCOPE_WORKGROUP); }
                const v4u c0 = *(const LAS v4u*)(hist + 4 * lane), c1 = *(const LAS v4u*)(hist + 256 + 4 * lane);
                const int ls0 = (int)(c0.x + c0.y + c0.z + c0.w), ls1 = (int)(c1.x + c1.y + c1.z + c1.w);
                int pr0 = ls0, pr1 = ls1;
#define SCAN_STEP(ctrl, rmask) { pr0 += __builtin_amdgcn_update_dpp(0, pr0, ctrl, rmask, 0xF, false); pr1 += __builtin_amdgcn_update_dpp(0, pr1, ctrl, rmask, 0xF, false); }
                SCAN_STEP(0x111, 0xF) SCAN_STEP(0x112, 0xF) SCAN_STEP(0x114, 0xF) SCAN_STEP(0x118, 0xF) SCAN_STEP(0x142, 0xA) SCAN_STEP(0x143, 0xC)
#undef SCAN_STEP
                const int tot0 = __builtin_amdgcn_readlane(pr0, 63), tot1 = __builtin_amdgcn_readlane(pr1, 63);
                const int exc0 = tot0 - pr0, exc1 = tot1 - pr1, inc0 = exc0 + ls0, inc1 = exc1 + ls1;
                const int hl0 = __builtin_ctzll(__ballot(exc0 < need0 && inc0 >= need0)), hl1 = __builtin_ctzll(__ballot(exc1 < need1 && inc1 >= need1));
                int d0, ab0, d1, ab1;
                { int cum = exc0; if (cum + (int)c0.w >= need0) { d0 = 3; ab0 = cum; } else { cum += (int)c0.w; if (cum + (int)c0.z >= need0) { d0 = 2; ab0 = cum; } else { cum += (int)c0.z; if (cum + (int)c0.y >= need0) { d0 = 1; ab0 = cum; } else { cum += (int)c0.y; d0 = 0; ab0 = cum; } } } }
                { int cum = exc1; if (cum + (int)c1.w >= need1) { d1 = 3; ab1 = cum; } else { cum += (int)c1.w; if (cum + (int)c1.z >= need1) { d1 = 2; ab1 = cum; } else { cum += (int)c1.z; if (cum + (int)c1.y >= need1) { d1 = 1; ab1 = cum; } else { cum += (int)c1.y; d1 = 0; ab1 = cum; } } } }
                { const int k0 = d0 == 3 ? (int)c0.w : d0 == 2 ? (int)c0.z : d0 == 1 ? (int)c0.y : (int)c0.x, k1 = d1 == 3 ? (int)c1.w : d1 == 2 ? (int)c1.z : d1 == 1 ? (int)c1.y : (int)c1.x;
                  cb0 = __builtin_amdgcn_readlane(k0, hl0); cb1 = __builtin_amdgcn_readlane(k1, hl1); }
                d0 = __builtin_amdgcn_readlane(d0 + 4 * lane, hl0); ab0 = __builtin_amdgcn_readlane(ab0, hl0); d1 = __builtin_amdgcn_readlane(d1 + 4 * lane, hl1); ab1 = __builtin_amdgcn_readlane(ab1, hl1);
                need0 -= ab0; pf0 = (pf0 << 8) | (unsigned)d0; need1 -= ab1; pf1 = (pf1 << 8) | (unsigned)d1;
            }
            unsigned w0 = 0u, w1 = 0u;
            if (need0 == cb0 && need1 == cb1) {
#pragma unroll
                for (int i = 0; i < 32; ++i) if ((i >> 3) < nb) { const unsigned long long mt0 = __ballot(u0[i] >= pf0), mt1 = __ballot(u1[i] >= pf1);
                    w0 = lane == 2 * i ? (unsigned)mt0 : (lane == 2 * i + 1 ? (unsigned)(mt0 >> 32) : w0); w1 = lane == 2 * i ? (unsigned)mt1 : (lane == 2 * i + 1 ? (unsigned)(mt1 >> 32) : w1); }
            } else {
                int tb0 = 0, tb1 = 0;
#pragma unroll
                for (int i = 0; i < 32; ++i) if ((i >> 3) < nb) {
                    const bool e0 = u0[i] == pf0, e1 = u1[i] == pf1;
                    const unsigned long long me0 = __ballot(e0), me1 = __ballot(e1);
                    const int r0 = tb0 + (int)__builtin_amdgcn_mbcnt_hi((unsigned)(me0 >> 32), __builtin_amdgcn_mbcnt_lo((unsigned)me0, 0u)), r1 = tb1 + (int)__builtin_amdgcn_mbcnt_hi((unsigned)(me1 >> 32), __builtin_amdgcn_mbcnt_lo((unsigned)me1, 0u));
                    const unsigned long long mt0 = __ballot(u0[i] > pf0 || (e0 && r0 < need0)), mt1 = __ballot(u1[i] > pf1 || (e1 && r1 < need1));
                    w0 = lane == 2 * i ? (unsigned)mt0 : (lane == 2 * i + 1 ? (unsigned)(mt0 >> 32) : w0); w1 = lane == 2 * i ? (unsigned)mt1 : (lane == 2 * i + 1 ? (unsigned)(mt1 >> 32) : w1);
                    tb0 += __popcll(me0); tb1 += __popcll(me1);
                }
            }
            bm0[lane] = w0; bm1[lane] = w1;
        }
    }
    __syncthreads();
    {
        bf16x8 Bq[2][2];
        {
#pragma unroll
          for (int nt = 0; nt < 2; ++nt) { const v4u w0 = qraw[nt][0], w1 = qraw[nt][1];
            float x[16] = {bf_lo(w0.x), bf_hi(w0.x), bf_lo(w0.y), bf_hi(w0.y), bf_lo(w0.z), bf_hi(w0.z), bf_lo(w0.w), bf_hi(w0.w),
                           bf_lo(w1.x), bf_hi(w1.x), bf_lo(w1.y), bf_hi(w1.y), bf_lo(w1.z), bf_hi(w1.z), bf_lo(w1.w), bf_hi(w1.w)};
            float ss = 0.f;
#pragma unroll
            for (int j = 0; j < 16; ++j) ss += x[j] * x[j];
            ss += __shfl_xor(ss, 16); ss += __shfl_xor(ss, 32);
            const float rs = (0.125f * 1.44269504089f) / sqrtf(ss * (1.f / 64.f) + NORM_EPS);
            Bq[nt][0] = pack8((f32x4){x[0] * rs * g0[0], x[1] * rs * g0[1], x[2] * rs * g0[2], x[3] * rs * g0[3]}, (f32x4){x[4] * rs * g1[0], x[5] * rs * g1[1], x[6] * rs * g1[2], x[7] * rs * g1[3]});
            Bq[nt][1] = pack8((f32x4){x[8] * rs * g2[0], x[9] * rs * g2[1], x[10] * rs * g2[2], x[11] * rs * g2[3]}, (f32x4){x[12] * rs * g3[0], x[13] * rs * g3[1], x[14] * rs * g3[2], x[15] * rs * g3[3]}); } }
        bf16x8 Bmk[2];
#pragma unroll
        for (int nt = 0; nt < 2; ++nt) { const int jq = 4 * qq + 2 * nt + (fr >> 3) - 8 * fq; v4u w;
            w.x = (jq == 0 ? 0x3F80u : 0u) | (jq == 1 ? 0x3F800000u : 0u); w.y = (jq == 2 ? 0x3F80u : 0u) | (jq == 3 ? 0x3F800000u : 0u);
            w.z = (jq == 4 ? 0x3F80u : 0u) | (jq == 5 ? 0x3F800000u : 0u); w.w = (jq == 6 ? 0x3F80u : 0u) | (jq == 7 ? 0x3F800000u : 0u);
            Bmk[nt] = __builtin_bit_cast(bf16x8, w); }
        att_mask_tile(BM, 0, wave, lane);
        const float m0h = ((const LAS float*)(F.lds + L_M0))[head];
        const float bias_far = BIAS[31 * 16 + head] - m0h;
        f32x4 ao[2][4];
#pragma unroll
        for (int nt = 0; nt < 2; ++nt)
#pragma unroll
            for (int dt = 0; dt < 4; ++dt) ao[nt][dt] = (f32x4){0.f, 0.f, 0.f, 0.f};
        f32x4 lsum[2] = {(f32x4){0.f, 0.f, 0.f, 0.f}, (f32x4){0.f, 0.f, 0.f, 0.f}};
        if (tid == 0) F.MISC[1] = nxt_draw;
        if (nt64 > 2) asm volatile("s_waitcnt vmcnt(8)" ::: "memory"); else if (nt64 > 1) asm volatile("s_waitcnt vmcnt(4)" ::: "memory"); else asm volatile("s_waitcnt vmcnt(0)" ::: "memory");
        LDS_WAIT(); __builtin_amdgcn_s_barrier(); asm volatile("" ::: "memory");
        {
            const int nx = q_pa_index((int)F.MISC[1]);
            if (nx >= 0) { const size_t nrow = (size_t)(nx & 7) * SEQ + (size_t)((SEQ / 16 - 1) - (nx >> 3)) * 16 + 2 * wave;
#pragma unroll
                for (int i = 0; i < 2; ++i) __builtin_amdgcn_global_load_lds((const unsigned*)(Z + (nrow + i) * NZ + C_QI + lane * 8), (LAS unsigned*)(F.lds + L_HIST + (2 * wave + i) * QI_PITCH), 16, 0, 0); }
        }
        int nfar = (qb * 16 - 113 - 63 + 64) >> 6; nfar = nfar < 0 ? 0 : (nfar > nt64 ? nt64 : nfar);
        if (!((PROBE_AT & 4) && rep == 1)) {
#pragma unroll 1
        for (int kt = 0; kt < nfar; ++kt) att_tile<true>(kt, nt64, qb, g, qq, fr, fq, head, bias_far, m0h, ST, BM, BIAS, LUT, kt0, vt0, goff, ldsw, Bq, Bmk, ao, lsum);
#pragma unroll 1
        for (int kt = nfar; kt < nt64; ++kt) att_tile<false>(kt, nt64, qb, g, qq, fr, fq, head, bias_far, m0h, ST, BM, BIAS, LUT, kt0, vt0, goff, ldsw, Bq, Bmk, ao, lsum);
        } else { asm volatile("s_waitcnt vmcnt(0)" ::: "memory"); __syncthreads(); }
#pragma unroll
        for (int nt = 0; nt < 2; ++nt) {
            float l = (lsum[nt][0] + lsum[nt][1]) + (lsum[nt][2] + lsum[nt][3]); l += __shfl_xor(l, 16); l += __shfl_xor(l, 32);
            const float inv = 1.0f / l;
            const size_t qrow = qrow0 + 4 * qq + 2 * nt + (fr >> 3);
#pragma unroll
            for (int dt = 0; dt < 4; ++dt) { const int col = head * 64 + dt * 16 + 4 * fq;
                const v2u gw = gwv[nt][dt];
                const float g0 = bf_lo(gw.x), g1 = bf_hi(gw.x), g2 = bf_lo(gw.y), g3 = bf_hi(gw.y);
                v2u o; o.x = pk2(ao[nt][dt][0] * inv * g0 * sigmoidf_(g0), ao[nt][dt][1] * inv * g1 * sigmoidf_(g1)); o.y = pk2(ao[nt][dt][2] * inv * g2 * sigmoidf_(g2), ao[nt][dt][3] * inv * g3 * sigmoidf_(g3));
                if (!(PROBE_AT && rep == 1)) *(v2u*)(OAB + qrow * (2 * D) + D + col) = o; }
        }
    }
}

template <bool FENCE>
__device__ __forceinline__ void dep_signal(Frame& F, unsigned* ctr) {
    asm volatile("s_waitcnt vmcnt(0)" ::: "memory");
    __syncthreads();
    if (FTID(F) == 0) { if (FENCE) { __builtin_amdgcn_fence(__ATOMIC_RELEASE, "agent"); asm volatile("s_waitcnt vmcnt(0)" ::: "memory"); } (void)xb_add(ctr, 1u); }
}
__device__ __forceinline__ void dep_arrive_xcd(Frame& F, unsigned* xcnt, unsigned* ctr, unsigned x) {
    asm volatile("s_waitcnt vmcnt(0)" ::: "memory");
    __syncthreads();
    if (FTID(F) == 0) { const unsigned nloc = F.MISC[8];
        if (nloc == 0u) { __builtin_amdgcn_fence(__ATOMIC_RELEASE, "agent"); asm volatile("s_waitcnt vmcnt(0)" ::: "memory"); (void)xb_add(ctr, 1u); }
        else if (xb_add(&xcnt[16 * x], 1u) + 1u == nloc) { __builtin_amdgcn_fence(__ATOMIC_RELEASE, "agent"); asm volatile("s_waitcnt vmcnt(0)" ::: "memory"); (void)xb_add(ctr, nloc); } }
}
template <bool ACQ>
__device__ __forceinline__ void dep_wait(Frame& F, unsigned* ctr, unsigned target) {
    if (FTID(F) == 0) { unsigned sp = 0u; while (xb_ld(ctr) < target) { __builtin_amdgcn_s_sleep(2); if (++sp > (1u << 24)) break; }
        if (ACQ) __builtin_amdgcn_fence(__ATOMIC_ACQUIRE, "agent"); }
    __syncthreads();
    asm volatile("" ::: "memory");
}
__device__ __forceinline__ void p3_queue(Frame& F, const Args& a, int rep) {
    { const int tid0 = FTID(F);
    { LAS float* BIAS = (LAS float*)(F.lds + L_BIAS); LAS unsigned char* LUT = (LAS unsigned char*)(F.lds + L_LUT);
      for (int i = tid0; i < 512; i += NWAVES * 64) BIAS[i] = a.in[I_RB][i] * 1.44269504089f;
      for (int d = tid0; d < 2112; d += NWAVES * 64) {
          int b = d;
          if (d >= 16) b = d < 19 ? 16 : d < 21 ? 17 : d < 24 ? 18 : d < 27 ? 19 : d < 31 ? 20 : d < 35 ? 21 : d < 40 ? 22 : d < 46 ? 23 : d < 52 ? 24 : d < 59 ? 25 : d < 67 ? 26 : d < 77 ? 27 : d < 87 ? 28 : d < 99 ? 29 : d < 113 ? 30 : 31;
          LUT[d] = (unsigned char)b; } }
    __syncthreads();
    if (tid0 < 16) {
        float gq = 0.f, gk = 0.f, mb = -INFINITY;
        for (int i = 0; i < 64; ++i) { gq = fmaxf(gq, fabsf(a.in[I_QG][i])); gk = fmaxf(gk, fabsf(a.in[I_KG][i])); }
        for (int b = 0; b < 32; ++b) mb = fmaxf(mb, ((const LAS float*)(F.lds + L_BIAS))[b * 16 + tid0]);
        ((LAS float*)(F.lds + L_M0))[tid0] = 8.f * 1.44269504089f * 1.02f * gq * gk + mb;
    }
    }
    unsigned* qctr = (unsigned*)(F.ctl + CW_QUEUE + 64 * rep);
    unsigned* p1b = (unsigned*)(F.ctl + CW_P1B); unsigned* p2p = (unsigned*)(F.ctl + CW_P2P); unsigned* p2s = (unsigned*)(F.ctl + CW_P2S);
    int okp = 0, oks = 0;
    int pf = -1, staged = 0;
    for (;;) {
        __syncthreads();
        int it;
        if (pf >= 0) it = pf;
        else { if (FTID(F) == 0) F.MISC[0] = __hip_atomic_fetch_add(qctr, 1u, RLX_AGENT);
            __syncthreads();
            it = (int)F.MISC[0]; }
        const int st = staged; pf = -1; staged = 0;
        if (it >= Q_TOTAL_) break;
        const int sub = rep == 0 ? 15 : PROBE_SUB;
        if (it < QB_PCH_) {
            if (rep == 0) { p2_rows(a, it * 256, it * 256 + 256, (it & 7) == 7 ? (it >> 3) : 0, (it & 7) == 7 ? (it >> 3) + 1 : 0, F.wave, NWAVES, FLANE()); dep_signal<false>(F, p2p); } }
        else if (it < QB_P2S_) { if (sub & 1) chain_item(F, a, (it - QB_PCH_) >> 4, (it - QB_PCH_) & 15, rep); }
        else if (it < QB_PA1_) {
            if (rep == 0) { const int j = it - QB_P2S_;
                dep_wait<false>(F, p1b, Q_SG_);
                p2_rows(a, MP + 64 * j, MP + 64 * j + 64, NB + 16 * j, NB + 16 * j + 16, F.wave, NWAVES, FLANE());
                dep_signal<false>(F, p2s); } }
        else if (it >= QB_SAT_ && it < QB_SCH_) { if (sub & 2) { if (!oks) { dep_wait<false>(F, p2s, Q_P2S_); oks = 1; } attn_item<true>(F, a, it - QB_SAT_, 0, rep); } }
        else if (it >= QB_SCH_ && it < QB_PA2_) { const int k = it - QB_SCH_; if (sub & 8) { if (!oks) { dep_wait<false>(F, p2s, Q_P2S_); oks = 1; } sample_chain_item(F, a, k >> 1, k & 1); } }
        else { const int k = q_pa_index(it);
            if (sub & 4) { if (!okp) { dep_wait<false>(F, p2p, Q_P2P_); okp = 1; }
                attn_prompt_item(F, a, k & 7, (SEQ / 16 - 1) - (k >> 3), rep, st, qctr);
                pf = (int)F.MISC[1]; staged = q_pa_index(pf) >= 0 ? 1 : 0; } }
    }
}

template <bool MERGE>
__device__ __forceinline__ void sample_rows_piece(Frame& F, const Args& a, int p) {
    const int lane = FLANE(), wave = F.wave, fr = lane & 15, fq = lane >> 4, tid = wave * 64 + lane;
    const int rt = p >> 4, ct = p & 15, r0 = MP + rt * 32, c0 = ct * 64;
    constexpr int LDA = MERGE ? 2 * D : D, KW = MERGE ? 256 : 128, NKS = KW / 32;
    const bf16* A = (const bf16*)(a.ws + (MERGE ? WS_OAB : WS_MG)) + (size_t)(r0 + fr) * LDA + wave * KW + fq * 8;
    const bf16* B = (const bf16*)(a.ws + (MERGE ? WS_WPAB : WS_WOUT)) + (size_t)(c0 + fr) * LDA + wave * KW + fq * 8;
    bf16x8 Af[2][NKS], Bf[4][NKS];
#pragma unroll
    for (int ks = 0; ks < NKS; ++ks) {
#pragma unroll
        for (int m = 0; m < 2; ++m) Af[m][ks] = *(const bf16x8*)(A + (size_t)m * 16 * LDA + ks * 32);
#pragma unroll
        for (int n = 0; n < 4; ++n) Bf[n][ks] = *(const bf16x8*)(B + (size_t)n * 16 * LDA + ks * 32); }
    f32x4 acc[2][4];
#pragma unroll
    for (int m = 0; m < 2; ++m)
#pragma unroll
        for (int n = 0; n < 4; ++n) acc[m][n] = (f32x4){0.f, 0.f, 0.f, 0.f};
#pragma unroll
    for (int ks = 0; ks < NKS; ++ks)
#pragma unroll
        for (int m = 0; m < 2; ++m)
#pragma unroll
            for (int n = 0; n < 4; ++n) acc[m][n] = __builtin_amdgcn_mfma_f32_16x16x32_bf16(Af[m][ks], Bf[n][ks], acc[m][n], 0, 0, 0);
    LAS float* P = (LAS float*)(F.lds + RING_OFF);
#pragma unroll
    for (int m = 0; m < 2; ++m)
#pragma unroll
        for (int n = 0; n < 4; ++n)
#pragma unroll
            for (int r = 0; r < 4; ++r) P[wave * 2048 + (m * 16 + 4 * fq + r) * 64 + n * 16 + fr] = acc[m][n][r];
    __syncthreads();
    const int row = tid >> 4, c4 = (tid & 15) * 4;
    f32x4 s0 = {0.f, 0.f, 0.f, 0.f}, s1 = {0.f, 0.f, 0.f, 0.f};
#pragma unroll
    for (int w = 0; w < 4; ++w) { s0 += *(const LAS f32x4*)(P + w * 2048 + row * 64 + c4); s1 += *(const LAS f32x4*)(P + (4 + w) * 2048 + row * 64 + c4); }
    if (MERGE) {
        const bf16* zr = (const bf16*)(a.ws + WS_Z) + (size_t)(r0 + row) * NZ + c0 + c4;
        const f32x4 ga = up4(*(const v2u*)(zr + C_GA)), gb = up4(*(const v2u*)(zr + C_GB));
        *(v2u*)((bf16*)(a.ws + WS_MG) + (size_t)(r0 + row) * D + c0 + c4) = dn4(s0 * ga + s1 * gb);
    } else {
        const f32x4 xv = *(const f32x4*)(a.in[I_XS] + (size_t)(r0 - MP + row) * D + c0 + c4);
        *(f32x4*)(a.out + O_Y + (size_t)(r0 + row) * D + c0 + c4) = xv + s0 + s1;
    }
    __syncthreads();
}

__global__ void __launch_bounds__(NWAVES * 64, 2) hybrid_fwd(Args args) {
    extern __shared__ __attribute__((aligned(16))) unsigned char lds[];
    Frame F;
    F.lds = (LAS unsigned char*)lds;
    F.MISC = (volatile LAS unsigned*)(F.lds + L_MISC);
    F.wave = __builtin_amdgcn_readfirstlane((int)threadIdx.x >> 6);
    F.G = gridDim.x; { const int bx = blockIdx.x; F.vcu = (F.G % 8 == 0) ? (bx % 8) * (F.G / 8) + bx / 8 : bx; }
    unsigned char* ws = args.ws;
    F.ctl = (gu32*)(ws + WS_CTL);
    { const int t0 = FTID(F); if (t0 < 32) F.MISC[t0] = 0u; }
    __syncthreads();
    XcdBarrier bar; bar.bar = (unsigned*)(F.ctl + CW_BAR) + args.li * XCD_BAR_WORDS; bar.x = 0; bar.st = nullptr; bar.wave = F.wave;
    if (MK_N_LAUNCHES == 1) bar = xcd_barrier_post((unsigned*)(F.ctl + CW_BAR) + args.li * XCD_BAR_WORDS, F.MISC + 8, F.wave);
    const int lo = args.ph_lo, hi = args.ph_hi;
#define IN(k) (lo <= (k) && (k) < hi)
#define BOTH(k) (IN(k) && IN((k) + 1))
#define GRID_BAR() xcd_barrier<true, false>(bar)

    for (int rep = 0; rep < REPS(0); ++rep)
    if (IN(0)) { p0_prologue(F, args); if (BOTH(0)) GRID_BAR(); }
    for (int rep = 0; rep < REPS(1); ++rep)
    if (IN(1)) {
        pg8::Gemm g{(const bf16*)(ws + WS_XN), (const bf16*)(ws + WS_WIN), M, NZ, D, D, D, nullptr, nullptr}; pg8::StaticOrder S; S.init(MP, NZ, F.G, (int)blockIdx.x);
        EpiZ E{(bf16*)(ws + WS_Z)};
        pg8::gemm_phase<EpiZ, pg8::StaticOrder>(F.lds + RING_OFF, g, S, E, F.wave);
        dep_arrive_xcd(F, (unsigned*)(F.ctl + CW_P1X), (unsigned*)(F.ctl + CW_P1A), bar.x);
        for (int j = (int)blockIdx.x; j < Q_SG_; j += F.G) {
            pg8::OneUnit S1{MP / 256 + j / (NZ / 256), j % (NZ / 256)}; EpiZT<true> E1{(bf16*)(ws + WS_Z)};
            pg8::gemm_phase<EpiZT<true>, pg8::OneUnit>(F.lds + RING_OFF, g, S1, E1, F.wave);
            dep_signal<false>(F, (unsigned*)(F.ctl + CW_P1B));
        }
    }
    for (int rep = 0; rep < REPS(3); ++rep)
    if (IN(3)) { if (rep == 0) dep_wait<false>(F, (unsigned*)(F.ctl + CW_P1A), (unsigned)F.G); p3_queue(F, args, rep); if (BOTH(3)) GRID_BAR(); }
    for (int rep = 0; rep < REPS(4); ++rep)
    if (IN(4)) {
        pg8::Gemm g{(const bf16*)(ws + WS_OAB), (const bf16*)(ws + WS_WPAB), MP, D, D, 2 * D, 2 * D, (const bf16*)(ws + WS_OAB) + D, (const bf16*)(ws + WS_WPAB) + D}; pg8::TwoHalfOrder S; S.init(MP, D, F.G, (int)blockIdx.x);
        EpiMerge E{(const bf16*)(ws + WS_Z), (bf16*)(ws + WS_MG)};
        pg8::gemm_phase<EpiMerge, pg8::TwoHalfOrder>(F.lds + RING_OFF, g, S, E, F.wave);
        for (int p = blockIdx.x; p < 256; p += F.G) sample_rows_piece<true>(F, args, p);
        if ((IN(4) && IN(6)) || rep + 1 < REPS(4)) GRID_BAR();
    }
    for (int rep = 0; rep < REPS(6); ++rep)
    if (IN(6)) {
        pg8::Gemm g{(const bf16*)(ws + WS_MG), (const bf16*)(ws + WS_WOUT), MP, D, D, D, D, nullptr, nullptr}; pg8::StaticOrder S; S.init(MP, D, F.G, (int)blockIdx.x);
        EpiOut E{args.in[I_XP], args.in[I_XS], args.out + O_Y};
        pg8::gemm_phase<EpiOut, pg8::StaticOrder>(F.lds + RING_OFF, g, S, E, F.wave);
        for (int p = blockIdx.x; p < 256; p += F.G) sample_rows_piece<false>(F, args, p);
        if (rep + 1 < REPS(6)) GRID_BAR();
    }
#undef IN
#undef BOTH
}

extern "C" void kernel_launch(void* const* d_in, const int* in_sizes, int n_in, void* d_out, int out_size, void* d_ws, size_t ws_size, hipStream_t stream) {
    static int grid = 0;
    if (grid == 0) {
        if (n_in != 26 || in_sizes[0] != MP * D || (size_t)out_size != O_END || ws_size < WS_END) {
            fprintf(stderr, "kernel_launch: unexpected shapes: n_in %d in0 %d out %d ws %zu (need %zu)\n", n_in, n_in > 0 ? in_sizes[0] : -1, out_size, ws_size, (size_t)WS_END); grid = -1; return; }
        int dev = 0, cus = 0, per_cu = 0;
        if (hipGetDevice(&dev) != hipSuccess || hipDeviceGetAttribute(&cus, hipDeviceAttributeMultiprocessorCount, dev) != hipSuccess) { grid = -1; return; }
        if (hipFuncSetAttribute((const void*)hybrid_fwd, hipFuncAttributeMaxDynamicSharedMemorySize, LDS_BYTES) != hipSuccess) { fprintf(stderr, "kernel_launch: hipFuncSetAttribute failed\n"); grid = -1; return; }
        if (hipOccupancyMaxActiveBlocksPerMultiprocessor(&per_cu, (const void*)hybrid_fwd, NWAVES * 64, LDS_BYTES) != hipSuccess || per_cu < 1) { fprintf(stderr, "kernel_launch: occupancy query says %d blocks per CU\n", per_cu); (void)hipGetLastError(); grid = -1; return; }
        grid = cus;
    }
    if (grid < 0) return;
    (void)hipMemsetAsync((char*)d_ws + WS_CTL, 0, CTL_ZERO_BYTES, stream);
    Args a{};
    for (int i = 0; i < 26; ++i) a.in[i] = (const float*)d_in[i];
    a.out = (float*)d_out; a.ws = (unsigned char*)d_ws;
    constexpr int NPH = 7;
#if MK_N_LAUNCHES == 1
#if defined(PROBE_PRELAUNCH_LO)
    a.ph_lo = PROBE_PRELAUNCH_LO; a.ph_hi = PROBE_PRELAUNCH_HI; a.li = 1;
    hipLaunchKernelGGL(hybrid_fwd, dim3(grid), dim3(NWAVES * 64), LDS_BYTES, stream, a);
#endif
    a.ph_lo = 0; a.ph_hi = NPH; a.li = 0;
    hipLaunchKernelGGL(hybrid_fwd, dim3(grid), dim3(NWAVES * 64), LDS_BYTES, stream, a);
#else
    for (int li = 0; li < NPH; ++li) { a.ph_lo = li; a.ph_hi = li + 1; a.li = 0; hipLaunchKernelGGL(hybrid_fwd, dim3(grid), dim3(NWAVES * 64), LDS_BYTES, stream, a); }
#endif
}
```

```cpp
#include <hip/hip_runtime.h>
#include <cstdio>
#include <cstdint>

#ifndef MK_N_LAUNCHES
#define MK_N_LAUNCHES 1
#endif
#define PROBE_DUP -1
#define PROBE_SUB 15
#define PROBE_SKIPD 0
#define PROBE_PRE2 0
#define PROBE_SEQ2 0
#define PROBE_AT 0
#define PROBE_CH 0
#define PROBE_SKIPA 0
#define PROBE_SA 0
#define PROBE_SKIPC 0
#define REPS(k) (PROBE_DUP == (k) ? 2 : 1)

__device__ __forceinline__ int lane_now() { int l; asm volatile("v_mbcnt_lo_u32_b32 %0, -1, 0\n\tv_mbcnt_hi_u32_b32 %0, -1, %0" : "=v"(l)); return l; }
namespace pg8 {
#define PG8_LAS __attribute__((address_space(3)))
typedef unsigned short bf16_t;
typedef short bf16x8 __attribute__((ext_vector_type(8)));
typedef float f32x4 __attribute__((ext_vector_type(4)));
typedef unsigned u32x4 __attribute__((ext_vector_type(4)));
constexpr int BM = 256, BK = 64, HALF = 128, HTB = HALF * BK * 2  , STAGE_BYTES = 8 * HTB, NXCD = 8, WGM = 8;

__host__ __device__ __forceinline__ int lds_byte(int r, int c) { const int st = (r >> 4) * 2 + (c >> 5), rr = r & 15, cc = c & 31, ob = rr * 64 + cc * 2; return st * 1024 + (ob ^ (((ob >> 9) & 1) << 5)); }
__host__ __device__ __forceinline__ void stage_rc(int b, int& R, int& C) { const int st = b / 1024, sb = b % 1024, swz = sb ^ (((sb >> 9) & 1) << 5); R = (st >> 1) * 16 + swz / 64; C = (st & 1) * 32 + (swz % 64) / 2; }
__host__ __device__ __forceinline__ int perm32(int rho) { const int n = rho >> 4, i = rho & 15; return 8 * (i >> 2) + 4 * n + (i & 3); }

struct Unit { int pm, pn, half; };
struct Gemm { const bf16_t* A; const bf16_t* Bt; int M, N, K, lda, ldb; const bf16_t* A2; const bf16_t* Bt2; };

struct StaticOrder {
    int nM, nN, nwg, G, c;
    __host__ __device__ void init(int M, int N, int G_, int c_) { nM = M / BM; nN = N / BM; nwg = nM * nN; G = G_; c = c_; }
    __host__ __device__ bool next(int i, Unit& u) const {
        const long L = (long)i * G + c; if (L >= nwg) return false;
        int wgid = (int)L; { const int q = nwg / NXCD, r = nwg % NXCD, xcd = wgid % NXCD, off = wgid / NXCD; wgid = (xcd < r ? xcd * (q + 1) : r * (q + 1) + (xcd - r) * q) + off; }
        const int nig = WGM * nN, gid = wgid / nig, fm = gid * WGM, gsz = (nM - fm) < WGM ? (nM - fm) : WGM;
        u.pm = fm + ((wgid % nig) % gsz); u.pn = (wgid % nig) / gsz; u.half = 0; return true;
    }
    __device__ __forceinline__ void a_ready(const Unit&) const {}
    __device__ __forceinline__ void done(const Unit&) const {}
};
struct OneUnit {
    int pm, pn;
    __host__ __device__ bool next(int i, Unit& u) const { if (i != 0) return false; u.pm = pm; u.pn = pn; u.half = 0; return true; }
    __device__ __forceinline__ void a_ready(const Unit&) const {}
    __device__ __forceinline__ void done(const Unit&) const {}
};
struct TwoHalfOrder : StaticOrder {
    __host__ __device__ bool next(int i, Unit& u) const { if (!StaticOrder::next(i >> 1, u)) return false; u.half = i & 1; return true; }
};

__device__ __forceinline__ unsigned cvt_pk_bf16(float lo, float hi) { unsigned r; asm volatile("v_cvt_pk_bf16_f32 %0, %1, %2" : "=v"(r) : "v"(lo), "v"(hi)); return r; }

template <class Epi, class Sched>
__device__ __forceinline__ void gemm_phase(PG8_LAS unsigned char* lds, const Gemm g, const Sched& S, const Epi& E, int wave_) {
    const int wid = wave_, lane = lane_now(), tid = wid * 64 + lane,
              wr = wid >> 2, wc = wid & 3, fr = lane & 15, fq = lane >> 4;
    const int K = g.K, nt = K / BK;
    unsigned voffA[2], voffB[2];
#pragma unroll
    for (int i = 0; i < 2; ++i) { int R, C; stage_rc(tid * 16 + i * 8192, R, C); const int Rb = Epi::PERM ? ((R & ~31) + perm32(R & 31)) : R;
        voffA[i] = (unsigned)(R * g.lda + C) * 2u; voffB[i] = (unsigned)(Rb * g.ldb + C) * 2u; }
    const size_t kstep = (size_t)(BK * 2);
    const size_t hstepA = (size_t)HALF * g.lda * 2, hstepB = (size_t)HALF * g.ldb * 2;
    const size_t tstepA = 2 * hstepA, tstepB = 2 * hstepB;
    const unsigned ldsw = (unsigned)wid * 1024u;
    const int aoff = lds_byte(wr * 64 + fr, fq * 8), boff = lds_byte(wc * 32 + fr, fq * 8);
#define PG8_SA(b, h) (((b) * 2 + (h)) * HTB)
#define PG8_SB(b, h) ((4 + (b) * 2 + (h)) * HTB)
#define PG8_STAGE(bufoff, gbase, voff) do { _Pragma("unroll") for (int _i = 0; _i < 2; ++_i) \
        __builtin_amdgcn_global_load_lds((const unsigned*)((const char*)(gbase) + (voff)[_i]), (PG8_LAS unsigned*)(lds + (bufoff) + ldsw + _i * 8192), 16, 0, 0); } while (0)
#define PG8_LDA(dst, b, h) do { _Pragma("unroll") for (int m = 0; m < 4; ++m) _Pragma("unroll") for (int k = 0; k < 2; ++k) dst[m][k] = *(const PG8_LAS bf16x8*)(lds + PG8_SA(b, h) + aoff + m * 2048 + k * 1024); } while (0)
#define PG8_LDB(dst, b, h) do { _Pragma("unroll") for (int n = 0; n < 2; ++n) _Pragma("unroll") for (int k = 0; k < 2; ++k) dst[n][k] = *(const PG8_LAS bf16x8*)(lds + PG8_SB(b, h) + boff + n * 2048 + k * 1024); } while (0)
#define PG8_MMA(ai, bj, At, Bt) do { __builtin_amdgcn_s_setprio(1); _Pragma("unroll") for (int m = 0; m < 4; ++m) _Pragma("unroll") for (int n = 0; n < 2; ++n) _Pragma("unroll") for (int k = 0; k < 2; ++k) \
        acc[ai][bj][m][n] = __builtin_amdgcn_mfma_f32_16x16x32_bf16(Bt[n][k], At[m][k], acc[ai][bj][m][n], 0, 0, 0); __builtin_amdgcn_s_setprio(0); } while (0)
#define PG8_WAIT_V(n) asm volatile("s_waitcnt vmcnt(" #n ")" ::: "memory")
#define PG8_WAIT_L(n) asm volatile("s_waitcnt lgkmcnt(" #n ")" ::: "memory")
#define PG8_BAR __builtin_amdgcn_s_barrier()
#define PG8_SCHED __builtin_amdgcn_sched_barrier(0)
    Unit cur, nxt; int ui = 0;
    if (!S.next(0, cur)) return;
    f32x4 acc[2][2][4][2];
#pragma unroll
    for (int a = 0; a < 2; ++a)
#pragma unroll
        for (int b = 0; b < 2; ++b)
#pragma unroll
            for (int m = 0; m < 4; ++m)
#pragma unroll
                for (int n = 0; n < 2; ++n) acc[a][b][m][n] = (f32x4){0.f, 0.f, 0.f, 0.f};
    bf16x8 At[4][2], B0[2][2], B1[2][2];
    const char* cA = (const char*)(cur.half ? g.A2 : g.A) + (size_t)cur.pm * tstepA; const char* cB = (const char*)(cur.half ? g.Bt2 : g.Bt) + (size_t)cur.pn * tstepB;
    S.a_ready(cur);
    PG8_STAGE(PG8_SB(0, 0), cB, voffB); PG8_STAGE(PG8_SA(0, 0), cA, voffA); PG8_STAGE(PG8_SB(0, 1), cB + hstepB, voffB); PG8_STAGE(PG8_SA(0, 1), cA + hstepA, voffA);
    if (wr == 1) PG8_BAR;
    PG8_WAIT_V(4); PG8_BAR;
    PG8_STAGE(PG8_SB(1, 0), cB + kstep, voffB); PG8_STAGE(PG8_SA(1, 0), cA + kstep, voffA); PG8_STAGE(PG8_SB(1, 1), cB + hstepB + kstep, voffB);
    PG8_WAIT_V(6); PG8_BAR;
    for (;;) {
        const bool has_next = S.next(ui + 1, nxt);
        const char* nA = has_next ? (const char*)(nxt.half ? g.A2 : g.A) + (size_t)nxt.pm * tstepA : cA; const char* nB = has_next ? (const char*)(nxt.half ? g.Bt2 : g.Bt) + (size_t)nxt.pn * tstepB : cB;
        for (int t = 0; t < nt; t += 2) {
            const bool last = (t == nt - 2);
            const char* a1 = cA + (size_t)(t + 1) * kstep;
            const char* a2 = last ? nA : cA + (size_t)(t + 2) * kstep; const char* b2 = last ? nB : cB + (size_t)(t + 2) * kstep;
            const char* a3 = a2 + kstep; const char* b3 = b2 + kstep;
            if (last && has_next) S.a_ready(nxt);
            PG8_LDB(B0, 0, 0); PG8_SCHED; PG8_LDA(At, 0, 0); PG8_STAGE(PG8_SA(1, 1), a1 + hstepA, voffA);
            PG8_WAIT_L(8); PG8_BAR; PG8_WAIT_L(0); PG8_MMA(0, 0, At, B0); PG8_BAR; PG8_SCHED;
            PG8_LDB(B1, 0, 1); PG8_STAGE(PG8_SB(0, 0), b2, voffB);
            PG8_BAR; PG8_WAIT_L(0); PG8_MMA(0, 1, At, B1); PG8_BAR;
            PG8_LDA(At, 0, 1); PG8_STAGE(PG8_SA(0, 0), a2, voffA);
            PG8_BAR; PG8_WAIT_L(0); PG8_MMA(1, 0, At, B0); PG8_BAR; PG8_SCHED;
            PG8_STAGE(PG8_SB(0, 1), b2 + hstepB, voffB);
            PG8_WAIT_V(6); PG8_BAR; PG8_MMA(1, 1, At, B1); PG8_BAR;
            PG8_LDB(B0, 1, 0); PG8_SCHED; PG8_LDA(At, 1, 0); PG8_STAGE(PG8_SA(0, 1), a2 + hstepA, voffA);
            PG8_WAIT_L(8); PG8_BAR; PG8_WAIT_L(0); PG8_MMA(0, 0, At, B0); PG8_BAR; PG8_SCHED;
            PG8_LDB(B1, 1, 1); PG8_STAGE(PG8_SB(1, 0), b3, voffB);
            PG8_BAR; PG8_WAIT_L(0); PG8_MMA(0, 1, At, B1); PG8_BAR;
            PG8_LDA(At, 1, 1); PG8_STAGE(PG8_SA(1, 0), a3, voffA);
            PG8_BAR; PG8_WAIT_L(0); PG8_MMA(1, 0, At, B0); PG8_BAR; PG8_SCHED;
            PG8_STAGE(PG8_SB(1, 1), b3 + hstepB, voffB);
            PG8_WAIT_V(6); PG8_BAR; PG8_MMA(1, 1, At, B1); PG8_BAR;
        }
        E(acc, cur, wr, wc, fr, fq); S.done(cur);
        if (!has_next) break;
        if (!(Epi::MID && cur.half == 0))
#pragma unroll
        for (int a = 0; a < 2; ++a)
#pragma unroll
            for (int b = 0; b < 2; ++b)
#pragma unroll
                for (int m = 0; m < 4; ++m)
#pragma unroll
                    for (int n = 0; n < 2; ++n) acc[a][b][m][n] = (f32x4){0.f, 0.f, 0.f, 0.f};
        cur = nxt; cA = nA; cB = nB; ++ui;
    }
    PG8_WAIT_V(0);
    if (wr == 0) PG8_BAR;
    PG8_BAR;
#undef PG8_SA
#undef PG8_SB
#undef PG8_STAGE
#undef PG8_LDA
#undef PG8_LDB
#undef PG8_MMA
#undef PG8_WAIT_V
#undef PG8_WAIT_L
#undef PG8_BAR
#undef PG8_SCHED
}
}

constexpr int D = 1024, NB = 8, SEQ = 2048, DB = 128, DS = 4, PAST = 2048, PAGE = 128, NPAGES = 16;
constexpr int MP = NB * SEQ;
constexpr int MS = DB * DS;
constexpr int M = MP + MS;
constexpr int NCOLS = 9160, NZ = 9216;
constexpr int RW_COLS = 4224;
constexpr int C_R = 0, C_K = 1024, C_V = 2048, C_G = 3072, C_WD = 4096, C_AD = 4160;
constexpr int C_Q = 4224, C_AK = 5248, C_AV = 5376, C_QI = 5504, C_KI = 6016, C_AG = 6080, C_GA = 7104, C_GB = 8128, C_WI = 9152;
constexpr int TOPK = 256;
constexpr float NORM_EPS = 1e-6f, LNX_EPS = 64e-5f;

constexpr size_t O_Y = 0;
constexpr size_t O_KP = (size_t)M * D;
constexpr size_t O_VP = O_KP + (size_t)MP * 128;
constexpr size_t O_KIP = O_VP + (size_t)MP * 128;
constexpr size_t O_WKVP = O_KIP + (size_t)MP * 64;
constexpr size_t O_SHP = O_WKVP + (size_t)NB * 16 * 64 * 64;
constexpr size_t O_KS = O_SHP + (size_t)NB * RW_COLS;
constexpr size_t O_VS = O_KS + (size_t)MS * 128;
constexpr size_t O_KIS = O_VS + (size_t)MS * 128;
constexpr size_t O_WKVS = O_KIS + (size_t)MS * 64;
constexpr size_t O_SHS = O_WKVS + (size_t)DB * 16 * 64 * 64;
constexpr size_t O_END = O_SHS + (size_t)DB * RW_COLS;
static_assert(O_END == 32195584, "output size");

constexpr size_t MiB = 1u << 20;
constexpr size_t WS_CTL = 0, CTL_ZERO_BYTES = 64 * 1024;
constexpr size_t WS_WIN = 2 * MiB;
constexpr size_t WS_WPAB = 20 * MiB;
constexpr size_t WS_WOUT = 24 * MiB;
constexpr size_t WS_W2T = 26 * MiB;
constexpr size_t WS_A2T = 26 * MiB + 128 * 1024;
constexpr size_t WS_XN = 32 * MiB;
constexpr size_t WS_Z = 66 * MiB;
constexpr size_t WS_KN = 364 * MiB;
constexpr size_t WS_OAB = 370 * MiB;
constexpr size_t WS_T1 = 436 * MiB;
constexpr size_t WS_MG = 502 * MiB;
constexpr size_t WS_VN = 536 * MiB;
constexpr size_t WS_KIN = 542 * MiB;
constexpr size_t WS_END = 546 * MiB;
constexpr int CW_TMO = 0, CW_QUEUE = 64, CW_BAR = 4096;
static_assert((CW_BAR + 2 * 3456) * 4 <= (int)CTL_ZERO_BYTES, "control words inside the zeroed region");

constexpr int RING_OFF = 0, RING_BYTES = 131072;
constexpr int SROW = 2068;
constexpr int L_S = 0;
constexpr int L_SEL = 132352;
constexpr int L_CNT = L_SEL + 8192;
constexpr int L_HIST = L_CNT + 64;
constexpr int LDS_BYTES = 160 * 1024;
constexpr int L_MISC = LDS_BYTES - 128;
constexpr int L_LUT = L_MISC - 2112;
constexpr int L_BIAS = L_LUT - 2048;
constexpr int L_M0 = L_BIAS - 64;
static_assert(L_HIST + 16 * 1040 <= L_M0, "LDS map");
constexpr int TC = 16;
#define GAS __attribute__((address_space(1)))
#define LAS __attribute__((address_space(3)))
typedef unsigned short bf16;
typedef unsigned v4u __attribute__((ext_vector_type(4)));
typedef unsigned v2u __attribute__((ext_vector_type(2)));
typedef float f32x4 __attribute__((ext_vector_type(4)));
typedef float f32x2 __attribute__((ext_vector_type(2)));
typedef short bf16x8 __attribute__((ext_vector_type(8)));
typedef short s16x4 __attribute__((ext_vector_type(4)));
typedef GAS unsigned gu32;
#define RLX_AGENT __ATOMIC_RELAXED, __HIP_MEMORY_SCOPE_AGENT
#define LDS_WAIT() asm volatile("s_waitcnt lgkmcnt(0)" ::: "memory")
#define VM_WAIT() asm volatile("s_waitcnt vmcnt(0)" ::: "memory")
typedef __bf16 bf16x2_t __attribute__((ext_vector_type(2)));
__device__ __forceinline__ unsigned pk2(float lo, float hi) { const f32x2 v = {lo, hi}; return __builtin_bit_cast(unsigned, __builtin_convertvector(v, bf16x2_t)); }
__device__ __forceinline__ unsigned f2bf(float f) { return pk2(f, 0.f) & 0xffffu; }
__device__ __forceinline__ float bf_lo(unsigned w) { return __builtin_bit_cast(float, w << 16); }
__device__ __forceinline__ float bf_hi(unsigned w) { return __builtin_bit_cast(float, w & 0xffff0000u); }
__device__ __forceinline__ float bf1(bf16 h) { return __builtin_bit_cast(float, (unsigned)h << 16); }
__device__ __forceinline__ float sigmoidf_(float x) { return __builtin_amdgcn_rcpf(1.0f + __expf(-x)); }

#define XB_TMO      128
#define XB_XCNT(j)  (256  + 64 * (j))
#define XB_XSUB(j)  (1280 + 64 * (j))
#define XB_XGEN(j)  (2304 + 64 * (j))
#define XB_TOP      3328
#define XB_TOPGEN   3392
#define XCD_BAR_WORDS 3456
#define XB_SPIN_CAP (1u << 22)
__device__ __forceinline__ unsigned xb_ld(unsigned* p)              { return __hip_atomic_load(p, __ATOMIC_RELAXED, __HIP_MEMORY_SCOPE_AGENT); }
__device__ __forceinline__ unsigned xb_add(unsigned* p, unsigned v) { return __hip_atomic_fetch_add(p, v, __ATOMIC_RELAXED, __HIP_MEMORY_SCOPE_AGENT); }
__device__ __forceinline__ unsigned xb_xcc_id() { return (unsigned)__builtin_amdgcn_s_getreg((3 << 11) | 20) & 0xFu; }
#define XB_SPIN(cond, bar) do { unsigned _sp = 0; while (cond) { __builtin_amdgcn_s_sleep(1); \
    if ((++_sp & 255u) == 0u) { if (xb_ld(&(bar)[XB_TMO])) break; if (_sp > XB_SPIN_CAP) { atomicAdd(&(bar)[XB_TMO], 1u); break; } } } } while (0)
struct XcdBarrier { unsigned* bar; unsigned x; volatile LAS unsigned* st; int wave; };
__device__ __forceinline__ XcdBarrier xcd_barrier_post(unsigned* bar, volatile LAS unsigned* st, int wave) {
    XcdBarrier b; b.bar = bar; b.x = xb_xcc_id(); b.st = st; b.wave = wave;
    if (wave == 0 && lane_now() == 0) (void)xb_add(&bar[XB_XCNT(b.x)], 1u);
    return b;
}
__device__ __forceinline__ void xcd_barrier_complete(unsigned* bar, unsigned x, unsigned& nloc, unsigned& nx) {
    const unsigned G = gridDim.x * gridDim.y * gridDim.z;
    unsigned sum, cnt, mine, sp = 0u;
    for (;;) {
        sum = 0u; cnt = 0u; mine = 0u;
#pragma unroll
        for (unsigned j = 0; j < 16; ++j) { const unsigned c = xb_ld(&bar[XB_XCNT(j)]); sum += c; cnt += (c > 0u) ? 1u : 0u; mine = (j == x) ? c : mine; }
        if (sum == G) break;
        __builtin_amdgcn_s_sleep(1);
        if ((++sp & 255u) == 0u) { if (xb_ld(&bar[XB_TMO])) break; if (sp > XB_SPIN_CAP) { atomicAdd(&bar[XB_TMO], 1u); break; } }
    }
    nloc = mine > 0u ? mine : 1u; nx = cnt > 0u ? cnt : 1u;
}
template <bool FENCE = true, bool ACQ = true>
__device__ __forceinline__ void xcd_barrier(const XcdBarrier& b) {
    asm volatile("s_waitcnt vmcnt(0)" ::: "memory");
    __syncthreads();
    if (b.wave == 0 && lane_now() == 0) {
        unsigned* bar = b.bar;
        __builtin_amdgcn_s_waitcnt(0);
        unsigned nloc = b.st[0], nx = b.st[1];
        if (nloc == 0u) { xcd_barrier_complete(bar, b.x, nloc, nx); b.st[0] = nloc; b.st[1] = nx; }
        const unsigned old = xb_add(&bar[XB_XSUB(b.x)], 1u);
        const unsigned gen = old / nloc;
        if (old + 1u == (gen + 1u) * nloc) {
            if (FENCE) __builtin_amdgcn_fence(__ATOMIC_RELEASE, "agent");
            asm volatile("s_waitcnt vmcnt(0)" ::: "memory");
            const unsigned og = xb_add(&bar[XB_TOP], 1u);
            const unsigned tg = og / nx;
            if (og + 1u == (tg + 1u) * nx) xb_add(&bar[XB_TOPGEN], 1u);
            else XB_SPIN(xb_ld(&bar[XB_TOPGEN]) == tg, bar);
            if (ACQ) __builtin_amdgcn_fence(__ATOMIC_ACQUIRE, "agent"); else asm volatile("" ::: "memory");
            xb_add(&bar[XB_XGEN(b.x)], 1u);
            asm volatile("s_waitcnt vmcnt(0)" ::: "memory");
        } else {
            XB_SPIN(xb_ld(&bar[XB_XGEN(b.x)]) == gen, bar);
            if (ACQ) __builtin_amdgcn_fence(__ATOMIC_ACQUIRE, "agent"); else asm volatile("" ::: "memory");
            asm volatile("s_waitcnt vmcnt(0)" ::: "memory");
        }
    }
    __syncthreads();
}

constexpr int NWAVES = 8;
struct Args { const float* in[26]; float* out; unsigned char* ws; int ph_lo, ph_hi, li, pad; };
enum { I_XP = 0, I_XS, I_CK, I_CV, I_CKI, I_SWKV, I_SSH, I_PT, I_NG, I_WIN, I_MU, I_W0, I_W2, I_A0, I_A2, I_KK, I_KA, I_RK, I_LG, I_LB, I_QG, I_KG, I_RB, I_WPA, I_WPB, I_WOUT };

struct Frame {
    LAS unsigned char* lds;
    volatile LAS unsigned* MISC;
    gu32* ctl;
    int wave, vcu, G;
};
#define FTID(F_) ((F_).wave * 64 + lane_now())
#define FLANE() lane_now()

__device__ __forceinline__ float wave_sum(float v) {
#pragma unroll
    for (int o = 1; o < 64; o <<= 1) v += __shfl_xor(v, o);
    return v;
}

__device__ __forceinline__ int win_src_col(int n) { return n < C_AG ? n : (n < C_WI ? n + 8 : (n < NCOLS ? n - C_WI + 6080 : -1)); }
__device__ __forceinline__ void p0_transpose_item(const float* W, int ldw, bool remap, bf16* WT, int ldd, int dcol0, int nblk, LAS float* scr, int item, int lane) {
    const int kb = item / nblk, nb = item % nblk, k0 = 64 * kb, n0 = 32 * nb;
    const int nsrc = remap ? win_src_col(n0 + (lane & 31)) : n0 + (lane & 31);
    const float* wp = W + (size_t)(k0 + (lane >> 5)) * ldw + (nsrc < 0 ? 0 : nsrc);
    float wv[32];
#pragma unroll
    for (int i = 0; i < 32; ++i) { wv[i] = wp[(size_t)(2 * i) * ldw]; }
#pragma unroll
    for (int i = 0; i < 32; ++i) { const int kk = 2 * i + (lane >> 5); scr[kk * 33 + (lane & 31)] = nsrc >= 0 ? wv[i] : 0.f; }
    LDS_WAIT(); asm volatile("" ::: "memory");
    const int c = lane & 7;
#pragma unroll
    for (int j = 0; j < 4; ++j) { const int n = (lane >> 3) + 8 * j; const LAS float* s = scr + (8 * c) * 33 + n;
        v4u o; o.x = pk2(s[0 * 33], s[1 * 33]); o.y = pk2(s[2 * 33], s[3 * 33]); o.z = pk2(s[4 * 33], s[5 * 33]); o.w = pk2(s[6 * 33], s[7 * 33]);
        *(GAS v4u*)(WT + (size_t)(n0 + n) * ldd + dcol0 + k0 + 8 * c) = o; }
    LDS_WAIT(); asm volatile("" ::: "memory");
}
__device__ __forceinline__ void p0_prologue(Frame& F, const Args& a) {
    const int lane0 = FLANE();
    LAS float* scr = (LAS float*)(F.lds + RING_OFF + F.wave * 16384);
    const int gw = F.vcu * NWAVES + F.wave, NGW = F.G * NWAVES;
    unsigned char* ws = a.ws;
    constexpr int I_IN = (D / 64) * (NZ / 32), I_SQ = (D / 64) * (D / 32), I_LR = (D / 32);
    constexpr int NITEMS = I_IN + 3 * I_SQ + 2 * I_LR;
    for (int it = gw; it < NITEMS; it += NGW) {
        int r = it;
        if (r < I_IN) { p0_transpose_item(a.in[I_WIN], NCOLS, true, (bf16*)(ws + WS_WIN), D, 0, NZ / 32, scr, r, lane0); continue; } r -= I_IN;
        if (r < I_SQ) { p0_transpose_item(a.in[I_WPA], D, false, (bf16*)(ws + WS_WPAB), 2 * D, 0, D / 32, scr, r, lane0); continue; } r -= I_SQ;
        if (r < I_SQ) { p0_transpose_item(a.in[I_WPB], D, false, (bf16*)(ws + WS_WPAB), 2 * D, D, D / 32, scr, r, lane0); continue; } r -= I_SQ;
        if (r < I_SQ) { p0_transpose_item(a.in[I_WOUT], D, false, (bf16*)(ws + WS_WOUT), D, 0, D / 32, scr, r, lane0); continue; } r -= I_SQ;
        if (r < I_LR) { p0_transpose_item(a.in[I_W2], D, false, (bf16*)(ws + WS_W2T), 64, 0, D / 32, scr, r, lane0); continue; } r -= I_LR;
        p0_transpose_item(a.in[I_A2], D, false, (bf16*)(ws + WS_A2T), 64, 0, D / 32, scr, r, lane0);
    }
    const GAS f32x4* g4 = (const GAS f32x4*)a.in[I_NG] + lane0;
    f32x4 gv[4];
#pragma unroll
    for (int j = 0; j < 4; ++j) gv[j] = g4[64 * j];
    for (int m0 = gw; m0 < M; m0 += 4 * NGW) {
        f32x4 v[4][4];
#pragma unroll
        for (int k = 0; k < 4; ++k) { const int m = m0 + k * NGW;
            if (m < M) { const float* xrow = m < MP ? a.in[I_XP] + (size_t)m * D : a.in[I_XS] + (size_t)(m - MP) * D; const GAS f32x4* xr = (const GAS f32x4*)xrow + lane0;
#pragma unroll
                for (int j = 0; j < 4; ++j) v[k][j] = xr[64 * j]; } }
#pragma unroll
        for (int k = 0; k < 4; ++k) { const int m = m0 + k * NGW;
            if (m < M) {
                float s = 0.f;
#pragma unroll
                for (int j = 0; j < 4; ++j) s += (v[k][j].x * v[k][j].x + v[k][j].y * v[k][j].y) + (v[k][j].z * v[k][j].z + v[k][j].w * v[k][j].w);
                const float rs = 1.f / sqrtf(wave_sum(s) * (1.f / D) + NORM_EPS);
                GAS unsigned long long* o8 = (GAS unsigned long long*)((bf16*)(ws + WS_XN) + (size_t)m * D) + lane0;
#pragma unroll
                for (int j = 0; j < 4; ++j) { const f32x4 y = v[k][j] * rs * gv[j]; o8[64 * j] = (unsigned long long)pk2(y.x, y.y) | ((unsigned long long)pk2(y.z, y.w) << 32); }
            } }
    }
}

#define ST_AGENT32(p_, v_) __hip_atomic_store((unsigned*)(p_), __builtin_bit_cast(unsigned, (v_)), __ATOMIC_RELAXED, __HIP_MEMORY_SCOPE_AGENT)
#define ST_AGENT64(p_, v_) __hip_atomic_store((unsigned long long*)(p_), __builtin_bit_cast(unsigned long long, (v_)), __ATOMIC_RELAXED, __HIP_MEMORY_SCOPE_AGENT)
#define ST_AGENT128(p_, v_) asm volatile("global_store_dwordx4 %0, %1, off sc1\n\ts_nop 1" :: "v"(p_), "v"(v_) : "memory")

template <bool WT>
struct EpiZT {
    static constexpr bool PERM = true, MID = false;
    bf16* O;
    __device__ __forceinline__ void operator()(const f32x4 (&acc)[2][2][4][2], const pg8::Unit& u, int wr, int wc, int fr, int fq) const {
        const int row0 = u.pm * 256 + wr * 64 + fr, col0 = u.pn * 256 + wc * 32 + 8 * fq;
#pragma unroll
        for (int ai = 0; ai < 2; ++ai)
#pragma unroll
            for (int m = 0; m < 4; ++m) { bf16* rowp = O + (size_t)(row0 + ai * 128 + m * 16) * NZ + col0;
#pragma unroll
                for (int bj = 0; bj < 2; ++bj) { f32x4 v0 = acc[ai][bj][m][0], v1 = acc[ai][bj][m][1];
                    const int cb = u.pn * 256 + bj * 128 + wc * 32;
                    if (cb >= C_GA && cb < C_WI) {
#pragma unroll
                        for (int e = 0; e < 4; ++e) { v0[e] = sigmoidf_(v0[e]); v1[e] = sigmoidf_(v1[e]); } }
                    v4u w; w.x = pg8::cvt_pk_bf16(v0[0], v0[1]); w.y = pg8::cvt_pk_bf16(v0[2], v0[3]); w.z = pg8::cvt_pk_bf16(v1[0], v1[1]); w.w = pg8::cvt_pk_bf16(v1[2], v1[3]);
                    if (WT) ST_AGENT128(rowp + bj * 128, w); else *(v4u*)(rowp + bj * 128) = w; } }
    }
};
typedef EpiZT<false> EpiZ;
struct EpiMerge {
    static constexpr bool PERM = true, MID = true;
    const bf16* Zb; bf16* O;
    __device__ __forceinline__ void operator()(f32x4 (&acc)[2][2][4][2], const pg8::Unit& u, int wr, int wc, int fr, int fq) const {
        const int row0 = u.pm * 256 + wr * 64 + fr, col0 = u.pn * 256 + wc * 32 + 8 * fq;
        if (u.half == 0) {
#pragma unroll
            for (int ai = 0; ai < 2; ++ai)
#pragma unroll
                for (int m = 0; m < 4; ++m) { const bf16* zr = Zb + (size_t)(row0 + ai * 128 + m * 16) * NZ + col0;
#pragma unroll
                    for (int bj = 0; bj < 2; ++bj) { const v4u ga = *(const v4u*)(zr + C_GA + bj * 128), gb = *(const v4u*)(zr + C_GB + bj * 128);
#define RT_(a_, b_) ((a_) * __builtin_amdgcn_rcpf(b_))
                        f32x4& v0 = acc[ai][bj][m][0]; f32x4& v1 = acc[ai][bj][m][1];
                        v0[0] *= RT_(bf_lo(ga.x), bf_lo(gb.x)); v0[1] *= RT_(bf_hi(ga.x), bf_hi(gb.x)); v0[2] *= RT_(bf_lo(ga.y), bf_lo(gb.y)); v0[3] *= RT_(bf_hi(ga.y), bf_hi(gb.y));
                        v1[0] *= RT_(bf_lo(ga.z), bf_lo(gb.z)); v1[1] *= RT_(bf_hi(ga.z), bf_hi(gb.z)); v1[2] *= RT_(bf_lo(ga.w), bf_lo(gb.w)); v1[3] *= RT_(bf_hi(ga.w), bf_hi(gb.w));
#undef RT_
                    } }
        } else {
#pragma unroll
            for (int ai = 0; ai < 2; ++ai)
#pragma unroll
                for (int m = 0; m < 4; ++m) { const size_t row = (size_t)(row0 + ai * 128 + m * 16);
#pragma unroll
                    for (int bj = 0; bj < 2; ++bj) { const v4u gz = *(const v4u*)(Zb + row * NZ + C_GB + col0 + bj * 128);
                        const f32x4 v0 = acc[ai][bj][m][0], v1 = acc[ai][bj][m][1];
                        v4u w; w.x = pg8::cvt_pk_bf16(v0[0] * bf_lo(gz.x), v0[1] * bf_hi(gz.x)); w.y = pg8::cvt_pk_bf16(v0[2] * bf_lo(gz.y), v0[3] * bf_hi(gz.y));
                        w.z = pg8::cvt_pk_bf16(v1[0] * bf_lo(gz.z), v1[1] * bf_hi(gz.z)); w.w = pg8::cvt_pk_bf16(v1[2] * bf_lo(gz.w), v1[3] * bf_hi(gz.w));
                        *(v4u*)(O + row * D + col0 + bj * 128) = w; } }
        }
    }
};
struct EpiOut {
    static constexpr bool PERM = false, MID = false;
    const float* xp; const float* xs; float* Y;
    __device__ __forceinline__ void operator()(const f32x4 (&acc)[2][2][4][2], const pg8::Unit& u, int wr, int wc, int fr, int fq) const {
        const int row0 = u.pm * 256 + wr * 64 + fr, col0 = u.pn * 256 + wc * 32 + 4 * fq;
        const float* xb = u.pm < MP / 256 ? xp : xs - (size_t)MP * D;
#pragma unroll
        for (int ai = 0; ai < 2; ++ai)
#pragma unroll
            for (int m = 0; m < 4; ++m) { const size_t off = (size_t)(row0 + ai * 128 + m * 16) * D + col0;
#pragma unroll
                for (int bj = 0; bj < 2; ++bj)
#pragma unroll
                    for (int n = 0; n < 2; ++n) { const f32x4 xv = *(const f32x4*)(xb + off + bj * 128 + n * 16); *(f32x4*)(Y + off + bj * 128 + n * 16) = xv + acc[ai][bj][m][n]; } }
    }
};

__device__ __forceinline__ void p2_rows(const Args& a, int mbeg, int mend, int rbeg, int rend, int gw, int NGW, int lane) {
    const bf16* Z = (const bf16*)(a.ws + WS_Z); bf16* KN = (bf16*)(a.ws + WS_KN); bf16* VN = (bf16*)(a.ws + WS_VN); bf16* KIN = (bf16*)(a.ws + WS_KIN);
    const float kg0 = a.in[I_KG][(lane & 31) * 2], kg1 = a.in[I_KG][(lane & 31) * 2 + 1];
    for (int m0 = mbeg + gw; m0 < mend; m0 += 9 * NGW) {
        unsigned kw4[9], vw4[9]; bf16 ki4[9];
#pragma unroll
        for (int k = 0; k < 9; ++k) { const int m = m0 + k * NGW;
            if (m < mend) { const bf16* zr = Z + (size_t)m * NZ; kw4[k] = *(const unsigned*)(zr + C_AK + 2 * lane); vw4[k] = *(const unsigned*)(zr + C_AV + 2 * lane); ki4[k] = zr[C_KI + lane]; } }
#pragma unroll
        for (int k = 0; k < 9; ++k) { const int m = m0 + k * NGW;
            if (m < mend) {
                float* ok = m < MP ? a.out + O_KP + (size_t)m * 128 : a.out + O_KS + (size_t)(m - MP) * 128;
                float* ov = m < MP ? a.out + O_VP + (size_t)m * 128 : a.out + O_VS + (size_t)(m - MP) * 128;
                float* oi = m < MP ? a.out + O_KIP + (size_t)m * 64 : a.out + O_KIS + (size_t)(m - MP) * 64;
                const float k0 = bf_lo(kw4[k]), k1 = bf_hi(kw4[k]);
                float s = k0 * k0 + k1 * k1;
#pragma unroll
                for (int o = 1; o < 32; o <<= 1) s += __shfl_xor(s, o);
                const float rs = 1.f / sqrtf(s * (1.f / 64.f) + NORM_EPS);
                const float y0 = k0 * rs * kg0, y1 = k1 * rs * kg1;
                ST_AGENT64(ok + 2 * lane, ((f32x2){y0, y1}));
                ST_AGENT32(KN + (size_t)m * 128 + 2 * lane, pk2(y0, y1));
                ST_AGENT64(ov + 2 * lane, ((f32x2){bf_lo(vw4[k]), bf_hi(vw4[k])}));
                ST_AGENT32(VN + (size_t)m * 128 + 2 * lane, vw4[k]);
                ST_AGENT32(oi + lane, bf1(ki4[k])); __hip_atomic_store((unsigned short*)(KIN + (size_t)m * 64 + lane), (unsigned short)ki4[k], __ATOMIC_RELAXED, __HIP_MEMORY_SCOPE_AGENT);
            } }
    }
    for (int r = rbeg + gw; r < rend; r += NGW) {
        const size_t m = r < NB ? (size_t)r * SEQ + SEQ - 1 : (size_t)MP + (size_t)(r - NB) * DS + DS - 1;
        const bf16* zr = Z + m * NZ; float* os = r < NB ? a.out + O_SHP + (size_t)r * RW_COLS : a.out + O_SHS + (size_t)(r - NB) * RW_COLS;
        unsigned w[33];
#pragma unroll
        for (int i = 0; i < 33; ++i) w[i] = *(const unsigned*)(zr + 2 * lane + 128 * i);
#pragma unroll
        for (int i = 0; i < 33; ++i) *(f32x2*)(os + 2 * lane + 128 * i) = (f32x2){bf_lo(w[i]), bf_hi(w[i])};
    }
}

#define DPP_ADD(x, ctrl) (x) += __builtin_bit_cast(float, __builtin_amdgcn_mov_dpp(__builtin_bit_cast(int, (x)), (ctrl), 0xF, 0xF, true))
__device__ __forceinline__ float sum8(float x) { DPP_ADD(x, 0xB1); DPP_ADD(x, 0x4E); DPP_ADD(x, 0x141); return x; }
__device__ __forceinline__ float half_sum(float v) {
#pragma unroll
    for (int o = 1; o < 32; o <<= 1) v += __shfl_xor(v, o);
    return v;
}

__device__ __forceinline__ float wsum(float x) {
    DPP_ADD(x, 0xB1); DPP_ADD(x, 0x4E); DPP_ADD(x, 0x141); DPP_ADD(x, 0x140);
    const int xi = __builtin_bit_cast(int, x);
    return (__builtin_bit_cast(float, __builtin_amdgcn_readlane(xi, 0)) + __builtin_bit_cast(float, __builtin_amdgcn_readlane(xi, 16)))
         + (__builtin_bit_cast(float, __builtin_amdgcn_readlane(xi, 32)) + __builtin_bit_cast(float, __builtin_amdgcn_readlane(xi, 48)));
}
__device__ __forceinline__ float fast_tanh(float x) { const float e = __expf(2.f * x); return 1.f - 2.f * __builtin_amdgcn_rcpf(e + 1.f); }

__device__ __forceinline__ bf16x8 pack8(const f32x4 lo, const f32x4 hi) {
    v4u w; w.x = pk2(lo[0], lo[1]); w.y = pk2(lo[2], lo[3]); w.z = pk2(hi[0], hi[1]); w.w = pk2(hi[2], hi[3]); return __builtin_bit_cast(bf16x8, w);
}
__device__ __forceinline__ unsigned sortable(float x) { const unsigned b = __builtin_bit_cast(unsigned, x); return b ^ ((b >> 31) ? 0xFFFFFFFFu : 0x80000000u); }
constexpr int PA = 136, PS = 160, PY = 72;
constexpr int CR_A = 0, CR_B = 16 * PA, CR_P = 32 * PA, CR_YO = CR_P  , CR_BN = CR_YO + 64 * PY, CR_KS = CR_BN + 16 * PS, CR_VS = CR_KS + 16 * PS, CR_GC = CR_VS + 16 * PS, CR_BYTES = CR_GC + 256;
constexpr int LC_CS = 8 * CR_BYTES, LC_XS = LC_CS + 13 * 256, CS_SAMPLE = 11 * 256;
static_assert(CR_BYTES == 16896 && LC_XS + 16384 <= L_M0 && LC_CS + 8 * CS_SAMPLE <= L_M0, "chain LDS map");
enum { CS_MU = 0  , CS_KK = 6, CS_KA = 7, CS_RK = 8, CS_W0 = 9, CS_A0 = 10, CS_LG = 11, CS_LB = 12 };

__device__ __forceinline__ float rowsum16(float x) { DPP_ADD(x, 0xB1); DPP_ADD(x, 0x4E); DPP_ADD(x, 0x141); DPP_ADD(x, 0x140); return x; }
__device__ __forceinline__ f32x4 up4(v2u w) { return (f32x4){bf_lo(w.x), bf_hi(w.x), bf_lo(w.y), bf_hi(w.y)}; }
__device__ __forceinline__ v2u dn4(f32x4 v) { v2u w; w.x = pk2(v[0], v[1]); w.y = pk2(v[2], v[3]); return w; }
__device__ __forceinline__ bf16x8 pk4z(f32x4 v) { v4u w; w.x = pk2(v[0], v[1]); w.y = pk2(v[2], v[3]); w.z = 0u; w.w = 0u; return __builtin_bit_cast(bf16x8, w); }
__device__ __forceinline__ bf16x8 cat8(v2u lo, v2u hi) { v4u w; w.x = lo.x; w.y = lo.y; w.z = hi.x; w.w = hi.y; return __builtin_bit_cast(bf16x8, w); }
__device__ __forceinline__ f32x4 exp4(f32x4 v) { return (f32x4){__expf(v[0]), __expf(v[1]), __expf(v[2]), __expf(v[3])}; }
__device__ __forceinline__ f32x4 sig4(f32x4 v) { return (f32x4){sigmoidf_(v[0]), sigmoidf_(v[1]), sigmoidf_(v[2]), sigmoidf_(v[3])}; }
#define MFMA16(A_, B_, C_) __builtin_amdgcn_mfma_f32_16x16x32_bf16((A_), (B_), (C_), 0, 0, 0)
#define ZERO4 ((f32x4){0.f, 0.f, 0.f, 0.f})

__device__ __forceinline__ void wkv_load_raw(v2u (&raw)[5][6], const bf16* Z, size_t row0, int T, int tc0, int h, bool sample, const float* shift_row, int fr, int fq) {
    const int segcol[6] = {C_R + h * 64, C_K + h * 64, C_V + h * 64, C_G + h * 64, C_WD, C_AD};
#pragma unroll
    for (int k = 0; k < 5; ++k) { int tg = tc0 + 4 * fq + k - 1; const bool first = tg < 0; tg = tg < 0 ? 0 : (tg >= T ? T - 1 : tg); const bf16* zr = Z + (row0 + tg) * NZ + 4 * fr;
#pragma unroll
        for (int s = 0; s < 6; ++s) {
            if (first) { if (sample) { const f32x4 x = *(const f32x4*)(shift_row + segcol[s] + 4 * fr); raw[k][s] = dn4(x); } else raw[k][s] = (v2u){0u, 0u}; }
            else raw[k][s] = *(const v2u*)(zr + segcol[s]); } }
}

template <bool GLOBALW>
__device__ __forceinline__ void wkv_pre(LAS unsigned char* R, const LAS float* CS, const LAS unsigned char* W2l, const LAS unsigned char* A2l, const bf16* W2g, const bf16* A2g, const v2u (&raw)[5][6], int tvalid, v2u (&vkp)[4], v2u (&gkp)[4], float (&bon)[4], int fr, int fq) {
    f32x4 zk[4];
    {
        f32x4 mu[6];
#pragma unroll
        for (int s = 0; s < 6; ++s) mu[s] = *(const LAS f32x4*)(CS + (CS_MU + s) * 64 + 4 * fr);
#pragma unroll
        for (int r = 0; r < 4; ++r) {
            f32x4 z[6];
#pragma unroll
            for (int s = 0; s < 6; ++s) { const f32x4 cur = up4(raw[r + 1][s]), prv = up4(raw[r][s]); z[s] = cur + (prv - cur) * mu[s]; }
            zk[r] = z[1]; vkp[r] = dn4(z[2]); gkp[r] = dn4(z[3]);
            *(LAS f32x2*)(R + CR_KS + (4 * fq + r) * PS + 8 * fr) = (f32x2){z[0][0], z[0][1]}; *(LAS f32x2*)(R + CR_VS + (4 * fq + r) * PS + 8 * fr) = (f32x2){z[0][2], z[0][3]};
            const f32x4 zw = {fast_tanh(z[4][0]), fast_tanh(z[4][1]), fast_tanh(z[4][2]), fast_tanh(z[4][3])};
            *(LAS v2u*)(R + CR_A + (4 * fq + r) * PA + 8 * fr) = dn4(zw); *(LAS v2u*)(R + CR_B + (4 * fq + r) * PA + 8 * fr) = dn4(z[5]);
        }
#pragma unroll
        for (int r = 0; r < 4; ++r) asm volatile("" : "+v"(zk[r]), "+v"(vkp[r]), "+v"(gkp[r]));
    }
    f32x4 lw[4], av[4];
    {
        const bf16x8 Aw0 = *(const LAS bf16x8*)(R + CR_A + fr * PA + fq * 16), Aw1 = *(const LAS bf16x8*)(R + CR_A + fr * PA + 64 + fq * 16);
        const bf16x8 Aa0 = *(const LAS bf16x8*)(R + CR_B + fr * PA + fq * 16), Aa1 = *(const LAS bf16x8*)(R + CR_B + fr * PA + 64 + fq * 16);
        f32x4 cw[4], ca[4];
#pragma unroll
        for (int nt = 0; nt < 4; ++nt) {
            bf16x8 Bw0, Bw1, Ba0, Ba1;
            if (GLOBALW) { const bf16* w2 = W2g + (size_t)(4 * fr + nt) * 64 + fq * 8; const bf16* a2 = A2g + (size_t)(4 * fr + nt) * 64 + fq * 8;
                Bw0 = *(const bf16x8*)w2; Bw1 = *(const bf16x8*)(w2 + 32); Ba0 = *(const bf16x8*)a2; Ba1 = *(const bf16x8*)(a2 + 32); }
            else { const LAS unsigned char* w2 = W2l + (4 * fr + nt) * 128; const LAS unsigned char* a2 = A2l + (4 * fr + nt) * 128;
                Bw0 = *(const LAS bf16x8*)(w2 + 16 * (fq ^ (fr & 7))); Bw1 = *(const LAS bf16x8*)(w2 + 16 * ((4 + fq) ^ (fr & 7)));
                Ba0 = *(const LAS bf16x8*)(a2 + 16 * (fq ^ (fr & 7))); Ba1 = *(const LAS bf16x8*)(a2 + 16 * ((4 + fq) ^ (fr & 7))); }
            cw[nt] = MFMA16(Aw0, Bw0, ZERO4); cw[nt] = MFMA16(Aw1, Bw1, cw[nt]);
            ca[nt] = MFMA16(Aa0, Ba0, ZERO4); ca[nt] = MFMA16(Aa1, Ba1, ca[nt]);
        }
        const f32x4 w0 = *(const LAS f32x4*)(CS + CS_W0 * 64 + 4 * fr), a0 = *(const LAS f32x4*)(CS + CS_A0 * 64 + 4 * fr);
#pragma unroll
        for (int r = 0; r < 4; ++r) { const f32x4 dw = {cw[0][r], cw[1][r], cw[2][r], cw[3][r]}, da = {ca[0][r], ca[1][r], ca[2][r], ca[3][r]};
            lw[r] = sig4(w0 + dw) * (-0.6065306597f); av[r] = sig4(a0 + da); }
    }
    f32x4 cl[4];
    {
#pragma unroll
        for (int r = 0; r < 4; ++r) if (4 * fq + r >= tvalid) lw[r] = ZERO4;
        f32x4 c[4]; c[0] = lw[0]; c[1] = c[0] + lw[1]; c[2] = c[1] + lw[2]; c[3] = c[2] + lw[3];
        f32x4 e = ZERO4;
#pragma unroll
        for (int j = 0; j < 4; ++j) { const float t1 = __shfl_up(c[3][j], 16), t2 = __shfl_up(c[3][j], 32), t3 = __shfl_up(c[3][j], 48); e[j] = (fq >= 1 ? t1 : 0.f) + (fq >= 2 ? t2 : 0.f) + (fq >= 3 ? t3 : 0.f); }
#pragma unroll
        for (int r = 0; r < 4; ++r) cl[r] = c[r] + e;
        if (fq == 3) *(LAS f32x4*)(R + CR_GC + 16 * fr) = exp4(cl[3]);
    }
    {
        const f32x4 kkc = *(const LAS f32x4*)(CS + CS_KK * 64 + 4 * fr), kac = *(const LAS f32x4*)(CS + CS_KA * 64 + 4 * fr), rkc = *(const LAS f32x4*)(CS + CS_RK * 64 + 4 * fr);
#pragma unroll
        for (int r = 0; r < 4; ++r) {
            const bool ok = 4 * fq + r < tvalid;
            const f32x4 kk = zk[r] * kkc; const float ss = rowsum16((kk[0] * kk[0] + kk[1] * kk[1]) + (kk[2] * kk[2] + kk[3] * kk[3]));
            const float rn = ok ? __builtin_amdgcn_rcpf(fmaxf(__builtin_amdgcn_sqrtf(ss), 1e-12f)) : 0.f;
            const f32x4 kkn = kk * rn;
            const f32x4 km = ok ? zk[r] * ((av[r] - 1.f) * kac + 1.f) : ZERO4;
            const f32x2 zlo = *(const LAS f32x2*)(R + CR_KS + (4 * fq + r) * PS + 8 * fr), zhi = *(const LAS f32x2*)(R + CR_VS + (4 * fq + r) * PS + 8 * fr);
            const f32x4 rr = ok ? (f32x4){zlo.x, zlo.y, zhi.x, zhi.y} : ZERO4;
            const f32x4 bt = rr * km * rkc; bon[r] = rowsum16((bt[0] + bt[1]) + (bt[2] + bt[3]));
            const f32x4 gi = exp4(-cl[r]);
            const f32x4 Amv = exp4(cl[r] - lw[r]) * kkn, Vmv = ok ? up4(vkp[r]) : ZERO4;
            const f32x4 Bmv = kkn * av[r] * gi, Kmv = km * gi, Pmv = exp4(cl[r]) * rr;
            *(LAS v2u*)(R + CR_A + (4 * fq + r) * PA + 8 * fr) = dn4(Amv); *(LAS v2u*)(R + CR_B + (4 * fq + r) * PA + 8 * fr) = dn4(Bmv); *(LAS v2u*)(R + CR_P + (4 * fq + r) * PA + 8 * fr) = dn4(Pmv);
            *(LAS v2u*)(R + CR_BN + (4 * fq + r) * PS + 8 * fr) = dn4(-Bmv); *(LAS v2u*)(R + CR_KS + (4 * fq + r) * PS + 8 * fr) = dn4(Kmv); *(LAS v2u*)(R + CR_VS + (4 * fq + r) * PS + 8 * fr) = dn4(Vmv);
        }
    }
    f32x4 G, Lm, G2, H1, H2;
    {
        const bf16x8 fA0 = *(const LAS bf16x8*)(R + CR_A + fr * PA + fq * 16), fA1 = *(const LAS bf16x8*)(R + CR_A + fr * PA + 64 + fq * 16);
        const bf16x8 fB0 = *(const LAS bf16x8*)(R + CR_B + fr * PA + fq * 16), fB1 = *(const LAS bf16x8*)(R + CR_B + fr * PA + 64 + fq * 16);
        const bf16x8 fK0 = *(const LAS bf16x8*)(R + CR_KS + fr * PS + fq * 16), fK1 = *(const LAS bf16x8*)(R + CR_KS + fr * PS + 64 + fq * 16);
        const bf16x8 fP0 = *(const LAS bf16x8*)(R + CR_P + fr * PA + fq * 16), fP1 = *(const LAS bf16x8*)(R + CR_P + fr * PA + 64 + fq * 16);
        G = MFMA16(fB0, fA0, ZERO4); G = MFMA16(fB1, fA1, G);
        Lm = MFMA16(fA0, fB0, ZERO4); Lm = MFMA16(fA1, fB1, Lm);
        G2 = MFMA16(fK0, fA0, ZERO4); G2 = MFMA16(fK1, fA1, G2);
        H1 = MFMA16(fB0, fP0, ZERO4); H1 = MFMA16(fB1, fP1, H1);
        H2 = MFMA16(fK0, fP0, ZERO4); H2 = MFMA16(fK1, fP1, H2);
#pragma unroll
        for (int r = 0; r < 4; ++r) { const int s = 4 * fq + r, t = fr;
            G[r] = s < t ? G[r] : 0.f; Lm[r] = s > t ? Lm[r] : 0.f; G2[r] = s < t ? G2[r] : 0.f; H1[r] = s <= t ? H1[r] : 0.f; H2[r] = s <= t ? H2[r] : 0.f; }
    }
    f32x4 Tm;
    {
        f32x4 Id;
#pragma unroll
        for (int r = 0; r < 4; ++r) Id[r] = (4 * fq + r == fr) ? 1.f : 0.f;
        const f32x4 Gs = MFMA16(pk4z(Lm), pk4z(G), ZERO4), Ls = MFMA16(pk4z(G), pk4z(Lm), ZERO4);
        const f32x4 Gq = MFMA16(pk4z(Ls), pk4z(Gs), ZERO4), Lq = MFMA16(pk4z(Gs), pk4z(Ls), ZERO4);
        const f32x4 Go = MFMA16(pk4z(Lq), pk4z(Gq), ZERO4);
        const f32x4 M1 = MFMA16(pk4z(Id + Lq), pk4z(Id + Go), ZERO4);
        const f32x4 M2 = MFMA16(pk4z(Id + Ls), pk4z(M1), ZERO4);
        Tm = MFMA16(pk4z(Id - Lm), pk4z(M2), ZERO4);
    }
    {
        const bf16x8 aT = pk4z(Tm), aG2 = pk4z(G2), aH1n = pk4z(-H1), aH2 = pk4z(H2);
        f32x4 Am[4], Pm[4], Vm[4];
#pragma unroll
        for (int r = 0; r < 4; ++r) { Am[r] = up4(*(const LAS v2u*)(R + CR_A + (4 * fq + r) * PA + 8 * fr)); Pm[r] = up4(*(const LAS v2u*)(R + CR_P + (4 * fq + r) * PA + 8 * fr)); Vm[r] = (4 * fq + r < tvalid) ? up4(vkp[r]) : ZERO4; }
        asm volatile("" ::: "memory");
#pragma unroll
        for (int nt = 0; nt < 4; ++nt) {
            const f32x4 amc = {Am[0][nt], Am[1][nt], Am[2][nt], Am[3][nt]}, vmc = {Vm[0][nt], Vm[1][nt], Vm[2][nt], Vm[3][nt]}, pmc = {Pm[0][nt], Pm[1][nt], Pm[2][nt], Pm[3][nt]};
            const f32x4 At = MFMA16(aT, pk4z(amc), ZERO4);
            const f32x4 Q = MFMA16(aG2, pk4z(vmc), ZERO4);
            const f32x4 Yt = MFMA16(aT, pk4z(Q), ZERO4);
            const f32x4 Pt = MFMA16(aH1n, pk4z(At), pmc);
            f32x4 Ol = MFMA16(aH2, pk4z(vmc), ZERO4); Ol = MFMA16(aH1n, pk4z(Yt), Ol);
#pragma unroll
            for (int r = 0; r < 4; ++r) {
                *(LAS unsigned short*)(R + CR_A + (4 * fq + r) * PA + (4 * fr + nt) * 2) = (unsigned short)f2bf(At[r]);
                *(LAS unsigned short*)(R + CR_B + (4 * fq + r) * PA + (4 * fr + nt) * 2) = (unsigned short)f2bf(Pt[r]); }
            *(LAS v2u*)(R + CR_YO + (4 * fr + nt) * PY + 8 * fq) = dn4(Yt); *(LAS v2u*)(R + CR_YO + (4 * fr + nt) * PY + 32 + 8 * fq) = dn4(Ol);
        }
    }
}

struct SeqOps { bf16x8 At0, At1, Pt0, Pt1; v2u yv, ov, vt; };
__device__ __forceinline__ v2u tr_read(const LAS unsigned char* p) { return __builtin_bit_cast(v2u, __builtin_amdgcn_ds_read_tr16_b64_v4i16((LAS s16x4*)p)); }
__device__ __forceinline__ void wkv_seq_load(const LAS unsigned char* R, SeqOps& o, int cb, int fr, int fq) {
    const int ic = 16 * cb + fr;
    const LAS unsigned char* ar = R + CR_A + fr * PA + 8 * fq; const LAS unsigned char* pr = R + CR_B + fr * PA + 8 * fq;
    o.At0 = cat8(*(const LAS v2u*)ar, *(const LAS v2u*)(ar + 32)); o.At1 = cat8(*(const LAS v2u*)(ar + 64), *(const LAS v2u*)(ar + 96));
    o.Pt0 = cat8(*(const LAS v2u*)pr, *(const LAS v2u*)(pr + 32)); o.Pt1 = cat8(*(const LAS v2u*)(pr + 64), *(const LAS v2u*)(pr + 96));
    const LAS unsigned char* yo = R + CR_YO + ic * PY;
    o.yv = *(const LAS v2u*)(yo + 8 * fq); o.ov = *(const LAS v2u*)(yo + 32 + 8 * fq);
    o.vt = tr_read(R + CR_VS + (4 * fq + (fr >> 2)) * PS + (16 * cb + 4 * (fr & 3)) * 2);
}
__device__ __forceinline__ void wkv_seq_step(LAS unsigned char* R, const SeqOps& o, f32x4 (&X)[4], int cb, int fr, int fq) {
    f32x4 gc[4]; bf16x8 Aj[4];
    const LAS unsigned char* trb = R + (4 * fq + (fr >> 2)) * PS + 4 * (fr & 3) * 2;
#pragma unroll
    for (int jt = 0; jt < 4; ++jt) { Aj[jt] = cat8(tr_read(trb + CR_BN + 32 * jt), tr_read(trb + CR_KS + 32 * jt)); gc[jt] = *(const LAS f32x4*)(R + CR_GC + (16 * jt + 4 * fq) * 4); }
    const bf16x8 Bx0 = pack8(X[0], X[1]), Bx1 = pack8(X[2], X[3]);
    const f32x4 U0 = MFMA16(o.At0, Bx0, up4(o.yv)), U1 = MFMA16(o.At1, Bx1, ZERO4);
    f32x4 O = MFMA16(o.Pt0, Bx0, up4(o.ov)); O = MFMA16(o.Pt1, Bx1, O);
    const bf16x8 Bu = cat8(dn4(U0 + U1), o.vt);
#pragma unroll
    for (int jt = 0; jt < 4; ++jt) X[jt] = MFMA16(Aj[jt], Bu, X[jt]) * gc[jt];
    *(LAS v2u*)(R + CR_YO + (16 * cb + fr) * PY + 8 * fq) = dn4(O);
}
__device__ __forceinline__ void wkv_seq(LAS unsigned char* R, f32x4 (&X)[4], int cb, int fr, int fq) { SeqOps o; wkv_seq_load(R, o, cb, fr, fq); asm volatile("" ::: "memory"); wkv_seq_step(R, o, X, cb, fr, fq); }

__device__ __forceinline__ void wkv_post(const LAS unsigned char* R, const f32x4 lg, const f32x4 lb, const v2u (&vkp)[4], const v2u (&gkp)[4], const float (&bon)[4], int tvalid, bf16* oab_row0, int fr, int fq) {
    f32x4 o[4];
#pragma unroll
    for (int nt = 0; nt < 4; ++nt) { const f32x4 c = up4(*(const LAS v2u*)(R + CR_YO + (4 * fr + nt) * PY + 8 * fq)); o[0][nt] = c[0]; o[1][nt] = c[1]; o[2][nt] = c[2]; o[3][nt] = c[3]; }
#pragma unroll
    for (int r = 0; r < 4; ++r) {
        const float mean = rowsum16((o[r][0] + o[r][1]) + (o[r][2] + o[r][3])) * (1.f / 64.f); const f32x4 d = o[r] - mean;
        const float var = rowsum16((d[0] * d[0] + d[1] * d[1]) + (d[2] * d[2] + d[3] * d[3])) * (1.f / 64.f);
        const f32x4 gv = up4(gkp[r]);
        f32x4 y = d * __builtin_amdgcn_rsqf(var + LNX_EPS) * lg + lb + up4(vkp[r]) * bon[r];
        y = y * gv * sig4(gv);
        if (4 * fq + r < tvalid) *(v2u*)(oab_row0 + (size_t)(4 * fq + r) * (2 * D) + 4 * fr) = dn4(y);
    }
}

__device__ __forceinline__ void wkv_consts(LAS float* CS, const Args& a, int h, int tid, int nthreads, int nrows) {
    const int segcol[6] = {C_R + h * 64, C_K + h * 64, C_V + h * 64, C_G + h * 64, C_WD, C_AD};
    for (int e = tid; e < nrows * 64; e += nthreads) { const int row = e >> 6, c = e & 63; float v;
        if (row < 6) v = a.in[I_MU][segcol[row] + c];
        else { const float* src = row == CS_KK ? a.in[I_KK] : row == CS_KA ? a.in[I_KA] : row == CS_RK ? a.in[I_RK] : row == CS_W0 ? a.in[I_W0] : row == CS_A0 ? a.in[I_A0] : row == CS_LG ? a.in[I_LG] : a.in[I_LB]; v = src[h * 64 + c]; }
        CS[e] = v; }
}

__device__ __forceinline__ void wkv_consts_wave(LAS float* CS, const Args& a, int h, int lane) {
    const int segcol[6] = {C_R + h * 64, C_K + h * 64, C_V + h * 64, C_G + h * 64, C_WD, C_AD};
    float v[11];
#pragma unroll
    for (int i = 0; i < 6; ++i) v[i] = a.in[I_MU][segcol[i] + lane];
    v[CS_KK] = a.in[I_KK][h * 64 + lane]; v[CS_KA] = a.in[I_KA][h * 64 + lane]; v[CS_RK] = a.in[I_RK][h * 64 + lane]; v[CS_W0] = a.in[I_W0][h * 64 + lane]; v[CS_A0] = a.in[I_A0][h * 64 + lane];
#pragma unroll
    for (int i = 0; i < 11; ++i) CS[i * 64 + lane] = v[i];
}

__device__ __forceinline__ void chain_item(Frame& F, const Args& a, int b, int h, int rep) {
    int tidv = FTID(F); asm volatile("" : "+v"(tidv));
    const int tid = tidv, lane = tidv & 63, wave = __builtin_amdgcn_readfirstlane(tidv >> 6), fr = lane & 15, fq = lane >> 4;
    const bf16* Z = (const bf16*)(a.ws + WS_Z); bf16* OAB = (bf16*)(a.ws + WS_OAB);
    const size_t row0 = (size_t)b * SEQ;
    LAS unsigned char* L = F.lds; LAS float* CS = (LAS float*)(L + LC_CS); LAS unsigned char* R = L + wave * CR_BYTES;
    wkv_consts(CS, a, h, tid, NWAVES * 64, 13);
    v2u raw[5][6];
    wkv_load_raw(raw, Z, row0, SEQ, wave * 16, h, false, nullptr, fr, fq);
    if (wave < 4) { LAS f32x4* xs = (LAS f32x4*)(L + LC_XS + wave * 4096) + lane;
#pragma unroll
        for (int jt = 0; jt < 4; ++jt) xs[64 * jt] = ZERO4; }
    __syncthreads();
    for (int grp = 0; grp < SEQ / (16 * NWAVES); ++grp) {
        const int c = grp * NWAVES + wave;
        v2u vk[4], gk[4]; float bon[4];
        int lg_ = lane; asm volatile("" : "+v"(lg_)); const int frg = lg_ & 15, fqg = lg_ >> 4;
        unsigned lb = (unsigned)(size_t)L; asm volatile("" : "+s"(lb));
        LAS unsigned char* Lg = (LAS unsigned char*)(size_t)lb; const LAS float* CSg = (const LAS float*)(Lg + LC_CS); LAS unsigned char* Rg = Lg + wave * CR_BYTES;
        unsigned long long wp_ = (unsigned long long)(size_t)((const bf16*)(a.ws + WS_W2T) + (size_t)h * 64 * 64); asm volatile("" : "+s"(wp_));
        const bf16* w2g = (const bf16*)(size_t)wp_;
        if (!((PROBE_CH & 1) && rep == 1)) wkv_pre<true>(Rg, CSg, nullptr, nullptr, w2g, w2g + (WS_A2T - WS_W2T) / 2, raw, 16, vk, gk, bon, frg, fqg);
        else { for (int r_ = 0; r_ < 4; ++r_) { vk[r_] = raw[r_][0]; gk[r_] = raw[r_][1]; bon[r_] = 0.f; } }
        asm volatile("" ::: "memory");
        if (grp + 1 < SEQ / (16 * NWAVES)) wkv_load_raw(raw, Z, row0, SEQ, (c + NWAVES) * 16, h, false, nullptr, frg, fqg);
        LDS_WAIT(); __builtin_amdgcn_s_barrier(); asm volatile("" ::: "memory");
        if (wave < 4) {
            LAS f32x4* xs = (LAS f32x4*)(Lg + LC_XS + wave * 4096) + lg_;
            f32x4 X[4];
#pragma unroll
            for (int jt = 0; jt < 4; ++jt) X[jt] = xs[64 * jt];
            if (!((PROBE_CH & 2) && rep == 1)) {
                SeqOps oa, ob;
                wkv_seq_load(Lg, oa, wave, frg, fqg);
#pragma unroll 1
                for (int cc = 0; cc < NWAVES; cc += 2) {
                    wkv_seq_load(Lg + (cc + 1) * CR_BYTES, ob, wave, frg, fqg);
                    wkv_seq_step(Lg + cc * CR_BYTES, oa, X, wave, frg, fqg);
                    if (cc + 2 < NWAVES) wkv_seq_load(Lg + (cc + 2) * CR_BYTES, oa, wave, frg, fqg);
                    wkv_seq_step(Lg + (cc + 1) * CR_BYTES, ob, X, wave, frg, fqg);
                }
            }
#pragma unroll
            for (int jt = 0; jt < 4; ++jt) xs[64 * jt] = X[jt];
        }
        LDS_WAIT(); __builtin_amdgcn_s_barrier(); asm volatile("" ::: "memory");
        if (!((PROBE_CH & 4) && rep == 1)) wkv_post(Rg, *(const LAS f32x4*)(CSg + CS_LG * 64 + 4 * frg), *(const LAS f32x4*)(CSg + CS_LB * 64 + 4 * frg), vk, gk, bon, (PROBE_CH && rep == 1) ? 0 : 16, OAB + (row0 + (size_t)c * 16) * (2 * D) + h * 64, frg, fqg);
    }
    if (wave < 4 && !(PROBE_CH && rep == 1)) { float* st = a.out + O_WKVP + ((size_t)(b * 16 + h) * 64 + 16 * wave + fr) * 64 + 4 * fq; const LAS f32x4* xs = (const LAS f32x4*)(L + LC_XS + wave * 4096) + lane;
#pragma unroll
        for (int jt = 0; jt < 4; ++jt) *(f32x4*)(st + 16 * jt) = xs[64 * jt]; }
}

__device__ __forceinline__ void sample_chain_item(Frame& F, const Args& a, int seq, int hh) {
    int tidv = FTID(F); asm volatile("" : "+v"(tidv));
    const int lane = tidv & 63, wave = __builtin_amdgcn_readfirstlane(tidv >> 6), fr = lane & 15, fq = lane >> 4;
    const int h = hh * 8 + wave;
    const bf16* Z = (const bf16*)(a.ws + WS_Z); bf16* OAB = (bf16*)(a.ws + WS_OAB);
    const size_t row0 = (size_t)MP + (size_t)seq * DS;
    LAS unsigned char* R = F.lds + wave * CR_BYTES; LAS float* CS = (LAS float*)(F.lds + LC_CS + wave * CS_SAMPLE);
    const f32x4 lgv = *(const f32x4*)(a.in[I_LG] + h * 64 + 4 * fr), lbv = *(const f32x4*)(a.in[I_LB] + h * 64 + 4 * fr);
    wkv_consts_wave(CS, a, h, lane);
    v2u raw[5][6];
    wkv_load_raw(raw, Z, row0, DS, 0, h, true, a.in[I_SSH] + (size_t)seq * RW_COLS, fr, fq);
    v2u vk[4], gk[4]; float bon[4];
    wkv_pre<true>(R, CS, nullptr, nullptr, (const bf16*)(a.ws + WS_W2T) + (size_t)h * 64 * 64, (const bf16*)(a.ws + WS_A2T) + (size_t)h * 64 * 64, raw, DS, vk, gk, bon, fr, fq);
    {
        const float* si = a.in[I_SWKV] + ((size_t)(seq * 16 + h) * 64 + fr) * 64 + 4 * fq; float* so = a.out + O_WKVS + ((size_t)(seq * 16 + h) * 64 + fr) * 64 + 4 * fq;
        f32x4 X[4][4];
#pragma unroll
        for (int cb = 0; cb < 4; ++cb)
#pragma unroll
            for (int jt = 0; jt < 4; ++jt) X[cb][jt] = *(const f32x4*)(si + (size_t)cb * 16 * 64 + 16 * jt);
#pragma unroll
        for (int cb = 0; cb < 4; ++cb) {
            wkv_seq(R, X[cb], cb, fr, fq);
#pragma unroll
            for (int jt = 0; jt < 4; ++jt) *(f32x4*)(so + (size_t)cb * 16 * 64 + 16 * jt) = X[cb][jt];
        }
    }
    wkv_post(R, lgv, lbv, vk, gk, bon, DS, OAB + row0 * (2 * D) + h * 64, fr, fq);
}


template <bool SAMPLE>
__device__ __forceinline__ void attn_item(Frame& F, const Args& a, int seq, int qb, int rep) {
    int tidv = FTID(F); asm volatile("" : "+v"(tidv));
    const int lane = tidv & 63, wave = __builtin_amdgcn_readfirstlane(tidv >> 6), fr = lane & 15, fq = lane >> 4;
    const bf16* Z = (const bf16*)(a.ws + WS_Z); const bf16* KN = (const bf16*)(a.ws + WS_KN);
    bf16* OAB = (bf16*)(a.ws + WS_OAB);
    LAS int* PT = (LAS int*)(F.lds + L_MISC + 64);
    if (SAMPLE) { if (tidv < NPAGES) PT[tidv] = ((const int*)a.in[I_PT])[seq * NPAGES + tidv]; __syncthreads(); }
    LAS float* S = (LAS float*)(F.lds + L_S); LAS unsigned short* SEL = (LAS unsigned short*)(F.lds + L_SEL); LAS int* CNT = (LAS int*)(F.lds + L_CNT);
    const LAS float* BIAS = (const LAS float*)(F.lds + L_BIAS); const LAS unsigned char* LUT = (const LAS unsigned char*)(F.lds + L_LUT);
    constexpr int NQ = SAMPLE ? DS : 16;
    const size_t qrow0 = SAMPLE ? (size_t)MP + (size_t)seq * DS : (size_t)seq * SEQ + (size_t)qb * 16;
    const size_t krow0 = SAMPLE ? (size_t)MP + (size_t)seq * DS : (size_t)seq * SEQ;
    const int ntiles = SAMPLE ? (PAST + DS + 15) / 16 : qb + 1;
    {
        bf16x8 Aq[8][2];
        { const int qr = fr < NQ ? fr : NQ - 1; const bf16* zq = Z + (qrow0 + qr) * NZ + C_QI + fq * 8;
#pragma unroll
          for (int hh = 0; hh < 8; ++hh) { Aq[hh][0] = *(const bf16x8*)(zq + hh * 64); Aq[hh][1] = *(const bf16x8*)(zq + hh * 64 + 32); } }
        float wi[4][8];
#pragma unroll
        for (int r = 0; r < 4; ++r) { const int q = (4 * fq + r) < NQ ? (4 * fq + r) : NQ - 1; const v4u w = *(const v4u*)(Z + (qrow0 + q) * NZ + C_WI);
            const float sc = 0.04419417382f;
            wi[r][0] = bf_lo(w.x) * sc; wi[r][1] = bf_hi(w.x) * sc; wi[r][2] = bf_lo(w.y) * sc; wi[r][3] = bf_hi(w.y) * sc;
            wi[r][4] = bf_lo(w.z) * sc; wi[r][5] = bf_hi(w.z) * sc; wi[r][6] = bf_lo(w.w) * sc; wi[r][7] = bf_hi(w.w) * sc; }
        f32x4 Rp[4][4];
        auto ld_tile = [&](int kt, f32x4 (&R)[4]) {
            const int key = kt * 16 + fr;
            const int knew = (key - PAST) < DS ? (key - PAST) : DS - 1;
            const float* kp = (key >= PAST ? a.out + O_KIS + ((size_t)seq * DS + knew) * 64 : a.in[I_CKI] + ((size_t)PT[(key < PAST ? key : 0) >> 7] * PAGE + (key & (PAGE - 1))) * 64) + fq * 8;
            R[0] = *(const f32x4*)kp; R[1] = *(const f32x4*)(kp + 4); R[2] = *(const f32x4*)(kp + 32); R[3] = *(const f32x4*)(kp + 36);
        };
#pragma unroll
        for (int i = 0; i < 4; ++i) { const int kt = wave + NWAVES * i; if (kt < ntiles) ld_tile(kt, Rp[i]); }
        if (!((PROBE_SA & 1) && rep == 1))
        for (int kt0 = wave; kt0 < ntiles; kt0 += 4 * NWAVES) {
#pragma unroll
            for (int i = 0; i < 4; ++i) { const int kt = kt0 + NWAVES * i;
                if (kt < ntiles) {
                    const bf16x8 Bk0 = pack8(Rp[i][0], Rp[i][1]), Bk1 = pack8(Rp[i][2], Rp[i][3]);
                    if (kt + 4 * NWAVES < ntiles) ld_tile(kt + 4 * NWAVES, Rp[i]);
                    f32x4 sc = {0.f, 0.f, 0.f, 0.f};
#pragma unroll
                    for (int hh = 0; hh < 8; ++hh) { f32x4 c = {0.f, 0.f, 0.f, 0.f};
                        c = __builtin_amdgcn_mfma_f32_16x16x32_bf16(Aq[hh][0], Bk0, c, 0, 0, 0); c = __builtin_amdgcn_mfma_f32_16x16x32_bf16(Aq[hh][1], Bk1, c, 0, 0, 0);
#pragma unroll
                        for (int r = 0; r < 4; ++r) sc[r] += wi[r][hh] * fmaxf(c[r], 0.f); }
#pragma unroll
                    for (int r = 0; r < 4; ++r) S[(4 * fq + r) * SROW + kt * 16 + fr] = sc[r] + 0.0f;
                } }
        }
    }
    __syncthreads();
    {
        const int nqw = SAMPLE ? (wave < DS ? 1 : 0) : 2;
        for (int qq = 0; qq < nqw; ++qq) {
            const int q = SAMPLE ? wave : 2 * wave + qq;
            const int n = SAMPLE ? PAST + q + 1 : qb * 16 + q + 1;
            LAS unsigned short* sel = SEL + q * TOPK;
            if (n <= TOPK || ((PROBE_SA & 2) && rep == 1)) {
#pragma unroll
                for (int i = 0; i < 4; ++i) { const int idx = lane + 64 * i; if (idx < n) sel[idx] = (unsigned short)idx; }
                if (lane == 0) CNT[q] = n < TOPK ? n : TOPK;
            } else {
                unsigned u[33];
#pragma unroll
                for (int i = 0; i < 33; ++i) { const int idx = lane + 64 * i; float x = S[q * SROW + (idx < SROW ? idx : SROW - 1)]; asm volatile("" : "+v"(x));
                    u[i] = idx < n ? sortable(x) : 0u; }
                unsigned Tv = 0u;
                for (int bit = 31; bit >= 0; --bit) {
                    const unsigned cand = Tv | (1u << bit); int c = 0;
#pragma unroll
                    for (int i = 0; i < 33; ++i) c += __popcll(__ballot(u[i] >= cand));
                    if (c >= TOPK) Tv = cand;
                }
                int G = 0;
#pragma unroll
                for (int i = 0; i < 33; ++i) G += __popcll(__ballot(u[i] > Tv));
                const int need = TOPK - G;
                int base = 0, tb = 0;
#pragma unroll
                for (int i = 0; i < 33; ++i) {
                    const bool gt = u[i] > Tv, eq = u[i] == Tv;
                    const unsigned long long meq = __ballot(eq);
                    const int trank = tb + (int)__builtin_amdgcn_mbcnt_hi((unsigned)(meq >> 32), __builtin_amdgcn_mbcnt_lo((unsigned)meq, 0u));
                    const bool take = gt || (eq && trank < need);
                    const unsigned long long mt = __ballot(take);
                    const int pos = base + (int)__builtin_amdgcn_mbcnt_hi((unsigned)(mt >> 32), __builtin_amdgcn_mbcnt_lo((unsigned)mt, 0u));
                    if (take) sel[pos] = (unsigned short)(lane + 64 * i);
                    base += __popcll(mt); tb += __popcll(meq);
                }
                if (lane == 0) CNT[q] = TOPK;
            }
        }
    }
    __syncthreads();
    LAS unsigned char* VST = F.lds + L_S + wave * 8192;
    if (!((PROBE_SA & 4) && rep == 1))
    for (int un = wave; un < NQ * 2; un += NWAVES) {
        const int q = un >> 1, g = un & 1;
        const int cnt = __builtin_amdgcn_readfirstlane(CNT[q]); const int pos = SAMPLE ? PAST + q : qb * 16 + q;
        const size_t qrow = qrow0 + q;
        const int head = g * 8 + (fr & 7);
        const LAS unsigned short* sel = SEL + q * TOPK;
        bf16x8 Bq0, Bq1;
        { const bf16* qp = Z + qrow * NZ + C_Q + head * 64 + fq * 8; const v4u w0 = *(const v4u*)qp, w1 = *(const v4u*)(qp + 32);
          float x[16] = {bf_lo(w0.x), bf_hi(w0.x), bf_lo(w0.y), bf_hi(w0.y), bf_lo(w0.z), bf_hi(w0.z), bf_lo(w0.w), bf_hi(w0.w),
                         bf_lo(w1.x), bf_hi(w1.x), bf_lo(w1.y), bf_hi(w1.y), bf_lo(w1.z), bf_hi(w1.z), bf_lo(w1.w), bf_hi(w1.w)};
          float ss = 0.f;
#pragma unroll
          for (int j = 0; j < 16; ++j) ss += x[j] * x[j];
          ss += __shfl_xor(ss, 16); ss += __shfl_xor(ss, 32);
          const float rs = (0.125f * 1.44269504089f) / sqrtf(ss * (1.f / 64.f) + NORM_EPS);
          const f32x4 g0 = *(const f32x4*)(a.in[I_QG] + fq * 8), g1 = *(const f32x4*)(a.in[I_QG] + fq * 8 + 4), g2 = *(const f32x4*)(a.in[I_QG] + 32 + fq * 8), g3 = *(const f32x4*)(a.in[I_QG] + 36 + fq * 8);
          Bq0 = pack8((f32x4){x[0] * rs * g0[0], x[1] * rs * g0[1], x[2] * rs * g0[2], x[3] * rs * g0[3]}, (f32x4){x[4] * rs * g1[0], x[5] * rs * g1[1], x[6] * rs * g1[2], x[7] * rs * g1[3]});
          Bq1 = pack8((f32x4){x[8] * rs * g2[0], x[9] * rs * g2[1], x[10] * rs * g2[2], x[11] * rs * g2[3]}, (f32x4){x[12] * rs * g3[0], x[13] * rs * g3[1], x[14] * rs * g3[2], x[15] * rs * g3[3]}); }
        f32x4 RB[16];
        float alpha[4]; bf16x8 Pf[4][2];
        float mrun = -INFINITY, sum = 0.f;
#define SA_FENCE asm volatile("" ::: "memory"); __builtin_amdgcn_sched_barrier(0)
#define SA_LDK(j, s) do { const int slot_ = (j) * 16 + fr; const int key_ = sel[slot_ < cnt ? slot_ : cnt - 1]; \
            const float* kp_ = (key_ >= PAST ? a.out + O_KS + ((size_t)seq * DS + (key_ - PAST)) * 128 : a.in[I_CK] + ((size_t)PT[(key_ < PAST ? key_ : 0) >> 7] * PAGE + (key_ & (PAGE - 1))) * 128) + g * 64 + fq * 8; \
            RB[4 * (s)] = *(const f32x4*)kp_; RB[4 * (s) + 1] = *(const f32x4*)(kp_ + 4); RB[4 * (s) + 2] = *(const f32x4*)(kp_ + 32); RB[4 * (s) + 3] = *(const f32x4*)(kp_ + 36); } while (0)
#define SA_LDV(i, p) do { const int r_ = (lane >> 3) + 8 * ((i) & 7); const int slot_ = ((i) >> 3) * 64 + r_; const int key_ = sel[slot_ < cnt ? slot_ : cnt - 1]; \
            const float* vp_ = (key_ >= PAST ? a.out + O_VS + ((size_t)seq * DS + (key_ - PAST)) * 128 : a.in[I_CV] + ((size_t)PT[(key_ < PAST ? key_ : 0) >> 7] * PAGE + (key_ & (PAGE - 1))) * 128) + g * 64 + (lane & 7) * 8; \
            RB[2 * (p)] = *(const f32x4*)vp_; RB[2 * (p) + 1] = *(const f32x4*)(vp_ + 4); } while (0)
#define SA_VPAIR(i) ((i) & 7)
#pragma unroll
        for (int j = 0; j < 4; ++j) SA_LDK(j, j);
        SA_FENCE;
        {
            float lg[4][4];
#pragma unroll
            for (int j = 0; j < 16; ++j) {
                const int t4 = j & 3, ch = j >> 2, sl = j & 3, sb = j * 16;
                const bf16x8 Ak0 = pack8(RB[4 * sl], RB[4 * sl + 1]), Ak1 = pack8(RB[4 * sl + 2], RB[4 * sl + 3]);
                f32x4 c = {0.f, 0.f, 0.f, 0.f};
                c = __builtin_amdgcn_mfma_f32_16x16x32_bf16(Ak0, Bq0, c, 0, 0, 0); c = __builtin_amdgcn_mfma_f32_16x16x32_bf16(Ak1, Bq1, c, 0, 0, 0);
                SA_FENCE;
                if (j + 4 < 16) SA_LDK(j + 4, sl); else { SA_LDV(2 * (j - 12), 2 * sl); SA_LDV(2 * (j - 12) + 1, 2 * sl + 1); }
                SA_FENCE;
                const v2u kw = *(const LAS v2u*)(sel + sb + 4 * fq);
                const int k4[4] = {(int)(kw.x & 0xffffu), (int)(kw.x >> 16), (int)(kw.y & 0xffffu), (int)(kw.y >> 16)};
#pragma unroll
                for (int r = 0; r < 4; ++r) { const bool ok = (sb + 4 * fq + r) < cnt; const int dist = ok ? pos - k4[r] : 0;
                    float bv = BIAS[(int)LUT[dist] * 16 + head]; asm volatile("" : "+v"(bv));
                    lg[t4][r] = ok ? c[r] + bv : -INFINITY; }
                if (t4 == 3) {
                    float mx = mrun;
#pragma unroll
                    for (int u4 = 0; u4 < 4; ++u4)
#pragma unroll
                        for (int r = 0; r < 4; ++r) mx = fmaxf(mx, lg[u4][r]);
                    mx = fmaxf(mx, __shfl_xor(mx, 16)); mx = fmaxf(mx, __shfl_xor(mx, 32));
                    alpha[ch] = __builtin_amdgcn_exp2f(mrun - mx); mrun = mx;
                    float ps = 0.f;
#pragma unroll
                    for (int u4 = 0; u4 < 4; ++u4)
#pragma unroll
                        for (int r = 0; r < 4; ++r) { lg[u4][r] = __builtin_amdgcn_exp2f(lg[u4][r] - mx); ps += lg[u4][r]; }
                    sum = sum * alpha[ch] + ps;
#pragma unroll
                    for (int k2 = 0; k2 < 2; ++k2) Pf[ch][k2] = pack8((f32x4){lg[2 * k2][0], lg[2 * k2][1], lg[2 * k2][2], lg[2 * k2][3]}, (f32x4){lg[2 * k2 + 1][0], lg[2 * k2 + 1][1], lg[2 * k2 + 1][2], lg[2 * k2 + 1][3]});
                }
            }
        }
        f32x4 ao[4];
#pragma unroll
        for (int dt = 0; dt < 4; ++dt) ao[dt] = (f32x4){0.f, 0.f, 0.f, 0.f};
#pragma unroll
        for (int i = 0; i < 32; ++i) {
            const int ch = i >> 3, pr = SA_VPAIR(i);
            { const int r = (lane >> 3) + 8 * (i & 7), c16 = lane & 7;
              *(LAS v4u*)(VST + r * 128 + 16 * (c16 ^ (r & 7))) = __builtin_bit_cast(v4u, pack8(RB[2 * pr], RB[2 * pr + 1])); }
            SA_FENCE;
            if (i + 8 < 32) SA_LDV(i + 8, pr);
            SA_FENCE;
            if ((i & 7) == 7) {
#pragma unroll
                for (int dt = 0; dt < 4; ++dt) ao[dt] = ao[dt] * alpha[ch];
#pragma unroll
                for (int k2 = 0; k2 < 2; ++k2) { const int ra = k2 * 32 + 4 * fq + (fr >> 2), rb = ra + 16;
#pragma unroll
                    for (int dt = 0; dt < 4; ++dt) { const int c16 = 2 * dt + ((fr & 3) >> 1), sub = 8 * (fr & 1);
                        const s16x4 va = __builtin_amdgcn_ds_read_tr16_b64_v4i16((LAS s16x4*)(VST + ra * 128 + 16 * (c16 ^ (ra & 7)) + sub));
                        const s16x4 vb = __builtin_amdgcn_ds_read_tr16_b64_v4i16((LAS s16x4*)(VST + rb * 128 + 16 * (c16 ^ (rb & 7)) + sub));
                        const bf16x8 Av = {va[0], va[1], va[2], va[3], vb[0], vb[1], vb[2], vb[3]};
                        ao[dt] = __builtin_amdgcn_mfma_f32_16x16x32_bf16(Av, Pf[ch][k2], ao[dt], 0, 0, 0); } }
                SA_FENCE;
            }
        }
#undef SA_FENCE
#undef SA_LDK
#undef SA_LDV
#undef SA_VPAIR
        sum += __shfl_xor(sum, 16); sum += __shfl_xor(sum, 32);
        if (fr < 8) {
            const float inv = 1.0f / sum;
#pragma unroll
            for (int dt = 0; dt < 4; ++dt) { const int col = head * 64 + dt * 16 + 4 * fq;
                const v2u gw = *(const v2u*)(Z + qrow * NZ + C_AG + col);
                const float g0 = bf_lo(gw.x), g1 = bf_hi(gw.x), g2 = bf_lo(gw.y), g3 = bf_hi(gw.y);
                v2u o; o.x = pk2(ao[dt][0] * inv * g0 * sigmoidf_(g0), ao[dt][1] * inv * g1 * sigmoidf_(g1)); o.y = pk2(ao[dt][2] * inv * g2 * sigmoidf_(g2), ao[dt][3] * inv * g3 * sigmoidf_(g3));
                if (!(PROBE_SA && rep == 1)) *(v2u*)(OAB + qrow * (2 * D) + D + col) = o; }
        }
    }
}

__device__ __forceinline__ int kv_rowpos(int key, int g) { return key * 2 + (g ^ (((key >> 2) ^ (key >> 3)) & 1)); }
__device__ __forceinline__ int kv_sw(int key) { return 2 * (key & 3) + ((key >> 3) & 1); }

__device__ __forceinline__ void att_dma(LAS unsigned char* stw, const bf16* kt, const bf16* vt, const unsigned (&goff)[2]) {
#pragma unroll
    for (int i = 0; i < 2; ++i) {
        __builtin_amdgcn_global_load_lds((const unsigned*)(kt + goff[i]), (LAS unsigned*)(stw + i * 1024), 16, 0, 0);
        __builtin_amdgcn_global_load_lds((const unsigned*)(vt + goff[i]), (LAS unsigned*)(stw + 16384 + i * 1024), 16, 0, 0); }
}
constexpr int BMP = 65, MT_OFFW = 16 * BMP;
static_assert((MT_OFFW * 4) % 32 == 0 && MT_OFFW * 4 + 4096 <= 8192 + 64, "mask images");
__device__ __forceinline__ void att_mask_tile(const LAS unsigned* BM, int kt, int wave, int lane) {
    const int key = wave * 8 + (lane >> 3), qp = lane & 7;
    const unsigned w0 = BM[(2 * qp) * BMP + kt * 2 + (key >> 5)], w1 = BM[(2 * qp + 1) * BMP + kt * 2 + (key >> 5)];
    const unsigned b0 = (w0 >> (key & 31)) & 1u, b1 = (w1 >> (key & 31)) & 1u;
    ((LAS unsigned*)BM)[MT_OFFW + (kt & 1) * 512 + key * 8 + qp] = (b0 ? 0u : 0xC76Au) | (b1 ? 0u : 0xC76A0000u);
}
template <bool FAR>
__device__ __forceinline__ void att_tile(int kt, int nt64, int qb, int g, int qq, int fr, int fq, int head, float bias_far, float m0h, LAS unsigned char* ST, const LAS unsigned* BM, const LAS float* BIAS, const LAS unsigned char* LUT,
                                         const bf16* kt0, const bf16* vt0, const unsigned (&goff)[2], unsigned ldsw,
                                         const bf16x8 (&Bq)[2][2], const bf16x8 (&Bmk)[2], f32x4 (&ao)[2][4], f32x4 (&lsum)[2]) {
    LAS unsigned char* Kb = ST + (kt & 3) * 32768; LAS unsigned char* Vb = Kb + 16384;
    if (kt + 3 < nt64) att_dma(ST + ((kt + 3) & 3) * 32768 + ldsw, kt0 + (size_t)(kt + 3) * 8192, vt0 + (size_t)(kt + 3) * 8192, goff);
    if (kt + 1 < nt64) att_mask_tile(BM, kt + 1, g * 4 + qq, fq * 16 + fr);
    const LAS unsigned char* MTb = (const LAS unsigned char*)(BM + MT_OFFW) + (kt & 1) * 2048;
    f32x4 cq[2][4];
    {
        bf16x8 Ak[4][2], Am[4];
#pragma unroll
        for (int sub = 0; sub < 4; ++sub) { const int krw = sub * 16 + fr; const int rp = kv_rowpos(krw, g) * 128;
            Ak[sub][0] = *(const LAS bf16x8*)(Kb + rp + 16 * (fq ^ kv_sw(krw))); Ak[sub][1] = *(const LAS bf16x8*)(Kb + rp + 16 * ((4 + fq) ^ kv_sw(krw)));
            Am[sub] = *(const LAS bf16x8*)(MTb + krw * 32 + 16 * (fq & 1)); }
#pragma unroll
        for (int nt = 0; nt < 2; ++nt) {
            const int ql = 4 * qq + 2 * nt + (fr >> 3);
#pragma unroll
            for (int sub = 0; sub < 4; ++sub) {
                f32x4 cin;
#pragma unroll
                for (int r = 0; r < 4; ++r) {
                    float bv = bias_far;
                    if (!FAR) { const int dd = qb * 16 + ql - (kt * 64 + sub * 16 + 4 * fq) - r; bv = BIAS[(int)LUT[dd < 0 ? 0 : dd] * 16 + head]; asm volatile("" : "+v"(bv)); bv -= m0h; }
                    cin[r] = bv;
                }
                cq[nt][sub] = __builtin_amdgcn_mfma_f32_16x16x32_bf16(Am[sub], Bmk[nt], cin, 0, 0, 0);
                cq[nt][sub] = __builtin_amdgcn_mfma_f32_16x16x32_bf16(Ak[sub][0], Bq[nt][0], cq[nt][sub], 0, 0, 0);
            }
        }
#pragma unroll
        for (int sub = 0; sub < 4; ++sub)
#pragma unroll
            for (int nt = 0; nt < 2; ++nt) cq[nt][sub] = __builtin_amdgcn_mfma_f32_16x16x32_bf16(Ak[sub][1], Bq[nt][1], cq[nt][sub], 0, 0, 0);
    }
    bf16x8 Pf[2][2];
#pragma unroll
    for (int nt = 0; nt < 2; ++nt) {
#pragma unroll
        for (int sub = 0; sub < 4; ++sub) {
#pragma unroll
            for (int r = 0; r < 4; ++r) cq[nt][sub][r] = __builtin_amdgcn_exp2f(cq[nt][sub][r]);
            lsum[nt] += cq[nt][sub]; }
#pragma unroll
        for (int k2 = 0; k2 < 2; ++k2) Pf[nt][k2] = pack8(cq[nt][2 * k2], cq[nt][2 * k2 + 1]);
    }
#pragma unroll
    for (int k2 = 0; k2 < 2; ++k2) {
        const int ra = k2 * 32 + 4 * fq + (fr >> 2), rb = ra + 16;
        const int pa = kv_rowpos(ra, g) * 128, pb = kv_rowpos(rb, g) * 128;
#pragma unroll
        for (int dt = 0; dt < 4; ++dt) { const int c16 = 2 * dt + ((fr & 3) >> 1), sub8 = 8 * (fr & 1);
            const s16x4 va = __builtin_amdgcn_ds_read_tr16_b64_v4i16((LAS s16x4*)(Vb + pa + 16 * (c16 ^ kv_sw(ra)) + sub8));
            const s16x4 vb = __builtin_amdgcn_ds_read_tr16_b64_v4i16((LAS s16x4*)(Vb + pb + 16 * (c16 ^ kv_sw(rb)) + sub8));
            const bf16x8 Av = {va[0], va[1], va[2], va[3], vb[0], vb[1], vb[2], vb[3]};
            ao[0][dt] = __builtin_amdgcn_mfma_f32_16x16x32_bf16(Av, Pf[0][k2], ao[0][dt], 0, 0, 0);
            ao[1][dt] = __builtin_amdgcn_mfma_f32_16x16x32_bf16(Av, Pf[1][k2], ao[1][dt], 0, 0, 0); }
    }
    if (kt + 3 < nt64) asm volatile("s_waitcnt vmcnt(8)" ::: "memory"); else if (kt + 2 < nt64) asm volatile("s_waitcnt vmcnt(4)" ::: "memory"); else asm volatile("s_waitcnt vmcnt(0)" ::: "memory");
    LDS_WAIT(); __builtin_amdgcn_s_barrier(); asm volatile("" ::: "memory");
}

constexpr int Q_P2P_ = MP / 256, Q_PCH_ = NB * 16, Q_P2S_ = 8, Q_PA1_ = 56, Q_SAT_ = DB, Q_SCH_ = DB * 2, Q_PAT_ = NB * (SEQ / 16), Q_SG_ = 2 * (NZ / 256);
constexpr int QB_PCH_ = Q_P2P_, QB_P2S_ = QB_PCH_ + Q_PCH_, QB_PA1_ = QB_P2S_ + Q_P2S_, QB_SAT_ = QB_PA1_ + Q_PA1_, QB_SCH_ = QB_SAT_ + Q_SAT_, QB_PA2_ = QB_SCH_ + Q_SCH_, Q_TOTAL_ = QB_PA2_ + Q_PAT_ - Q_PA1_;
__device__ __forceinline__ int q_pa_index(int it) { return (it >= QB_PA1_ && it < QB_SAT_) ? it - QB_PA1_ : ((it >= QB_PA2_ && it < Q_TOTAL_) ? it - QB_PA2_ + Q_PA1_ : -1); }
constexpr int CW_P1A = 1024, CW_P1B = 1088, CW_P2P = 1152, CW_P2S = 1216, CW_P1X = 1280  ;
constexpr int QI_PITCH = 1040;
__device__ __forceinline__ void attn_prompt_item(Frame& F, const Args& a, int b, int qb, int rep, int staged, unsigned* qctr) {
    int tidv = FTID(F); asm volatile("" : "+v"(tidv));
    const int tid = tidv, lane = tidv & 63, wave = __builtin_amdgcn_readfirstlane(tidv >> 6), fr = lane & 15, fq = lane >> 4;
    const bf16* Z = (const bf16*)(a.ws + WS_Z); const bf16* KN = (const bf16*)(a.ws + WS_KN);
    bf16* OAB = (bf16*)(a.ws + WS_OAB);
    LAS float* S = (LAS float*)(F.lds + L_S); LAS unsigned* BM = (LAS unsigned*)(F.lds + L_SEL);
    const LAS float* BIAS = (const LAS float*)(F.lds + L_BIAS); const LAS unsigned char* LUT = (const LAS unsigned char*)(F.lds + L_LUT);
    const size_t qrow0 = (size_t)b * SEQ + (size_t)qb * 16, krow0 = (size_t)b * SEQ;
    const int ntiles = qb + 1;
    const int g = wave >> 2, qq = wave & 3, head = g * 8 + (fr & 7);
    const int nt64 = (qb * 16 + 16 + 63) >> 6;
    LAS unsigned char* ST = F.lds + L_S;
    unsigned goff[2];
#pragma unroll
    for (int i = 0; i < 2; ++i) { const int o = 2048 * wave + 1024 * i + 16 * lane, row = o >> 7, key = row >> 1, gg = (row & 1) ^ (((key >> 2) ^ (key >> 3)) & 1), c8 = ((o >> 4) & 7) ^ kv_sw(key);
        goff[i] = (unsigned)(key * 128 + gg * 64 + c8 * 8); }
    const unsigned ldsw = 2048u * (unsigned)wave;
    const bf16* kt0 = KN + krow0 * 128; const bf16* vt0 = (const bf16*)(a.ws + WS_VN) + krow0 * 128;
    v4u qraw[2][2]; v2u gwv[2][4];
    const f32x4 g0 = *(const f32x4*)(a.in[I_QG] + fq * 8), g1 = *(const f32x4*)(a.in[I_QG] + fq * 8 + 4), g2 = *(const f32x4*)(a.in[I_QG] + 32 + fq * 8), g3 = *(const f32x4*)(a.in[I_QG] + 36 + fq * 8);
#pragma unroll
    for (int nt = 0; nt < 2; ++nt) { const bf16* zrow = Z + (qrow0 + 4 * qq + 2 * nt + (fr >> 3)) * NZ;
        qraw[nt][0] = *(const v4u*)(zrow + C_Q + head * 64 + fq * 8); qraw[nt][1] = *(const v4u*)(zrow + C_Q + head * 64 + fq * 8 + 32);
#pragma unroll
        for (int dt = 0; dt < 4; ++dt) gwv[nt][dt] = *(const v2u*)(zrow + C_AG + head * 64 + dt * 16 + 4 * fq); }
    {
        bf16x8 Aq[8][2];
        if (staged) { const LAS unsigned char* zq = F.lds + L_HIST + fr * QI_PITCH + fq * 16;
#pragma unroll
          for (int hh = 0; hh < 8; ++hh) { Aq[hh][0] = *(const LAS bf16x8*)(zq + hh * 128); Aq[hh][1] = *(const LAS bf16x8*)(zq + hh * 128 + 64); } }
        else { const bf16* zq = Z + (qrow0 + fr) * NZ + C_QI + fq * 8;
#pragma unroll
          for (int hh = 0; hh < 8; ++hh) { Aq[hh][0] = *(const bf16x8*)(zq + hh * 64); Aq[hh][1] = *(const bf16x8*)(zq + hh * 64 + 32); } }
        float wi[4][8];
#pragma unroll
        for (int r = 0; r < 4; ++r) { const v4u w = *(const v4u*)(Z + (qrow0 + 4 * fq + r) * NZ + C_WI);
            const float sc = 0.04419417382f;
            wi[r][0] = bf_lo(w.x) * sc; wi[r][1] = bf_hi(w.x) * sc; wi[r][2] = bf_lo(w.y) * sc; wi[r][3] = bf_hi(w.y) * sc;
            wi[r][4] = bf_lo(w.z) * sc; wi[r][5] = bf_hi(w.z) * sc; wi[r][6] = bf_lo(w.w) * sc; wi[r][7] = bf_hi(w.w) * sc; }
        const bf16* kbase = (const bf16*)(a.ws + WS_KIN) + krow0 * 64 + (size_t)fr * 64 + fq * 8;
        bf16x8 Bp[4][2];
#pragma unroll
        for (int i = 0; i < 4; ++i) { const int kt = wave + NWAVES * i; if (kt < ntiles) { Bp[i][0] = *(const bf16x8*)(kbase + (size_t)kt * 1024); Bp[i][1] = *(const bf16x8*)(kbase + (size_t)kt * 1024 + 32); } }
        if (!((PROBE_AT & 1) && rep == 1))
        for (int kt0 = wave; kt0 < ntiles; kt0 += 4 * NWAVES) {
#pragma unroll
            for (int i = 0; i < 4; ++i) { const int kt = kt0 + NWAVES * i;
                if (kt < ntiles) {
                    const bf16x8 Bk0 = Bp[i][0], Bk1 = Bp[i][1];
                    const int kn = kt + 4 * NWAVES; if (kn < ntiles) { Bp[i][0] = *(const bf16x8*)(kbase + (size_t)kn * 1024); Bp[i][1] = *(const bf16x8*)(kbase + (size_t)kn * 1024 + 32); }
                    f32x4 sc = {0.f, 0.f, 0.f, 0.f};
#pragma unroll
                    for (int hh = 0; hh < 8; ++hh) { f32x4 c = {0.f, 0.f, 0.f, 0.f};
                        c = __builtin_amdgcn_mfma_f32_16x16x32_bf16(Aq[hh][0], Bk0, c, 0, 0, 0); c = __builtin_amdgcn_mfma_f32_16x16x32_bf16(Aq[hh][1], Bk1, c, 0, 0, 0);
#pragma unroll
                        for (int r = 0; r < 4; ++r) sc[r] += wi[r][hh] * fmaxf(c[r], 0.f); }
#pragma unroll
                    for (int r = 0; r < 4; ++r) S[(4 * fq + r) * SROW + kt * 16 + fr] = sc[r] + 0.0f;
                } }
        }
    }
    __syncthreads();
    unsigned nxt_draw = 0u;
    {
        if (tid == 0) nxt_draw = __hip_atomic_fetch_add(qctr, 1u, RLX_AGENT);
        LAS unsigned* hist = (LAS unsigned*)(F.lds + L_HIST + wave * 2048);
        const int q0 = 2 * wave, n0 = qb * 16 + q0 + 1, n1 = n0 + 1;
        LAS unsigned* bm0 = BM + q0 * BMP; LAS unsigned* bm1 = bm0 + BMP;
        const bool all = n1 <= TOPK;
        unsigned u0[32], u1[32];
        const int nb = (n1 + 511) >> 9;
#pragma unroll
        for (int i = 0; i < 32; ++i) { u0[i] = 0u; u1[i] = 0u; }
        if (!all) {
#pragma unroll
            for (int i = 0; i < 32; ++i) if ((i >> 3) < nb) { const int idx = lane + 64 * i;
                float x0 = S[q0 * SROW + idx], x1 = S[(q0 + 1) * SROW + idx]; asm volatile("" : "+v"(x0), "+v"(x1));
                u0[i] = idx < n0 ? sortable(x0) : 0u; u1[i] = idx < n1 ? sortable(x1) : 0u; }
        }
        LDS_WAIT(); __builtin_amdgcn_s_barrier(); asm volatile("" ::: "memory");
#pragma unroll
        for (int t = 0; t < 3; ++t) if (t < nt64) att_dma(ST + t * 32768 + ldsw, kt0 + (size_t)t * 8192, vt0 + (size_t)t * 8192, goff);
        if ((PROBE_AT & 2) && rep == 1) {} else
        if (all) {
#pragma unroll
            for (int i = 0; i < 4; ++i) { const unsigned long long m0 = __ballot(lane + 64 * i < n0), m1 = __ballot(lane + 64 * i < n1);
                if (lane == 0) { bm0[2 * i] = (unsigned)m0; bm0[2 * i + 1] = (unsigned)(m0 >> 32); bm1[2 * i] = (unsigned)m1; bm1[2 * i + 1] = (unsigned)(m1 >> 32); } }
            if (lane < 56) { bm0[8 + lane] = 0u; bm1[8 + lane] = 0u; }
        } else {
            unsigned pf0 = 0u, pf1 = 0u; int need0 = TOPK, need1 = TOPK, cb0 = 0, cb1 = 0;
            {
                unsigned d0 = 0u, d1 = 0u;
#pragma unroll 1
                for (int bit = 7; bit >= 0; --bit) {
                    const unsigned c0 = (d0 | (1u << bit)) << 24, c1 = (d1 | (1u << bit)) << 24; int k0 = 0, k1 = 0;
#pragma unroll
                    for (int i = 0; i < 32; ++i) if ((i >> 3) < nb) { k0 += __popcll(__ballot(u0[i] >= c0)); k1 += __popcll(__ballot(u1[i] >= c1)); }
                    if (k0 >= TOPK) d0 |= 1u << bit; if (k1 >= TOPK) d1 |= 1u << bit;
                }
                int a0 = 0, a1 = 0; const unsigned e0 = (d0 + 1u) << 24, e1 = (d1 + 1u) << 24;
#pragma unroll
                for (int i = 0; i < 32; ++i) if ((i >> 3) < nb) { a0 += __popcll(__ballot(u0[i] >= e0)); a1 += __popcll(__ballot(u1[i] >= e1)); }
                need0 -= a0; need1 -= a1; pf0 = d0; pf1 = d1;
            }
#pragma unroll 1
            for (int p = 1; p < 4; ++p) {
                const int sh = 24 - 8 * p;
                *(LAS v4u*)(hist + 4 * lane) = (v4u){0u, 0u, 0u, 0u}; *(LAS v4u*)(hist + 256 + 4 * lane) = (v4u){0u, 0u, 0u, 0u};
#pragma unroll
                for (int i = 0; i < 32; ++i) if ((i >> 3) < nb) {
                    const bool m0 = (u0[i] >> (sh + 8)) == pf0, m1 = (u1[i] >> (sh + 8)) == pf1;
                    if (m0) (void)__hip_atomic_fetch_add(hist + ((u0[i] >> sh) & 255u), 1u, __ATOMIC_RELAXED, __HIP_MEMORY_SCOPE_WORKGROUP);
                    if (m1) (void)__hip_atomic_fetch_add(hist + 256 + ((u1[i] >> sh) & 255u), 1u, __ATOMIC_RELAXED, __HIP_MEMORY_SCOPE_WORKGROUP); }
                const v4u c0 = *(const LAS v4u*)(hist + 4 * lane), c1 = *(const LAS v4u*)(hist + 256 + 4 * lane);
                const int ls0 = (int)(c0.x + c0.y + c0.z + c0.w), ls1 = (int)(c1.x + c1.y + c1.z + c1.w);
                int pr0 = ls0, pr1 = ls1;
#define SCAN_STEP(ctrl, rmask) { pr0 += __builtin_amdgcn_update_dpp(0, pr0, ctrl, rmask, 0xF, false); pr1 += __builtin_amdgcn_update_dpp(0, pr1, ctrl, rmask, 0xF, false); }
                SCAN_STEP(0x111, 0xF) SCAN_STEP(0x112, 0xF) SCAN_STEP(0x114, 0xF) SCAN_STEP(0x118, 0xF) SCAN_STEP(0x142, 0xA) SCAN_STEP(0x143, 0xC)
#undef SCAN_STEP
                const int tot0 = __builtin_amdgcn_readlane(pr0, 63), tot1 = __builtin_amdgcn_readlane(pr1, 63);
                const int exc0 = tot0 - pr0, exc1 = tot1 - pr1, inc0 = exc0 + ls0, inc1 = exc1 + ls1;
                const int hl0 = __builtin_ctzll(__ballot(exc0 < need0 && inc0 >= need0)), hl1 = __builtin_ctzll(__ballot(exc1 < need1 && inc1 >= need1));
                int d0, ab0, d1, ab1;
                { int cum = exc0; if (cum + (int)c0.w >= need0) { d0 = 3; ab0 = cum; } else { cum += (int)c0.w; if (cum + (int)c0.z >= need0) { d0 = 2; ab0 = cum; } else { cum += (int)c0.z; if (cum + (int)c0.y >= need0) { d0 = 1; ab0 = cum; } else { cum += (int)c0.y; d0 = 0; ab0 = cum; } } } }
                { int cum = exc1; if (cum + (int)c1.w >= need1) { d1 = 3; ab1 = cum; } else { cum += (int)c1.w; if (cum + (int)c1.z >= need1) { d1 = 2; ab1 = cum; } else { cum += (int)c1.z; if (cum + (int)c1.y >= need1) { d1 = 1; ab1 = cum; } else { cum += (int)c1.y; d1 = 0; ab1 = cum; } } } }
                { const int k0 = d0 == 3 ? (int)c0.w : d0 == 2 ? (int)c0.z : d0 == 1 ? (int)c0.y : (int)c0.x, k1 = d1 == 3 ? (int)c1.w : d1 == 2 ? (int)c1.z : d1 == 1 ? (int)c1.y : (int)c1.x;
                  cb0 = __builtin_amdgcn_readlane(k0, hl0); cb1 = __builtin_amdgcn_readlane(k1, hl1); }
                d0 = __builtin_amdgcn_readlane(d0 + 4 * lane, hl0); ab0 = __builtin_amdgcn_readlane(ab0, hl0); d1 = __builtin_amdgcn_readlane(d1 + 4 * lane, hl1); ab1 = __builtin_amdgcn_readlane(ab1, hl1);
                need0 -= ab0; pf0 = (pf0 << 8) | (unsigned)d0; need1 -= ab1; pf1 = (pf1 << 8) | (unsigned)d1;
                if (p < 3 && need0 == cb0 && need1 == cb1) { pf0 <<= sh; pf1 <<= sh; break; }
            }
            unsigned w0 = 0u, w1 = 0u;
            if (need0 == cb0 && need1 == cb1) {
#pragma unroll
                for (int i = 0; i < 32; ++i) if ((i >> 3) < nb) { const unsigned long long mt0 = __ballot(u0[i] >= pf0), mt1 = __ballot(u1[i] >= pf1);
                    w0 = lane == 2 * i ? (unsigned)mt0 : (lane == 2 * i + 1 ? (unsigned)(mt0 >> 32) : w0); w1 = lane == 2 * i ? (unsigned)mt1 : (lane == 2 * i + 1 ? (unsigned)(mt1 >> 32) : w1); }
            } else {
                int tb0 = 0, tb1 = 0;
#pragma unroll
                for (int i = 0; i < 32; ++i) if ((i >> 3) < nb) {
                    const bool e0 = u0[i] == pf0, e1 = u1[i] == pf1;
                    const unsigned long long me0 = __ballot(e0), me1 = __ballot(e1);
                    const int r0 = tb0 + (int)__builtin_amdgcn_mbcnt_hi((unsigned)(me0 >> 32), __builtin_amdgcn_mbcnt_lo((unsigned)me0, 0u)), r1 = tb1 + (int)__builtin_amdgcn_mbcnt_hi((unsigned)(me1 >> 32), __builtin_amdgcn_mbcnt_lo((unsigned)me1, 0u));
                    const unsigned long long mt0 = __ballot(u0[i] > pf0 || (e0 && r0 < need0)), mt1 = __ballot(u1[i] > pf1 || (e1 && r1 < need1));
                    w0 = lane == 2 * i ? (unsigned)mt0 : (lane == 2 * i + 1 ? (unsigned)(mt0 >> 32) : w0); w1 = lane == 2 * i ? (unsigned)mt1 : (lane == 2 * i + 1 ? (unsigned)(mt1 >> 32) : w1);
                    tb0 += __popcll(me0); tb1 += __popcll(me1);
                }
            }
            bm0[lane] = w0; bm1[lane] = w1;
        }
    }
    __syncthreads();
    {
        bf16x8 Bq[2][2];
        {
#pragma unroll
          for (int nt = 0; nt < 2; ++nt) { const v4u w0 = qraw[nt][0], w1 = qraw[nt][1];
            float x[16] = {bf_lo(w0.x), bf_hi(w0.x), bf_lo(w0.y), bf_hi(w0.y), bf_lo(w0.z), bf_hi(w0.z), bf_lo(w0.w), bf_hi(w0.w),
                           bf_lo(w1.x), bf_hi(w1.x), bf_lo(w1.y), bf_hi(w1.y), bf_lo(w1.z), bf_hi(w1.z), bf_lo(w1.w), bf_hi(w1.w)};
            float ss = 0.f;
#pragma unroll
            for (int j = 0; j < 16; ++j) ss += x[j] * x[j];
            ss += __shfl_xor(ss, 16); ss += __shfl_xor(ss, 32);
            const float rs = (0.125f * 1.44269504089f) / sqrtf(ss * (1.f / 64.f) + NORM_EPS);
            Bq[nt][0] = pack8((f32x4){x[0] * rs * g0[0], x[1] * rs * g0[1], x[2] * rs * g0[2], x[3] * rs * g0[3]}, (f32x4){x[4] * rs * g1[0], x[5] * rs * g1[1], x[6] * rs * g1[2], x[7] * rs * g1[3]});
            Bq[nt][1] = pack8((f32x4){x[8] * rs * g2[0], x[9] * rs * g2[1], x[10] * rs * g2[2], x[11] * rs * g2[3]}, (f32x4){x[12] * rs * g3[0], x[13] * rs * g3[1], x[14] * rs * g3[2], x[15] * rs * g3[3]}); } }
        bf16x8 Bmk[2];
#pragma unroll
        for (int nt = 0; nt < 2; ++nt) { const int jq = 4 * qq + 2 * nt + (fr >> 3) - 8 * fq; v4u w;
            w.x = (jq == 0 ? 0x3F80u : 0u) | (jq == 1 ? 0x3F800000u : 0u); w.y = (jq == 2 ? 0x3F80u : 0u) | (jq == 3 ? 0x3F800000u : 0u);
            w.z = (jq == 4 ? 0x3F80u : 0u) | (jq == 5 ? 0x3F800000u : 0u); w.w = (jq == 6 ? 0x3F80u : 0u) | (jq == 7 ? 0x3F800000u : 0u);
            Bmk[nt] = __builtin_bit_cast(bf16x8, w); }
        att_mask_tile(BM, 0, wave, lane);
        const float m0h = ((const LAS float*)(F.lds + L_M0))[head];
        const float bias_far = BIAS[31 * 16 + head] - m0h;
        f32x4 ao[2][4];
#pragma unroll
        for (int nt = 0; nt < 2; ++nt)
#pragma unroll
            for (int dt = 0; dt < 4; ++dt) ao[nt][dt] = (f32x4){0.f, 0.f, 0.f, 0.f};
        f32x4 lsum[2] = {(f32x4){0.f, 0.f, 0.f, 0.f}, (f32x4){0.f, 0.f, 0.f, 0.f}};
        if (tid == 0) F.MISC[1] = nxt_draw;
        if (nt64 > 2) asm volatile("s_waitcnt vmcnt(8)" ::: "memory"); else if (nt64 > 1) asm volatile("s_waitcnt vmcnt(4)" ::: "memory"); else asm volatile("s_waitcnt vmcnt(0)" ::: "memory");
        LDS_WAIT(); __builtin_amdgcn_s_barrier(); asm volatile("" ::: "memory");
        {
            const int nx = q_pa_index((int)F.MISC[1]);
            if (nx >= 0) { const size_t nrow = (size_t)(nx & 7) * SEQ + (size_t)((SEQ / 16 - 1) - (nx >> 3)) * 16 + 2 * wave;
#pragma unroll
                for (int i = 0; i < 2; ++i) __builtin_amdgcn_global_load_lds((const unsigned*)(Z + (nrow + i) * NZ + C_QI + lane * 8), (LAS unsigned*)(F.lds + L_HIST + (2 * wave + i) * QI_PITCH), 16, 0, 0); }
        }
        int nfar = (qb * 16 - 113 - 63 + 64) >> 6; nfar = nfar < 0 ? 0 : (nfar > nt64 ? nt64 : nfar);
        if (!((PROBE_AT & 4) && rep == 1)) {
#pragma unroll 1
        for (int kt = 0; kt < nfar; ++kt) att_tile<true>(kt, nt64, qb, g, qq, fr, fq, head, bias_far, m0h, ST, BM, BIAS, LUT, kt0, vt0, goff, ldsw, Bq, Bmk, ao, lsum);
#pragma unroll 1
        for (int kt = nfar; kt < nt64; ++kt) att_tile<false>(kt, nt64, qb, g, qq, fr, fq, head, bias_far, m0h, ST, BM, BIAS, LUT, kt0, vt0, goff, ldsw, Bq, Bmk, ao, lsum);
        } else { asm volatile("s_waitcnt vmcnt(0)" ::: "memory"); __syncthreads(); }
#pragma unroll
        for (int nt = 0; nt < 2; ++nt) {
            float l = (lsum[nt][0] + lsum[nt][1]) + (lsum[nt][2] + lsum[nt][3]); l += __shfl_xor(l, 16); l += __shfl_xor(l, 32);
            const float inv = 1.0f / l;
            const size_t qrow = qrow0 + 4 * qq + 2 * nt + (fr >> 3);
#pragma unroll
            for (int dt = 0; dt < 4; ++dt) { const int col = head * 64 + dt * 16 + 4 * fq;
                const v2u gw = gwv[nt][dt];
                const float g0 = bf_lo(gw.x), g1 = bf_hi(gw.x), g2 = bf_lo(gw.y), g3 = bf_hi(gw.y);
                v2u o; o.x = pk2(ao[nt][dt][0] * inv * g0 * sigmoidf_(g0), ao[nt][dt][1] * inv * g1 * sigmoidf_(g1)); o.y = pk2(ao[nt][dt][2] * inv * g2 * sigmoidf_(g2), ao[nt][dt][3] * inv * g3 * sigmoidf_(g3));
                if (!(PROBE_AT && rep == 1)) *(v2u*)(OAB + qrow * (2 * D) + D + col) = o; }
        }
    }
}

template <bool FENCE>
__device__ __forceinline__ void dep_signal(Frame& F, unsigned* ctr) {
    asm volatile("s_waitcnt vmcnt(0)" ::: "memory");
    __syncthreads();
    if (FTID(F) == 0) { if (FENCE) { __builtin_amdgcn_fence(__ATOMIC_RELEASE, "agent"); asm volatile("s_waitcnt vmcnt(0)" ::: "memory"); } (void)xb_add(ctr, 1u); }
}
__device__ __forceinline__ void dep_arrive_xcd(Frame& F, unsigned* xcnt, unsigned* ctr, unsigned x) {
    asm volatile("s_waitcnt vmcnt(0)" ::: "memory");
    __syncthreads();
    if (FTID(F) == 0) { const unsigned nloc = F.MISC[8];
        if (nloc == 0u) { __builtin_amdgcn_fence(__ATOMIC_RELEASE, "agent"); asm volatile("s_waitcnt vmcnt(0)" ::: "memory"); (void)xb_add(ctr, 1u); }
        else if (xb_add(&xcnt[16 * x], 1u) + 1u == nloc) { __builtin_amdgcn_fence(__ATOMIC_RELEASE, "agent"); asm volatile("s_waitcnt vmcnt(0)" ::: "memory"); (void)xb_add(ctr, nloc); } }
}
template <bool ACQ>
__device__ __forceinline__ void dep_wait(Frame& F, unsigned* ctr, unsigned target) {
    if (FTID(F) == 0) { unsigned sp = 0u; while (xb_ld(ctr) < target) { __builtin_amdgcn_s_sleep(2); if (++sp > (1u << 24)) break; }
        if (ACQ) __builtin_amdgcn_fence(__ATOMIC_ACQUIRE, "agent"); }
    __syncthreads();
    asm volatile("" ::: "memory");
}
__device__ __forceinline__ void p3_queue(Frame& F, const Args& a, int rep) {
    { const int tid0 = FTID(F);
    { LAS float* BIAS = (LAS float*)(F.lds + L_BIAS); LAS unsigned char* LUT = (LAS unsigned char*)(F.lds + L_LUT);
      for (int i = tid0; i < 512; i += NWAVES * 64) BIAS[i] = a.in[I_RB][i] * 1.44269504089f;
      for (int d = tid0; d < 2112; d += NWAVES * 64) {
          int b = d;
          if (d >= 16) b = d < 19 ? 16 : d < 21 ? 17 : d < 24 ? 18 : d < 27 ? 19 : d < 31 ? 20 : d < 35 ? 21 : d < 40 ? 22 : d < 46 ? 23 : d < 52 ? 24 : d < 59 ? 25 : d < 67 ? 26 : d < 77 ? 27 : d < 87 ? 28 : d < 99 ? 29 : d < 113 ? 30 : 31;
          LUT[d] = (unsigned char)b; } }
    __syncthreads();
    if (tid0 < 16) {
        float gq = 0.f, gk = 0.f, mb = -INFINITY;
        for (int i = 0; i < 64; ++i) { gq = fmaxf(gq, fabsf(a.in[I_QG][i])); gk = fmaxf(gk, fabsf(a.in[I_KG][i])); }
        for (int b = 0; b < 32; ++b) mb = fmaxf(mb, ((const LAS float*)(F.lds + L_BIAS))[b * 16 + tid0]);
        ((LAS float*)(F.lds + L_M0))[tid0] = 8.f * 1.44269504089f * 1.02f * gq * gk + mb;
    }
    }
    unsigned* qctr = (unsigned*)(F.ctl + CW_QUEUE + 64 * rep);
    unsigned* p1b = (unsigned*)(F.ctl + CW_P1B); unsigned* p2p = (unsigned*)(F.ctl + CW_P2P); unsigned* p2s = (unsigned*)(F.ctl + CW_P2S);
    int okp = 0, oks = 0;
    int pf = -1, staged = 0;
    for (;;) {
        __syncthreads();
        int it;
        if (pf >= 0) it = pf;
        else { if (FTID(F) == 0) F.MISC[0] = __hip_atomic_fetch_add(qctr, 1u, RLX_AGENT);
            __syncthreads();
            it = (int)F.MISC[0]; }
        const int st = staged; pf = -1; staged = 0;
        if (it >= Q_TOTAL_) break;
        const int sub = rep == 0 ? 15 : PROBE_SUB;
        if (it < QB_PCH_) {
            if (rep == 0) { p2_rows(a, it * 256, it * 256 + 256, (it & 7) == 7 ? (it >> 3) : 0, (it & 7) == 7 ? (it >> 3) + 1 : 0, F.wave, NWAVES, FLANE()); dep_signal<false>(F, p2p); } }
        else if (it < QB_P2S_) { if (sub & 1) chain_item(F, a, (it - QB_PCH_) >> 4, (it - QB_PCH_) & 15, rep); }
        else if (it < QB_PA1_) {
            if (rep == 0) { const int j = it - QB_P2S_;
                dep_wait<false>(F, p1b, Q_SG_);
                p2_rows(a, MP + 64 * j, MP + 64 * j + 64, NB + 16 * j, NB + 16 * j + 16, F.wave, NWAVES, FLANE());
                dep_signal<false>(F, p2s); } }
        else if (it >= QB_SAT_ && it < QB_SCH_) { if (sub & 2) { if (!oks) { dep_wait<false>(F, p2s, Q_P2S_); oks = 1; } attn_item<true>(F, a, it - QB_SAT_, 0, rep); } }
        else if (it >= QB_SCH_ && it < QB_PA2_) { const int k = it - QB_SCH_; if (sub & 8) { if (!oks) { dep_wait<false>(F, p2s, Q_P2S_); oks = 1; } sample_chain_item(F, a, k >> 1, k & 1); } }
        else { const int k = q_pa_index(it);
            if (sub & 4) { if (!okp) { dep_wait<false>(F, p2p, Q_P2P_); okp = 1; }
                attn_prompt_item(F, a, k & 7, (SEQ / 16 - 1) - (k >> 3), rep, st, qctr);
                pf = (int)F.MISC[1]; staged = q_pa_index(pf) >= 0 ? 1 : 0; } }
    }
}

template <bool MERGE>
__device__ __forceinline__ void sample_rows_piece(Frame& F, const Args& a, int p) {
    const int lane = FLANE(), wave = F.wave, fr = lane & 15, fq = lane >> 4, tid = wave * 64 + lane;
    const int rt = p >> 4, ct = p & 15, r0 = MP + rt * 32, c0 = ct * 64;
    constexpr int LDA = MERGE ? 2 * D : D, KW = MERGE ? 256 : 128, NKS = KW / 32;
    const bf16* A = (const bf16*)(a.ws + (MERGE ? WS_OAB : WS_MG)) + (size_t)(r0 + fr) * LDA + wave * KW + fq * 8;
    const bf16* B = (const bf16*)(a.ws + (MERGE ? WS_WPAB : WS_WOUT)) + (size_t)(c0 + fr) * LDA + wave * KW + fq * 8;
    bf16x8 Af[2][NKS], Bf[4][NKS];
#pragma unroll
    for (int ks = 0; ks < NKS; ++ks) {
#pragma unroll
        for (int m = 0; m < 2; ++m) Af[m][ks] = *(const bf16x8*)(A + (size_t)m * 16 * LDA + ks * 32);
#pragma unroll
        for (int n = 0; n < 4; ++n) Bf[n][ks] = *(const bf16x8*)(B + (size_t)n * 16 * LDA + ks * 32); }
    f32x4 acc[2][4];
#pragma unroll
    for (int m = 0; m < 2; ++m)
#pragma unroll
        for (int n = 0; n < 4; ++n) acc[m][n] = (f32x4){0.f, 0.f, 0.f, 0.f};
#pragma unroll
    for (int ks = 0; ks < NKS; ++ks)
#pragma unroll
        for (int m = 0; m < 2; ++m)
#pragma unroll
            for (int n = 0; n < 4; ++n) acc[m][n] = __builtin_amdgcn_mfma_f32_16x16x32_bf16(Af[m][ks], Bf[n][ks], acc[m][n], 0, 0, 0);
    LAS float* P = (LAS float*)(F.lds + RING_OFF);
#pragma unroll
    for (int m = 0; m < 2; ++m)
#pragma unroll
        for (int n = 0; n < 4; ++n)
#pragma unroll
            for (int r = 0; r < 4; ++r) P[wave * 2048 + (m * 16 + 4 * fq + r) * 64 + n * 16 + fr] = acc[m][n][r];
    __syncthreads();
    const int row = tid >> 4, c4 = (tid & 15) * 4;
    f32x4 s0 = {0.f, 0.f, 0.f, 0.f}, s1 = {0.f, 0.f, 0.f, 0.f};
#pragma unroll
    for (int w = 0; w < 4; ++w) { s0 += *(const LAS f32x4*)(P + w * 2048 + row * 64 + c4); s1 += *(const LAS f32x4*)(P + (4 + w) * 2048 + row * 64 + c4); }
    if (MERGE) {
        const bf16* zr = (const bf16*)(a.ws + WS_Z) + (size_t)(r0 + row) * NZ + c0 + c4;
        const f32x4 ga = up4(*(const v2u*)(zr + C_GA)), gb = up4(*(const v2u*)(zr + C_GB));
        *(v2u*)((bf16*)(a.ws + WS_MG) + (size_t)(r0 + row) * D + c0 + c4) = dn4(s0 * ga + s1 * gb);
    } else {
        const f32x4 xv = *(const f32x4*)(a.in[I_XS] + (size_t)(r0 - MP + row) * D + c0 + c4);
        *(f32x4*)(a.out + O_Y + (size_t)(r0 + row) * D + c0 + c4) = xv + s0 + s1;
    }
    __syncthreads();
}

__global__ void __launch_bounds__(NWAVES * 64, 2) hybrid_fwd(Args args) {
    extern __shared__ __attribute__((aligned(16))) unsigned char lds[];
    Frame F;
    F.lds = (LAS unsigned char*)lds;
    F.MISC = (volatile LAS unsigned*)(F.lds + L_MISC);
    F.wave = __builtin_amdgcn_readfirstlane((int)threadIdx.x >> 6);
    F.G = gridDim.x; { const int bx = blockIdx.x; F.vcu = (F.G % 8 == 0) ? (bx % 8) * (F.G / 8) + bx / 8 : bx; }
    unsigned char* ws = args.ws;
    F.ctl = (gu32*)(ws + WS_CTL);
    { const int t0 = FTID(F); if (t0 < 32) F.MISC[t0] = 0u; }
    __syncthreads();
    XcdBarrier bar; bar.bar = (unsigned*)(F.ctl + CW_BAR) + args.li * XCD_BAR_WORDS; bar.x = 0; bar.st = nullptr; bar.wave = F.wave;
    if (MK_N_LAUNCHES == 1) bar = xcd_barrier_post((unsigned*)(F.ctl + CW_BAR) + args.li * XCD_BAR_WORDS, F.MISC + 8, F.wave);
    const int lo = args.ph_lo, hi = args.ph_hi;
#define IN(k) (lo <= (k) && (k) < hi)
#define BOTH(k) (IN(k) && IN((k) + 1))
#define GRID_BAR() xcd_barrier<true, false>(bar)

    for (int rep = 0; rep < REPS(0); ++rep)
    if (IN(0)) { p0_prologue(F, args); if (BOTH(0)) GRID_BAR(); }
    for (int rep = 0; rep < REPS(1); ++rep)
    if (IN(1)) {
        pg8::Gemm g{(const bf16*)(ws + WS_XN), (const bf16*)(ws + WS_WIN), M, NZ, D, D, D, nullptr, nullptr}; pg8::StaticOrder S; S.init(MP, NZ, F.G, (int)blockIdx.x);
        EpiZ E{(bf16*)(ws + WS_Z)};
        pg8::gemm_phase<EpiZ, pg8::StaticOrder>(F.lds + RING_OFF, g, S, E, F.wave);
        dep_arrive_xcd(F, (unsigned*)(F.ctl + CW_P1X), (unsigned*)(F.ctl + CW_P1A), bar.x);
        for (int j = (int)blockIdx.x; j < Q_SG_; j += F.G) {
            pg8::OneUnit S1{MP / 256 + j / (NZ / 256), j % (NZ / 256)}; EpiZT<true> E1{(bf16*)(ws + WS_Z)};
            pg8::gemm_phase<EpiZT<true>, pg8::OneUnit>(F.lds + RING_OFF, g, S1, E1, F.wave);
            dep_signal<false>(F, (unsigned*)(F.ctl + CW_P1B));
        }
    }
    for (int rep = 0; rep < REPS(3); ++rep)
    if (IN(3)) { if (rep == 0) dep_wait<false>(F, (unsigned*)(F.ctl + CW_P1A), (unsigned)F.G); p3_queue(F, args, rep); if (BOTH(3)) GRID_BAR(); }
    for (int rep = 0; rep < REPS(4); ++rep)
    if (IN(4)) {
        pg8::Gemm g{(const bf16*)(ws + WS_OAB), (const bf16*)(ws + WS_WPAB), MP, D, D, 2 * D, 2 * D, (const bf16*)(ws + WS_OAB) + D, (const bf16*)(ws + WS_WPAB) + D}; pg8::TwoHalfOrder S; S.init(MP, D, F.G, (int)blockIdx.x);
        EpiMerge E{(const bf16*)(ws + WS_Z), (bf16*)(ws + WS_MG)};
        pg8::gemm_phase<EpiMerge, pg8::TwoHalfOrder>(F.lds + RING_OFF, g, S, E, F.wave);
        for (int p = blockIdx.x; p < 256; p += F.G) sample_rows_piece<true>(F, args, p);
        if ((IN(4) && IN(6)) || rep + 1 < REPS(4)) GRID_BAR();
    }
    for (int rep = 0; rep < REPS(6); ++rep)
    if (IN(6)) {
        pg8::Gemm g{(const bf16*)(ws + WS_MG), (const bf16*)(ws + WS_WOUT), MP, D, D, D, D, nullptr, nullptr}; pg8::StaticOrder S; S.init(MP, D, F.G, (int)blockIdx.x);
        EpiOut E{args.in[I_XP], args.in[I_XS], args.out + O_Y};
        pg8::gemm_phase<EpiOut, pg8::StaticOrder>(F.lds + RING_OFF, g, S, E, F.wave);
        for (int p = blockIdx.x; p < 256; p += F.G) sample_rows_piece<false>(F, args, p);
        if (rep + 1 < REPS(6)) GRID_BAR();
    }
#undef IN
#undef BOTH
}

extern "C" void kernel_launch(void* const* d_in, const int* in_sizes, int n_in, void* d_out, int out_size, void* d_ws, size_t ws_size, hipStream_t stream) {
    static int grid = 0;
    if (grid == 0) {
        if (n_in != 26 || in_sizes[0] != MP * D || (size_t)out_size != O_END || ws_size < WS_END) {
            fprintf(stderr, "kernel_launch: unexpected shapes: n_in %d in0 %d out %d ws %zu (need %zu)\n", n_in, n_in > 0 ? in_sizes[0] : -1, out_size, ws_size, (size_t)WS_END); grid = -1; return; }
        int dev = 0, cus = 0, per_cu = 0;
        if (hipGetDevice(&dev) != hipSuccess || hipDeviceGetAttribute(&cus, hipDeviceAttributeMultiprocessorCount, dev) != hipSuccess) { grid = -1; return; }
        if (hipFuncSetAttribute((const void*)hybrid_fwd, hipFuncAttributeMaxDynamicSharedMemorySize, LDS_BYTES) != hipSuccess) { fprintf(stderr, "kernel_launch: hipFuncSetAttribute failed\n"); grid = -1; return; }
        if (hipOccupancyMaxActiveBlocksPerMultiprocessor(&per_cu, (const void*)hybrid_fwd, NWAVES * 64, LDS_BYTES) != hipSuccess || per_cu < 1) { fprintf(stderr, "kernel_launch: occupancy query says %d blocks per CU\n", per_cu); (void)hipGetLastError(); grid = -1; return; }
        grid = cus;
    }
    if (grid < 0) return;
    (void)hipMemsetAsync((char*)d_ws + WS_CTL, 0, CTL_ZERO_BYTES, stream);
    Args a{};
    for (int i = 0; i < 26; ++i) a.in[i] = (const float*)d_in[i];
    a.out = (float*)d_out; a.ws = (unsigned char*)d_ws;
    constexpr int NPH = 7;
#if MK_N_LAUNCHES == 1
#if defined(PROBE_PRELAUNCH_LO)
    a.ph_lo = PROBE_PRELAUNCH_LO; a.ph_hi = PROBE_PRELAUNCH_HI; a.li = 1;
    hipLaunchKernelGGL(hybrid_fwd, dim3(grid), dim3(NWAVES * 64), LDS_BYTES, stream, a);
#endif
    a.ph_lo = 0; a.ph_hi = NPH; a.li = 0;
    hipLaunchKernelGGL(hybrid_fwd, dim3(grid), dim3(NWAVES * 64), LDS_BYTES, stream, a);
#else
    for (int li = 0; li < NPH; ++li) { a.ph_lo = li; a.ph_hi = li + 1; a.li = 0; hipLaunchKernelGGL(hybrid_fwd, dim3(grid), dim3(NWAVES * 64), LDS_BYTES, stream, a); }
#endif
}
```

```cpp
#include <hip/hip_runtime.h>
#include <cstdio>
#include <cstdint>

#ifndef MK_N_LAUNCHES
#define MK_N_LAUNCHES 1
#endif
#define PROBE_DUP -1
#define PROBE_SUB 15
#define PROBE_SKIPD 0
#define PROBE_PRE2 0
#define PROBE_SEQ2 0
#define PROBE_AT 0
#define PROBE_CH 0
#define PROBE_SKIPA 0
#define PROBE_SA 0
#define PROBE_SKIPC 0
#define REPS(k) (PROBE_DUP == (k) ? 2 : 1)

__device__ __forceinline__ int lane_now() { int l; asm volatile("v_mbcnt_lo_u32_b32 %0, -1, 0\n\tv_mbcnt_hi_u32_b32 %0, -1, %0" : "=v"(l)); return l; }
namespace pg8 {
#define PG8_LAS __attribute__((address_space(3)))
typedef unsigned short bf16_t;
typedef short bf16x8 __attribute__((ext_vector_type(8)));
typedef float f32x4 __attribute__((ext_vector_type(4)));
typedef unsigned u32x4 __attribute__((ext_vector_type(4)));
constexpr int BM = 256, BK = 64, HALF = 128, HTB = HALF * BK * 2  , STAGE_BYTES = 8 * HTB, NXCD = 8, WGM = 4;

__host__ __device__ __forceinline__ int lds_byte(int r, int c) { const int st = (r >> 4) * 2 + (c >> 5), rr = r & 15, cc = c & 31, ob = rr * 64 + cc * 2; return st * 1024 + (ob ^ (((ob >> 9) & 1) << 5)); }
__host__ __device__ __forceinline__ void stage_rc(int b, int& R, int& C) { const int st = b / 1024, sb = b % 1024, swz = sb ^ (((sb >> 9) & 1) << 5); R = (st >> 1) * 16 + swz / 64; C = (st & 1) * 32 + (swz % 64) / 2; }
__host__ __device__ __forceinline__ int perm32(int rho) { const int n = rho >> 4, i = rho & 15; return 8 * (i >> 2) + 4 * n + (i & 3); }

struct Unit { int pm, pn, half; };
struct Gemm { const bf16_t* A; const bf16_t* Bt; int M, N, K, lda, ldb; const bf16_t* A2; const bf16_t* Bt2; };

struct StaticOrder {
    int nM, nN, nwg, G, c;
    __host__ __device__ void init(int M, int N, int G_, int c_) { nM = M / BM; nN = N / BM; nwg = nM * nN; G = G_; c = c_; }
    __host__ __device__ __forceinline__ bool next(int i, Unit& u) const {
        const long L = (long)i * G + c; if (L >= nwg) return false;
        int wgid = (int)L; { const int q = nwg / NXCD, r = nwg % NXCD, xcd = wgid % NXCD, off = wgid / NXCD; wgid = (xcd < r ? xcd * (q + 1) : r * (q + 1) + (xcd - r) * q) + off; }
        const int nig = WGM * nN, gid = wgid / nig, fm = gid * WGM, gsz = (nM - fm) < WGM ? (nM - fm) : WGM;
        u.pm = fm + ((wgid % nig) % gsz); u.pn = (wgid % nig) / gsz; u.half = 0; return true;
    }
    __device__ __forceinline__ void a_ready(const Unit&) const {}
    __device__ __forceinline__ void done(const Unit&) const {}
};
struct OneUnit {
    int pm, pn;
    __host__ __device__ bool next(int i, Unit& u) const { if (i != 0) return false; u.pm = pm; u.pn = pn; u.half = 0; return true; }
    __device__ __forceinline__ void a_ready(const Unit&) const {}
    __device__ __forceinline__ void done(const Unit&) const {}
};
struct TwoHalfOrder : StaticOrder {
    __host__ __device__ __forceinline__ bool next(int i, Unit& u) const { if (!StaticOrder::next(i >> 1, u)) return false; u.half = i & 1; return true; }
};

struct WaitStatic : StaticOrder {
    unsigned* ctr; int wave; unsigned target;
    __device__ __forceinline__ void a_ready(const Unit& u) const {
        if (lane_now() == 0) { unsigned sp = 0u; while (__hip_atomic_load(ctr + 16 * u.pm, __ATOMIC_RELAXED, __HIP_MEMORY_SCOPE_AGENT) < target) { __builtin_amdgcn_s_sleep(1); if (++sp > (1u << 24)) break; } }
        asm volatile("" ::: "memory");
    }
};
__device__ __forceinline__ unsigned cvt_pk_bf16(float lo, float hi) { unsigned r; asm volatile("v_cvt_pk_bf16_f32 %0, %1, %2" : "=v"(r) : "v"(lo), "v"(hi)); return r; }

template <class Epi, class Sched>
__device__ __forceinline__ void gemm_phase(PG8_LAS unsigned char* lds, const Gemm g, const Sched& S, const Epi& E, int wave_) {
    const int wid = wave_, lane = lane_now(), tid = wid * 64 + lane,
              wr = wid >> 2, wc = wid & 3, fr = lane & 15, fq = lane >> 4;
    const int K = g.K, nt = K / BK;
    unsigned voffA[2], voffB[2];
#pragma unroll
    for (int i = 0; i < 2; ++i) { int R, C; stage_rc(tid * 16 + i * 8192, R, C); const int Rb = Epi::PERM ? ((R & ~31) + perm32(R & 31)) : R;
        voffA[i] = (unsigned)(R * g.lda + C) * 2u; voffB[i] = (unsigned)(Rb * g.ldb + C) * 2u; }
    const size_t kstep = (size_t)(BK * 2);
    const size_t hstepA = (size_t)HALF * g.lda * 2, hstepB = (size_t)HALF * g.ldb * 2;
    const size_t tstepA = 2 * hstepA, tstepB = 2 * hstepB;
    const unsigned ldsw = (unsigned)wid * 1024u;
    const int aoff = lds_byte(wr * 64 + fr, fq * 8), boff = lds_byte(wc * 32 + fr, fq * 8);
#define PG8_SA(b, h) (((b) * 2 + (h)) * HTB)
#define PG8_SB(b, h) ((4 + (b) * 2 + (h)) * HTB)
#define PG8_STAGE(bufoff, gbase, voff) do { _Pragma("unroll") for (int _i = 0; _i < 2; ++_i) \
        __builtin_amdgcn_global_load_lds((const unsigned*)((const char*)(gbase) + (voff)[_i]), (PG8_LAS unsigned*)(lds + (bufoff) + ldsw + _i * 8192), 16, 0, 0); } while (0)
#define PG8_LDA(dst, b, h) do { _Pragma("unroll") for (int m = 0; m < 4; ++m) _Pragma("unroll") for (int k = 0; k < 2; ++k) dst[m][k] = *(const PG8_LAS bf16x8*)(lds + PG8_SA(b, h) + aoff + m * 2048 + k * 1024); } while (0)
#define PG8_LDB(dst, b, h) do { _Pragma("unroll") for (int n = 0; n < 2; ++n) _Pragma("unroll") for (int k = 0; k < 2; ++k) dst[n][k] = *(const PG8_LAS bf16x8*)(lds + PG8_SB(b, h) + boff + n * 2048 + k * 1024); } while (0)
#define PG8_MMA(ai, bj, At, Bt) do { __builtin_amdgcn_s_setprio(1); _Pragma("unroll") for (int m = 0; m < 4; ++m) _Pragma("unroll") for (int n = 0; n < 2; ++n) _Pragma("unroll") for (int k = 0; k < 2; ++k) \
        acc[ai][bj][m][n] = __builtin_amdgcn_mfma_f32_16x16x32_bf16(Bt[n][k], At[m][k], acc[ai][bj][m][n], 0, 0, 0); __builtin_amdgcn_s_setprio(0); } while (0)
#define PG8_WAIT_V(n) asm volatile("s_waitcnt vmcnt(" #n ")" ::: "memory")
#define PG8_WAIT_L(n) asm volatile("s_waitcnt lgkmcnt(" #n ")" ::: "memory")
#define PG8_BAR __builtin_amdgcn_s_barrier()
#define PG8_SCHED __builtin_amdgcn_sched_barrier(0)
    Unit cur, nxt; int ui = 0;
    if (!S.next(0, cur)) return;
    f32x4 acc[2][2][4][2];
#pragma unroll
    for (int a = 0; a < 2; ++a)
#pragma unroll
        for (int b = 0; b < 2; ++b)
#pragma unroll
            for (int m = 0; m < 4; ++m)
#pragma unroll
                for (int n = 0; n < 2; ++n) acc[a][b][m][n] = (f32x4){0.f, 0.f, 0.f, 0.f};
    bf16x8 At[4][2], B0[2][2], B1[2][2];
    const char* cA = (const char*)(cur.half ? g.A2 : g.A) + (size_t)cur.pm * tstepA; const char* cB = (const char*)(cur.half ? g.Bt2 : g.Bt) + (size_t)cur.pn * tstepB;
    S.a_ready(cur);
    PG8_STAGE(PG8_SB(0, 0), cB, voffB); PG8_STAGE(PG8_SA(0, 0), cA, voffA); PG8_STAGE(PG8_SB(0, 1), cB + hstepB, voffB); PG8_STAGE(PG8_SA(0, 1), cA + hstepA, voffA);
    if (wr == 1) PG8_BAR;
    PG8_WAIT_V(4); PG8_BAR;
    PG8_STAGE(PG8_SB(1, 0), cB + kstep, voffB); PG8_STAGE(PG8_SA(1, 0), cA + kstep, voffA); PG8_STAGE(PG8_SB(1, 1), cB + hstepB + kstep, voffB);
    PG8_WAIT_V(6); PG8_BAR;
    for (;;) {
        const bool has_next = S.next(ui + 1, nxt);
        const char* nA = has_next ? (const char*)(nxt.half ? g.A2 : g.A) + (size_t)nxt.pm * tstepA : cA; const char* nB = has_next ? (const char*)(nxt.half ? g.Bt2 : g.Bt) + (size_t)nxt.pn * tstepB : cB;
        for (int t = 0; t < nt; t += 2) {
            const bool last = (t == nt - 2);
            const char* a1 = cA + (size_t)(t + 1) * kstep;
            const char* a2 = last ? nA : cA + (size_t)(t + 2) * kstep; const char* b2 = last ? nB : cB + (size_t)(t + 2) * kstep;
            const char* a3 = a2 + kstep; const char* b3 = b2 + kstep;
            if (last && has_next) S.a_ready(nxt);
            PG8_LDB(B0, 0, 0); PG8_SCHED; PG8_LDA(At, 0, 0); PG8_STAGE(PG8_SA(1, 1), a1 + hstepA, voffA);
            PG8_WAIT_L(8); PG8_BAR; PG8_WAIT_L(0); PG8_MMA(0, 0, At, B0); PG8_BAR; PG8_SCHED;
            PG8_LDB(B1, 0, 1); PG8_STAGE(PG8_SB(0, 0), b2, voffB);
            PG8_BAR; PG8_WAIT_L(0); PG8_MMA(0, 1, At, B1); PG8_BAR;
            PG8_LDA(At, 0, 1); PG8_STAGE(PG8_SA(0, 0), a2, voffA);
            PG8_BAR; PG8_WAIT_L(0); PG8_MMA(1, 0, At, B0); PG8_BAR; PG8_SCHED;
            PG8_STAGE(PG8_SB(0, 1), b2 + hstepB, voffB);
            PG8_WAIT_V(6); PG8_BAR; PG8_MMA(1, 1, At, B1); PG8_BAR;
            PG8_LDB(B0, 1, 0); PG8_SCHED; PG8_LDA(At, 1, 0); PG8_STAGE(PG8_SA(0, 1), a2 + hstepA, voffA);
            PG8_WAIT_L(8); PG8_BAR; PG8_WAIT_L(0); PG8_MMA(0, 0, At, B0); PG8_BAR; PG8_SCHED;
            PG8_LDB(B1, 1, 1); PG8_STAGE(PG8_SB(1, 0), b3, voffB);
            PG8_BAR; PG8_WAIT_L(0); PG8_MMA(0, 1, At, B1); PG8_BAR;
            PG8_LDA(At, 1, 1); PG8_STAGE(PG8_SA(1, 0), a3, voffA);
            PG8_BAR; PG8_WAIT_L(0); PG8_MMA(1, 0, At, B0); PG8_BAR; PG8_SCHED;
            PG8_STAGE(PG8_SB(1, 1), b3 + hstepB, voffB);
            PG8_WAIT_V(6); PG8_BAR; PG8_MMA(1, 1, At, B1); PG8_BAR;
        }
        E(acc, cur, wr, wc, fr, fq); S.done(cur);
        if (!has_next) break;
        if (!(Epi::MID && cur.half == 0))
#pragma unroll
        for (int a = 0; a < 2; ++a)
#pragma unroll
            for (int b = 0; b < 2; ++b)
#pragma unroll
                for (int m = 0; m < 4; ++m)
#pragma unroll
                    for (int n = 0; n < 2; ++n) acc[a][b][m][n] = (f32x4){0.f, 0.f, 0.f, 0.f};
        cur = nxt; cA = nA; cB = nB; ++ui;
    }
    PG8_WAIT_V(0);
    if (wr == 0) PG8_BAR;
    PG8_BAR;
#undef PG8_SA
#undef PG8_SB
#undef PG8_STAGE
#undef PG8_LDA
#undef PG8_LDB
#undef PG8_MMA
#undef PG8_WAIT_V
#undef PG8_WAIT_L
#undef PG8_BAR
#undef PG8_SCHED
}
}

constexpr int D = 1024, NB = 8, SEQ = 2048, DB = 128, DS = 4, PAST = 2048, PAGE = 128, NPAGES = 16;
constexpr int MP = NB * SEQ;
constexpr int MS = DB * DS;
constexpr int M = MP + MS;
constexpr int NCOLS = 9160, NZ = 9216;
constexpr int RW_COLS = 4224;
constexpr int C_R = 0, C_K = 1024, C_V = 2048, C_G = 3072, C_WD = 4096, C_AD = 4160;
constexpr int C_Q = 4224, C_AK = 5248, C_AV = 5376, C_QI = 5504, C_KI = 6016, C_AG = 6080, C_GA = 7104, C_GB = 8128, C_WI = 9152;
constexpr int TOPK = 256;
constexpr float NORM_EPS = 1e-6f, LNX_EPS = 64e-5f;

constexpr size_t O_Y = 0;
constexpr size_t O_KP = (size_t)M * D;
constexpr size_t O_VP = O_KP + (size_t)MP * 128;
constexpr size_t O_KIP = O_VP + (size_t)MP * 128;
constexpr size_t O_WKVP = O_KIP + (size_t)MP * 64;
constexpr size_t O_SHP = O_WKVP + (size_t)NB * 16 * 64 * 64;
constexpr size_t O_KS = O_SHP + (size_t)NB * RW_COLS;
constexpr size_t O_VS = O_KS + (size_t)MS * 128;
constexpr size_t O_KIS = O_VS + (size_t)MS * 128;
constexpr size_t O_WKVS = O_KIS + (size_t)MS * 64;
constexpr size_t O_SHS = O_WKVS + (size_t)DB * 16 * 64 * 64;
constexpr size_t O_END = O_SHS + (size_t)DB * RW_COLS;
static_assert(O_END == 32195584, "output size");

constexpr size_t MiB = 1u << 20;
constexpr size_t WS_CTL = 0, CTL_ZERO_BYTES = 64 * 1024;
constexpr size_t WS_WIN = 2 * MiB;
constexpr size_t WS_WPAB = 20 * MiB;
constexpr size_t WS_WOUT = 24 * MiB;
constexpr size_t WS_W2T = 26 * MiB;
constexpr size_t WS_A2T = 26 * MiB + 128 * 1024;
constexpr size_t WS_XN = 32 * MiB;
constexpr size_t WS_Z = 66 * MiB;
constexpr size_t WS_KN = 364 * MiB;
constexpr size_t WS_OAB = 370 * MiB;
constexpr size_t WS_T1 = 436 * MiB;
constexpr size_t WS_MG = 502 * MiB;
constexpr size_t WS_VN = 536 * MiB;
constexpr size_t WS_KIN = 542 * MiB;
constexpr size_t WS_END = 546 * MiB;
constexpr int CW_TMO = 0, CW_QUEUE = 64, CW_BAR = 4096;
static_assert((CW_BAR + 2 * 3456) * 4 <= (int)CTL_ZERO_BYTES, "control words inside the zeroed region");

constexpr int RING_OFF = 0, RING_BYTES = 131072;
constexpr int SROW = 2068;
constexpr int L_S = 0;
constexpr int L_SEL = 132352;
constexpr int L_CNT = L_SEL + 8192;
constexpr int L_HIST = L_CNT + 64;
constexpr int LDS_BYTES = 160 * 1024;
constexpr int L_MISC = LDS_BYTES - 128;
constexpr int L_LUT = L_MISC - 2112;
constexpr int L_BIAS = L_LUT - 2048;
constexpr int L_M0 = L_BIAS - 64;
static_assert(L_HIST + 16 * 1040 <= L_M0, "LDS map");
constexpr int TC = 16;
#define GAS __attribute__((address_space(1)))
#define LAS __attribute__((address_space(3)))
typedef unsigned short bf16;
typedef unsigned v4u __attribute__((ext_vector_type(4)));
typedef unsigned v2u __attribute__((ext_vector_type(2)));
typedef float f32x4 __attribute__((ext_vector_type(4)));
typedef float f32x2 __attribute__((ext_vector_type(2)));
typedef short bf16x8 __attribute__((ext_vector_type(8)));
typedef short s16x4 __attribute__((ext_vector_type(4)));
typedef GAS unsigned gu32;
#define RLX_AGENT __ATOMIC_RELAXED, __HIP_MEMORY_SCOPE_AGENT
#define LDS_WAIT() asm volatile("s_waitcnt lgkmcnt(0)" ::: "memory")
#define VM_WAIT() asm volatile("s_waitcnt vmcnt(0)" ::: "memory")
typedef __bf16 bf16x2_t __attribute__((ext_vector_type(2)));
__device__ __forceinline__ unsigned pk2(float lo, float hi) { const f32x2 v = {lo, hi}; return __builtin_bit_cast(unsigned, __builtin_convertvector(v, bf16x2_t)); }
__device__ __forceinline__ unsigned f2bf(float f) { return pk2(f, 0.f) & 0xffffu; }
__device__ __forceinline__ float bf_lo(unsigned w) { return __builtin_bit_cast(float, w << 16); }
__device__ __forceinline__ float bf_hi(unsigned w) { return __builtin_bit_cast(float, w & 0xffff0000u); }
__device__ __forceinline__ float bf1(bf16 h) { return __builtin_bit_cast(float, (unsigned)h << 16); }
__device__ __forceinline__ float sigmoidf_(float x) { return __builtin_amdgcn_rcpf(1.0f + __expf(-x)); }

#define XB_TMO      128
#define XB_XCNT(j)  (256  + 64 * (j))
#define XB_XSUB(j)  (1280 + 64 * (j))
#define XB_XGEN(j)  (2304 + 64 * (j))
#define XB_TOP      3328
#define XB_TOPGEN   3392
#define XCD_BAR_WORDS 3456
#define XB_SPIN_CAP (1u << 22)
__device__ __forceinline__ unsigned xb_ld(unsigned* p)              { return __hip_atomic_load(p, __ATOMIC_RELAXED, __HIP_MEMORY_SCOPE_AGENT); }
__device__ __forceinline__ unsigned xb_add(unsigned* p, unsigned v) { return __hip_atomic_fetch_add(p, v, __ATOMIC_RELAXED, __HIP_MEMORY_SCOPE_AGENT); }
__device__ __forceinline__ unsigned xb_xcc_id() { return (unsigned)__builtin_amdgcn_s_getreg((3 << 11) | 20) & 0xFu; }
#define XB_SPIN(cond, bar) do { unsigned _sp = 0; while (cond) { __builtin_amdgcn_s_sleep(1); \
    if ((++_sp & 255u) == 0u) { if (xb_ld(&(bar)[XB_TMO])) break; if (_sp > XB_SPIN_CAP) { atomicAdd(&(bar)[XB_TMO], 1u); break; } } } } while (0)
struct XcdBarrier { unsigned* bar; unsigned x; volatile LAS unsigned* st; int wave; };
__device__ __forceinline__ XcdBarrier xcd_barrier_post(unsigned* bar, volatile LAS unsigned* st, int wave) {
    XcdBarrier b; b.bar = bar; b.x = xb_xcc_id(); b.st = st; b.wave = wave;
    if (wave == 0 && lane_now() == 0) (void)xb_add(&bar[XB_XCNT(b.x)], 1u);
    return b;
}
__device__ __forceinline__ void xcd_barrier_complete(unsigned* bar, unsigned x, unsigned& nloc, unsigned& nx) {
    const unsigned G = gridDim.x * gridDim.y * gridDim.z;
    unsigned sum, cnt, mine, sp = 0u;
    for (;;) {
        sum = 0u; cnt = 0u; mine = 0u;
#pragma unroll
        for (unsigned j = 0; j < 16; ++j) { const unsigned c = xb_ld(&bar[XB_XCNT(j)]); sum += c; cnt += (c > 0u) ? 1u : 0u; mine = (j == x) ? c : mine; }
        if (sum == G) break;
        __builtin_amdgcn_s_sleep(1);
        if ((++sp & 255u) == 0u) { if (xb_ld(&bar[XB_TMO])) break; if (sp > XB_SPIN_CAP) { atomicAdd(&bar[XB_TMO], 1u); break; } }
    }
    nloc = mine > 0u ? mine : 1u; nx = cnt > 0u ? cnt : 1u;
}
template <bool FENCE = true, bool ACQ = true>
__device__ __forceinline__ void xcd_barrier(const XcdBarrier& b) {
    asm volatile("s_waitcnt vmcnt(0)" ::: "memory");
    __syncthreads();
    if (b.wave == 0 && lane_now() == 0) {
        unsigned* bar = b.bar;
        __builtin_amdgcn_s_waitcnt(0);
        unsigned nloc = b.st[0], nx = b.st[1];
        if (nloc == 0u) { xcd_barrier_complete(bar, b.x, nloc, nx); b.st[0] = nloc; b.st[1] = nx; }
        const unsigned old = xb_add(&bar[XB_XSUB(b.x)], 1u);
        const unsigned gen = old / nloc;
        if (old + 1u == (gen + 1u) * nloc) {
            if (FENCE) __builtin_amdgcn_fence(__ATOMIC_RELEASE, "agent");
            asm volatile("s_waitcnt vmcnt(0)" ::: "memory");
            const unsigned og = xb_add(&bar[XB_TOP], 1u);
            const unsigned tg = og / nx;
            if (og + 1u == (tg + 1u) * nx) xb_add(&bar[XB_TOPGEN], 1u);
            else XB_SPIN(xb_ld(&bar[XB_TOPGEN]) == tg, bar);
            if (ACQ) __builtin_amdgcn_fence(__ATOMIC_ACQUIRE, "agent"); else asm volatile("" ::: "memory");
            xb_add(&bar[XB_XGEN(b.x)], 1u);
            asm volatile("s_waitcnt vmcnt(0)" ::: "memory");
        } else {
            XB_SPIN(xb_ld(&bar[XB_XGEN(b.x)]) == gen, bar);
            if (ACQ) __builtin_amdgcn_fence(__ATOMIC_ACQUIRE, "agent"); else asm volatile("" ::: "memory");
            asm volatile("s_waitcnt vmcnt(0)" ::: "memory");
        }
    }
    __syncthreads();
}

constexpr int NWAVES = 8;
struct Args { const float* in[26]; float* out; unsigned char* ws; int ph_lo, ph_hi, li, pad; };
enum { I_XP = 0, I_XS, I_CK, I_CV, I_CKI, I_SWKV, I_SSH, I_PT, I_NG, I_WIN, I_MU, I_W0, I_W2, I_A0, I_A2, I_KK, I_KA, I_RK, I_LG, I_LB, I_QG, I_KG, I_RB, I_WPA, I_WPB, I_WOUT };

struct Frame {
    LAS unsigned char* lds;
    volatile LAS unsigned* MISC;
    gu32* ctl;
    int wave, vcu, G;
};
#define FTID(F_) ((F_).wave * 64 + lane_now())
#define FLANE() lane_now()

__device__ __forceinline__ float wave_sum(float v) {
#pragma unroll
    for (int o = 1; o < 64; o <<= 1) v += __shfl_xor(v, o);
    return v;
}

__device__ __forceinline__ int win_src_col(int n) { return n < C_AG ? n : (n < C_WI ? n + 8 : (n < NCOLS ? n - C_WI + 6080 : -1)); }
__device__ __forceinline__ void p0_transpose_item(const float* W, int ldw, bool remap, bf16* WT, int ldd, int dcol0, int nblk, LAS float* scr, int item, int lane) {
    const int kb = item / nblk, nb = item % nblk, k0 = 64 * kb, n0 = 32 * nb;
    const int nsrc = remap ? win_src_col(n0 + (lane & 31)) : n0 + (lane & 31);
    const float* wp = W + (size_t)(k0 + (lane >> 5)) * ldw + (nsrc < 0 ? 0 : nsrc);
    float wv[32];
#pragma unroll
    for (int i = 0; i < 32; ++i) { wv[i] = wp[(size_t)(2 * i) * ldw]; }
#pragma unroll
    for (int i = 0; i < 32; ++i) { const int kk = 2 * i + (lane >> 5); scr[kk * 33 + (lane & 31)] = nsrc >= 0 ? wv[i] : 0.f; }
    LDS_WAIT(); asm volatile("" ::: "memory");
    const int c = lane & 7;
#pragma unroll
    for (int j = 0; j < 4; ++j) { const int n = (lane >> 3) + 8 * j; const LAS float* s = scr + (8 * c) * 33 + n;
        v4u o; o.x = pk2(s[0 * 33], s[1 * 33]); o.y = pk2(s[2 * 33], s[3 * 33]); o.z = pk2(s[4 * 33], s[5 * 33]); o.w = pk2(s[6 * 33], s[7 * 33]);
        *(GAS v4u*)(WT + (size_t)(n0 + n) * ldd + dcol0 + k0 + 8 * c) = o; }
    LDS_WAIT(); asm volatile("" ::: "memory");
}
__device__ __forceinline__ void p0_prologue(Frame& F, const Args& a) {
    const int lane0 = FLANE();
    LAS float* scr = (LAS float*)(F.lds + RING_OFF + F.wave * 16384);
    const int gw = F.vcu * NWAVES + F.wave, NGW = F.G * NWAVES;
    unsigned char* ws = a.ws;
    constexpr int I_IN = (D / 64) * (NZ / 32), I_SQ = (D / 64) * (D / 32), I_LR = (D / 32);
    constexpr int NITEMS = I_IN + 3 * I_SQ + 2 * I_LR;
    for (int it = gw; it < NITEMS; it += NGW) {
        int r = it;
        if (r < I_IN) { p0_transpose_item(a.in[I_WIN], NCOLS, true, (bf16*)(ws + WS_WIN), D, 0, NZ / 32, scr, r, lane0); continue; } r -= I_IN;
        if (r < I_SQ) { p0_transpose_item(a.in[I_WPA], D, false, (bf16*)(ws + WS_WPAB), 2 * D, 0, D / 32, scr, r, lane0); continue; } r -= I_SQ;
        if (r < I_SQ) { p0_transpose_item(a.in[I_WPB], D, false, (bf16*)(ws + WS_WPAB), 2 * D, D, D / 32, scr, r, lane0); continue; } r -= I_SQ;
        if (r < I_SQ) { p0_transpose_item(a.in[I_WOUT], D, false, (bf16*)(ws + WS_WOUT), D, 0, D / 32, scr, r, lane0); continue; } r -= I_SQ;
        if (r < I_LR) { p0_transpose_item(a.in[I_W2], D, false, (bf16*)(ws + WS_W2T), 64, 0, D / 32, scr, r, lane0); continue; } r -= I_LR;
        p0_transpose_item(a.in[I_A2], D, false, (bf16*)(ws + WS_A2T), 64, 0, D / 32, scr, r, lane0);
    }
    const GAS f32x4* g4 = (const GAS f32x4*)a.in[I_NG] + lane0;
    f32x4 gv[4];
#pragma unroll
    for (int j = 0; j < 4; ++j) gv[j] = g4[64 * j];
    for (int m0 = gw; m0 < M; m0 += 4 * NGW) {
        f32x4 v[4][4];
#pragma unroll
        for (int k = 0; k < 4; ++k) { const int m = m0 + k * NGW;
            if (m < M) { const float* xrow = m < MP ? a.in[I_XP] + (size_t)m * D : a.in[I_XS] + (size_t)(m - MP) * D; const GAS f32x4* xr = (const GAS f32x4*)xrow + lane0;
#pragma unroll
                for (int j = 0; j < 4; ++j) v[k][j] = xr[64 * j]; } }
#pragma unroll
        for (int k = 0; k < 4; ++k) { const int m = m0 + k * NGW;
            if (m < M) {
                float s = 0.f;
#pragma unroll
                for (int j = 0; j < 4; ++j) s += (v[k][j].x * v[k][j].x + v[k][j].y * v[k][j].y) + (v[k][j].z * v[k][j].z + v[k][j].w * v[k][j].w);
                const float rs = 1.f / sqrtf(wave_sum(s) * (1.f / D) + NORM_EPS);
                GAS unsigned long long* o8 = (GAS unsigned long long*)((bf16*)(ws + WS_XN) + (size_t)m * D) + lane0;
#pragma unroll
                for (int j = 0; j < 4; ++j) { const f32x4 y = v[k][j] * rs * gv[j]; o8[64 * j] = (unsigned long long)pk2(y.x, y.y) | ((unsigned long long)pk2(y.z, y.w) << 32); }
            } }
    }
}

#define ST_AGENT32(p_, v_) __hip_atomic_store((unsigned*)(p_), __builtin_bit_cast(unsigned, (v_)), __ATOMIC_RELAXED, __HIP_MEMORY_SCOPE_AGENT)
#define ST_AGENT64(p_, v_) __hip_atomic_store((unsigned long long*)(p_), __builtin_bit_cast(unsigned long long, (v_)), __ATOMIC_RELAXED, __HIP_MEMORY_SCOPE_AGENT)
#define ST_AGENT128(p_, v_) asm volatile("global_store_dwordx4 %0, %1, off sc1\n\ts_nop 1" :: "v"(p_), "v"(v_) : "memory")

template <bool WT>
struct EpiZT {
    static constexpr bool PERM = true, MID = false;
    bf16* O;
    __device__ __forceinline__ void operator()(const f32x4 (&acc)[2][2][4][2], const pg8::Unit& u, int wr, int wc, int fr, int fq) const {
        const int row0 = u.pm * 256 + wr * 64 + fr, col0 = u.pn * 256 + wc * 32 + 8 * fq;
#pragma unroll
        for (int ai = 0; ai < 2; ++ai)
#pragma unroll
            for (int m = 0; m < 4; ++m) { bf16* rowp = O + (size_t)(row0 + ai * 128 + m * 16) * NZ + col0;
#pragma unroll
                for (int bj = 0; bj < 2; ++bj) { f32x4 v0 = acc[ai][bj][m][0], v1 = acc[ai][bj][m][1];
                    const int cb = u.pn * 256 + bj * 128 + wc * 32;
                    if (cb >= C_GA && cb < C_WI) {
#pragma unroll
                        for (int e = 0; e < 4; ++e) { v0[e] = sigmoidf_(v0[e]); v1[e] = sigmoidf_(v1[e]); } }
                    v4u w; w.x = pg8::cvt_pk_bf16(v0[0], v0[1]); w.y = pg8::cvt_pk_bf16(v0[2], v0[3]); w.z = pg8::cvt_pk_bf16(v1[0], v1[1]); w.w = pg8::cvt_pk_bf16(v1[2], v1[3]);
                    if (WT) ST_AGENT128(rowp + bj * 128, w); else *(v4u*)(rowp + bj * 128) = w; } }
    }
};
typedef EpiZT<false> EpiZ;
struct EpiMerge {
    static constexpr bool PERM = true, MID = true;
    const bf16* Zb; bf16* O;
    __device__ __forceinline__ void operator()(f32x4 (&acc)[2][2][4][2], const pg8::Unit& u, int wr, int wc, int fr, int fq) const {
        const int row0 = u.pm * 256 + wr * 64 + fr, col0 = u.pn * 256 + wc * 32 + 8 * fq;
        if (u.half == 0) {
#pragma unroll
            for (int ai = 0; ai < 2; ++ai) {
                v4u gav[4][2], gbv[4][2];
#pragma unroll
                for (int m = 0; m < 4; ++m)
#pragma unroll
                    for (int bj = 0; bj < 2; ++bj) { const bf16* zr = Zb + (size_t)(row0 + ai * 128 + m * 16) * NZ + col0; gav[m][bj] = *(const v4u*)(zr + C_GA + bj * 128); gbv[m][bj] = *(const v4u*)(zr + C_GB + bj * 128); }
                asm volatile("" : "+v"(gav[0][0]), "+v"(gav[1][0]), "+v"(gav[2][0]), "+v"(gav[3][0]), "+v"(gbv[0][1]), "+v"(gbv[1][1]), "+v"(gbv[2][1]), "+v"(gbv[3][1]));
#pragma unroll
                for (int m = 0; m < 4; ++m) {
#pragma unroll
                    for (int bj = 0; bj < 2; ++bj) { const v4u ga = gav[m][bj], gb = gbv[m][bj];
#define RT_(a_, b_) ((a_) * __builtin_amdgcn_rcpf(b_))
                        f32x4& v0 = acc[ai][bj][m][0]; f32x4& v1 = acc[ai][bj][m][1];
                        v0[0] *= RT_(bf_lo(ga.x), bf_lo(gb.x)); v0[1] *= RT_(bf_hi(ga.x), bf_hi(gb.x)); v0[2] *= RT_(bf_lo(ga.y), bf_lo(gb.y)); v0[3] *= RT_(bf_hi(ga.y), bf_hi(gb.y));
                        v1[0] *= RT_(bf_lo(ga.z), bf_lo(gb.z)); v1[1] *= RT_(bf_hi(ga.z), bf_hi(gb.z)); v1[2] *= RT_(bf_lo(ga.w), bf_lo(gb.w)); v1[3] *= RT_(bf_hi(ga.w), bf_hi(gb.w));
#undef RT_
                    } } }
        } else {
            v4u gzv[2][4][2];
#pragma unroll
            for (int ai = 0; ai < 2; ++ai)
#pragma unroll
                for (int m = 0; m < 4; ++m)
#pragma unroll
                    for (int bj = 0; bj < 2; ++bj) gzv[ai][m][bj] = *(const v4u*)(Zb + (size_t)(row0 + ai * 128 + m * 16) * NZ + C_GB + col0 + bj * 128);
#pragma unroll
            for (int ai = 0; ai < 2; ++ai)
#pragma unroll
                for (int m = 0; m < 4; ++m) { const size_t row = (size_t)(row0 + ai * 128 + m * 16);
#pragma unroll
                    for (int bj = 0; bj < 2; ++bj) { const v4u gz = gzv[ai][m][bj];
                        const f32x4 v0 = acc[ai][bj][m][0], v1 = acc[ai][bj][m][1];
                        v4u w; w.x = pg8::cvt_pk_bf16(v0[0] * bf_lo(gz.x), v0[1] * bf_hi(gz.x)); w.y = pg8::cvt_pk_bf16(v0[2] * bf_lo(gz.y), v0[3] * bf_hi(gz.y));
                        w.z = pg8::cvt_pk_bf16(v1[0] * bf_lo(gz.z), v1[1] * bf_hi(gz.z)); w.w = pg8::cvt_pk_bf16(v1[2] * bf_lo(gz.w), v1[3] * bf_hi(gz.w));
                        ST_AGENT128(O + row * D + col0 + bj * 128, w); } }
        }
    }
};
struct EpiOut {
    static constexpr bool PERM = false, MID = false;
    const float* xp; const float* xs; float* Y;
    __device__ __forceinline__ void operator()(const f32x4 (&acc)[2][2][4][2], const pg8::Unit& u, int wr, int wc, int fr, int fq) const {
        const int row0 = u.pm * 256 + wr * 64 + fr, col0 = u.pn * 256 + wc * 32 + 4 * fq;
        const float* xb = u.pm < MP / 256 ? xp : xs - (size_t)MP * D;
        f32x4 xa[4][2][2], xc[4][2][2];
#pragma unroll
        for (int m = 0; m < 4; ++m)
#pragma unroll
            for (int bj = 0; bj < 2; ++bj)
#pragma unroll
                for (int n = 0; n < 2; ++n) xa[m][bj][n] = *(const f32x4*)(xb + (size_t)(row0 + m * 16) * D + col0 + bj * 128 + n * 16);
#pragma unroll
        for (int m = 0; m < 4; ++m)
#pragma unroll
            for (int bj = 0; bj < 2; ++bj)
#pragma unroll
                for (int n = 0; n < 2; ++n) xa[m][bj][n] += acc[0][bj][m][n];
#pragma unroll
        for (int m = 0; m < 4; ++m)
#pragma unroll
            for (int bj = 0; bj < 2; ++bj)
#pragma unroll
                for (int n = 0; n < 2; ++n) xc[m][bj][n] = *(const f32x4*)(xb + (size_t)(row0 + 128 + m * 16) * D + col0 + bj * 128 + n * 16);
#pragma unroll
        for (int m = 0; m < 4; ++m)
#pragma unroll
            for (int bj = 0; bj < 2; ++bj)
#pragma unroll
                for (int n = 0; n < 2; ++n) *(f32x4*)(Y + (size_t)(row0 + m * 16) * D + col0 + bj * 128 + n * 16) = xa[m][bj][n];
#pragma unroll
        for (int m = 0; m < 4; ++m)
#pragma unroll
            for (int bj = 0; bj < 2; ++bj)
#pragma unroll
                for (int n = 0; n < 2; ++n) *(f32x4*)(Y + (size_t)(row0 + 128 + m * 16) * D + col0 + bj * 128 + n * 16) = xc[m][bj][n] + acc[1][bj][m][n];
    }
};

__device__ __forceinline__ void p2_rows(const Args& a, int mbeg, int mend, int rbeg, int rend, int gw, int NGW, int lane) {
    const bf16* Z = (const bf16*)(a.ws + WS_Z); bf16* KN = (bf16*)(a.ws + WS_KN); bf16* VN = (bf16*)(a.ws + WS_VN); bf16* KIN = (bf16*)(a.ws + WS_KIN);
    const float kg0 = a.in[I_KG][(lane & 31) * 2], kg1 = a.in[I_KG][(lane & 31) * 2 + 1];
    for (int m0 = mbeg + gw; m0 < mend; m0 += 9 * NGW) {
        unsigned kw4[9], vw4[9]; bf16 ki4[9];
#pragma unroll
        for (int k = 0; k < 9; ++k) { const int m = m0 + k * NGW;
            if (m < mend) { const bf16* zr = Z + (size_t)m * NZ; kw4[k] = *(const unsigned*)(zr + C_AK + 2 * lane); vw4[k] = *(const unsigned*)(zr + C_AV + 2 * lane); ki4[k] = zr[C_KI + lane]; } }
#pragma unroll
        for (int k = 0; k < 9; ++k) { const int m = m0 + k * NGW;
            if (m < mend) {
                float* ok = m < MP ? a.out + O_KP + (size_t)m * 128 : a.out + O_KS + (size_t)(m - MP) * 128;
                float* ov = m < MP ? a.out + O_VP + (size_t)m * 128 : a.out + O_VS + (size_t)(m - MP) * 128;
                float* oi = m < MP ? a.out + O_KIP + (size_t)m * 64 : a.out + O_KIS + (size_t)(m - MP) * 64;
                const float k0 = bf_lo(kw4[k]), k1 = bf_hi(kw4[k]);
                float s = k0 * k0 + k1 * k1;
#pragma unroll
                for (int o = 1; o < 32; o <<= 1) s += __shfl_xor(s, o);
                const float rs = 1.f / sqrtf(s * (1.f / 64.f) + NORM_EPS);
                const float y0 = k0 * rs * kg0, y1 = k1 * rs * kg1;
                ST_AGENT64(ok + 2 * lane, ((f32x2){y0, y1}));
                ST_AGENT32(KN + (size_t)m * 128 + 2 * lane, pk2(y0, y1));
                ST_AGENT64(ov + 2 * lane, ((f32x2){bf_lo(vw4[k]), bf_hi(vw4[k])}));
                ST_AGENT32(VN + (size_t)m * 128 + 2 * lane, vw4[k]);
                ST_AGENT32(oi + lane, bf1(ki4[k])); __hip_atomic_store((unsigned short*)(KIN + (size_t)m * 64 + lane), (unsigned short)ki4[k], __ATOMIC_RELAXED, __HIP_MEMORY_SCOPE_AGENT);
            } }
    }
    for (int r = rbeg + gw; r < rend; r += NGW) {
        const size_t m = r < NB ? (size_t)r * SEQ + SEQ - 1 : (size_t)MP + (size_t)(r - NB) * DS + DS - 1;
        const bf16* zr = Z + m * NZ; float* os = r < NB ? a.out + O_SHP + (size_t)r * RW_COLS : a.out + O_SHS + (size_t)(r - NB) * RW_COLS;
        unsigned w[33];
#pragma unroll
        for (int i = 0; i < 33; ++i) w[i] = *(const unsigned*)(zr + 2 * lane + 128 * i);
#pragma unroll
        for (int i = 0; i < 33; ++i) *(f32x2*)(os + 2 * lane + 128 * i) = (f32x2){bf_lo(w[i]), bf_hi(w[i])};
    }
}

#define DPP_ADD(x, ctrl) (x) += __builtin_bit_cast(float, __builtin_amdgcn_mov_dpp(__builtin_bit_cast(int, (x)), (ctrl), 0xF, 0xF, true))
__device__ __forceinline__ float sum8(float x) { DPP_ADD(x, 0xB1); DPP_ADD(x, 0x4E); DPP_ADD(x, 0x141); return x; }
__device__ __forceinline__ float half_sum(float v) {
#pragma unroll
    for (int o = 1; o < 32; o <<= 1) v += __shfl_xor(v, o);
    return v;
}

__device__ __forceinline__ float wsum(float x) {
    DPP_ADD(x, 0xB1); DPP_ADD(x, 0x4E); DPP_ADD(x, 0x141); DPP_ADD(x, 0x140);
    const int xi = __builtin_bit_cast(int, x);
    return (__builtin_bit_cast(float, __builtin_amdgcn_readlane(xi, 0)) + __builtin_bit_cast(float, __builtin_amdgcn_readlane(xi, 16)))
         + (__builtin_bit_cast(float, __builtin_amdgcn_readlane(xi, 32)) + __builtin_bit_cast(float, __builtin_amdgcn_readlane(xi, 48)));
}
__device__ __forceinline__ float fast_tanh(float x) { const float e = __expf(2.f * x); return 1.f - 2.f * __builtin_amdgcn_rcpf(e + 1.f); }

__device__ __forceinline__ bf16x8 pack8(const f32x4 lo, const f32x4 hi) {
    v4u w; w.x = pk2(lo[0], lo[1]); w.y = pk2(lo[2], lo[3]); w.z = pk2(hi[0], hi[1]); w.w = pk2(hi[2], hi[3]); return __builtin_bit_cast(bf16x8, w);
}
__device__ __forceinline__ unsigned sortable(float x) { const unsigned b = __builtin_bit_cast(unsigned, x); return b ^ ((b >> 31) ? 0xFFFFFFFFu : 0x80000000u); }
constexpr int PA = 136, PS = 160, PY = 72;
constexpr int CR_A = 0, CR_B = 16 * PA, CR_P = 32 * PA, CR_YO = CR_P  , CR_BN = CR_YO + 64 * PY, CR_KS = CR_BN + 16 * PS, CR_VS = CR_KS + 16 * PS, CR_GC = CR_VS + 16 * PS, CR_BYTES = CR_GC + 256;
constexpr int LC_CS = 8 * CR_BYTES, LC_XS = LC_CS + 13 * 256, CS_SAMPLE = 11 * 256;
static_assert(CR_BYTES == 16896 && LC_XS + 16384 <= L_M0 && LC_CS + 8 * CS_SAMPLE <= L_M0, "chain LDS map");
enum { CS_MU = 0  , CS_KK = 6, CS_KA = 7, CS_RK = 8, CS_W0 = 9, CS_A0 = 10, CS_LG = 11, CS_LB = 12 };

__device__ __forceinline__ float rowsum16(float x) { DPP_ADD(x, 0xB1); DPP_ADD(x, 0x4E); DPP_ADD(x, 0x141); DPP_ADD(x, 0x140); return x; }
__device__ __forceinline__ f32x4 up4(v2u w) { return (f32x4){bf_lo(w.x), bf_hi(w.x), bf_lo(w.y), bf_hi(w.y)}; }
__device__ __forceinline__ v2u dn4(f32x4 v) { v2u w; w.x = pk2(v[0], v[1]); w.y = pk2(v[2], v[3]); return w; }
__device__ __forceinline__ bf16x8 pk4z(f32x4 v) { v4u w; w.x = pk2(v[0], v[1]); w.y = pk2(v[2], v[3]); w.z = 0u; w.w = 0u; return __builtin_bit_cast(bf16x8, w); }
__device__ __forceinline__ bf16x8 cat8(v2u lo, v2u hi) { v4u w; w.x = lo.x; w.y = lo.y; w.z = hi.x; w.w = hi.y; return __builtin_bit_cast(bf16x8, w); }
__device__ __forceinline__ f32x4 exp4(f32x4 v) { return (f32x4){__expf(v[0]), __expf(v[1]), __expf(v[2]), __expf(v[3])}; }
__device__ __forceinline__ f32x4 sig4(f32x4 v) { return (f32x4){sigmoidf_(v[0]), sigmoidf_(v[1]), sigmoidf_(v[2]), sigmoidf_(v[3])}; }
#define MFMA16(A_, B_, C_) __builtin_amdgcn_mfma_f32_16x16x32_bf16((A_), (B_), (C_), 0, 0, 0)
#define ZERO4 ((f32x4){0.f, 0.f, 0.f, 0.f})

__device__ __forceinline__ void wkv_load_raw(v2u (&raw)[5][6], const bf16* Z, size_t row0, int T, int tc0, int h, bool sample, const float* shift_row, int fr, int fq) {
    const int segcol[6] = {C_R + h * 64, C_K + h * 64, C_V + h * 64, C_G + h * 64, C_WD, C_AD};
#pragma unroll
    for (int k = 0; k < 5; ++k) { int tg = tc0 + 4 * fq + k - 1; const bool first = tg < 0; tg = tg < 0 ? 0 : (tg >= T ? T - 1 : tg); const bf16* zr = Z + (row0 + tg) * NZ + 4 * fr;
#pragma unroll
        for (int s = 0; s < 6; ++s) {
            if (first) { if (sample) { const f32x4 x = *(const f32x4*)(shift_row + segcol[s] + 4 * fr); raw[k][s] = dn4(x); } else raw[k][s] = (v2u){0u, 0u}; }
            else raw[k][s] = *(const v2u*)(zr + segcol[s]); } }
}

template <bool GLOBALW>
__device__ __forceinline__ void wkv_pre(LAS unsigned char* R, const LAS float* CS, const LAS unsigned char* W2l, const LAS unsigned char* A2l, const bf16* W2g, const bf16* A2g, const v2u (&raw)[5][6], int tvalid, v2u (&vkp)[4], v2u (&gkp)[4], float (&bon)[4], int fr, int fq) {
    f32x4 zk[4];
    {
        f32x4 mu[6];
#pragma unroll
        for (int s = 0; s < 6; ++s) mu[s] = *(const LAS f32x4*)(CS + (CS_MU + s) * 64 + 4 * fr);
#pragma unroll
        for (int r = 0; r < 4; ++r) {
            f32x4 z[6];
#pragma unroll
            for (int s = 0; s < 6; ++s) { const f32x4 cur = up4(raw[r + 1][s]), prv = up4(raw[r][s]); z[s] = cur + (prv - cur) * mu[s]; }
            zk[r] = z[1]; vkp[r] = dn4(z[2]); gkp[r] = dn4(z[3]);
            *(LAS f32x2*)(R + CR_KS + (4 * fq + r) * PS + 8 * fr) = (f32x2){z[0][0], z[0][1]}; *(LAS f32x2*)(R + CR_VS + (4 * fq + r) * PS + 8 * fr) = (f32x2){z[0][2], z[0][3]};
            const f32x4 zw = {fast_tanh(z[4][0]), fast_tanh(z[4][1]), fast_tanh(z[4][2]), fast_tanh(z[4][3])};
            *(LAS v2u*)(R + CR_A + (4 * fq + r) * PA + 8 * fr) = dn4(zw); *(LAS v2u*)(R + CR_B + (4 * fq + r) * PA + 8 * fr) = dn4(z[5]);
        }
#pragma unroll
        for (int r = 0; r < 4; ++r) asm volatile("" : "+v"(zk[r]), "+v"(vkp[r]), "+v"(gkp[r]));
    }
    f32x4 lw[4], av[4];
    {
        const bf16x8 Aw0 = *(const LAS bf16x8*)(R + CR_A + fr * PA + fq * 16), Aw1 = *(const LAS bf16x8*)(R + CR_A + fr * PA + 64 + fq * 16);
        const bf16x8 Aa0 = *(const LAS bf16x8*)(R + CR_B + fr * PA + fq * 16), Aa1 = *(const LAS bf16x8*)(R + CR_B + fr * PA + 64 + fq * 16);
        f32x4 cw[4], ca[4];
#pragma unroll
        for (int nt = 0; nt < 4; ++nt) {
            bf16x8 Bw0, Bw1, Ba0, Ba1;
            if (GLOBALW) { const GAS bf16* w2 = (const GAS bf16*)W2g + (size_t)(4 * fr + nt) * 64 + fq * 8; const GAS bf16* a2 = (const GAS bf16*)A2g + (size_t)(4 * fr + nt) * 64 + fq * 8;
                Bw0 = *(const GAS bf16x8*)w2; Bw1 = *(const GAS bf16x8*)(w2 + 32); Ba0 = *(const GAS bf16x8*)a2; Ba1 = *(const GAS bf16x8*)(a2 + 32); }
            else { const LAS unsigned char* w2 = W2l + (4 * fr + nt) * 128; const LAS unsigned char* a2 = A2l + (4 * fr + nt) * 128;
                Bw0 = *(const LAS bf16x8*)(w2 + 16 * (fq ^ (fr & 7))); Bw1 = *(const LAS bf16x8*)(w2 + 16 * ((4 + fq) ^ (fr & 7)));
                Ba0 = *(const LAS bf16x8*)(a2 + 16 * (fq ^ (fr & 7))); Ba1 = *(const LAS bf16x8*)(a2 + 16 * ((4 + fq) ^ (fr & 7))); }
            cw[nt] = MFMA16(Aw0, Bw0, ZERO4); cw[nt] = MFMA16(Aw1, Bw1, cw[nt]);
            ca[nt] = MFMA16(Aa0, Ba0, ZERO4); ca[nt] = MFMA16(Aa1, Ba1, ca[nt]);
        }
        const f32x4 w0 = *(const LAS f32x4*)(CS + CS_W0 * 64 + 4 * fr), a0 = *(const LAS f32x4*)(CS + CS_A0 * 64 + 4 * fr);
#pragma unroll
        for (int r = 0; r < 4; ++r) { const f32x4 dw = {cw[0][r], cw[1][r], cw[2][r], cw[3][r]}, da = {ca[0][r], ca[1][r], ca[2][r], ca[3][r]};
            lw[r] = sig4(w0 + dw) * (-0.6065306597f); av[r] = sig4(a0 + da); }
    }
    f32x4 cl[4];
    {
#pragma unroll
        for (int r = 0; r < 4; ++r) if (4 * fq + r >= tvalid) lw[r] = ZERO4;
        f32x4 c[4]; c[0] = lw[0]; c[1] = c[0] + lw[1]; c[2] = c[1] + lw[2]; c[3] = c[2] + lw[3];
        f32x4 e = ZERO4;
#pragma unroll
        for (int j = 0; j < 4; ++j) { const float t1 = __shfl_up(c[3][j], 16), t2 = __shfl_up(c[3][j], 32), t3 = __shfl_up(c[3][j], 48); e[j] = (fq >= 1 ? t1 : 0.f) + (fq >= 2 ? t2 : 0.f) + (fq >= 3 ? t3 : 0.f); }
#pragma unroll
        for (int r = 0; r < 4; ++r) cl[r] = c[r] + e;
        if (fq == 3) *(LAS f32x4*)(R + CR_GC + 16 * fr) = exp4(cl[3]);
    }
    {
        const f32x4 kkc = *(const LAS f32x4*)(CS + CS_KK * 64 + 4 * fr), kac = *(const LAS f32x4*)(CS + CS_KA * 64 + 4 * fr), rkc = *(const LAS f32x4*)(CS + CS_RK * 64 + 4 * fr);
#pragma unroll
        for (int r = 0; r < 4; ++r) {
            const bool ok = 4 * fq + r < tvalid;
            const f32x4 kk = zk[r] * kkc; const float ss = rowsum16((kk[0] * kk[0] + kk[1] * kk[1]) + (kk[2] * kk[2] + kk[3] * kk[3]));
            const float rn = ok ? __builtin_amdgcn_rcpf(fmaxf(__builtin_amdgcn_sqrtf(ss), 1e-12f)) : 0.f;
            const f32x4 kkn = kk * rn;
            const f32x4 km = ok ? zk[r] * ((av[r] - 1.f) * kac + 1.f) : ZERO4;
            const f32x2 zlo = *(const LAS f32x2*)(R + CR_KS + (4 * fq + r) * PS + 8 * fr), zhi = *(const LAS f32x2*)(R + CR_VS + (4 * fq + r) * PS + 8 * fr);
            const f32x4 rr = ok ? (f32x4){zlo.x, zlo.y, zhi.x, zhi.y} : ZERO4;
            const f32x4 bt = rr * km * rkc; bon[r] = rowsum16((bt[0] + bt[1]) + (bt[2] + bt[3]));
            const f32x4 gi = exp4(-cl[r]);
            const f32x4 Amv = exp4(cl[r] - lw[r]) * kkn, Vmv = ok ? up4(vkp[r]) : ZERO4;
            const f32x4 Bmv = kkn * av[r] * gi, Kmv = km * gi, Pmv = exp4(cl[r]) * rr;
            *(LAS v2u*)(R + CR_A + (4 * fq + r) * PA + 8 * fr) = dn4(Amv); *(LAS v2u*)(R + CR_B + (4 * fq + r) * PA + 8 * fr) = dn4(Bmv); *(LAS v2u*)(R + CR_P + (4 * fq + r) * PA + 8 * fr) = dn4(Pmv);
            *(LAS v2u*)(R + CR_BN + (4 * fq + r) * PS + 8 * fr) = dn4(-Bmv); *(LAS v2u*)(R + CR_KS + (4 * fq + r) * PS + 8 * fr) = dn4(Kmv); *(LAS v2u*)(R + CR_VS + (4 * fq + r) * PS + 8 * fr) = dn4(Vmv);
        }
    }
    f32x4 G, Lm, G2, H1, H2;
    {
        const bf16x8 fA0 = *(const LAS bf16x8*)(R + CR_A + fr * PA + fq * 16), fA1 = *(const LAS bf16x8*)(R + CR_A + fr * PA + 64 + fq * 16);
        const bf16x8 fB0 = *(const LAS bf16x8*)(R + CR_B + fr * PA + fq * 16), fB1 = *(const LAS bf16x8*)(R + CR_B + fr * PA + 64 + fq * 16);
        const bf16x8 fK0 = *(const LAS bf16x8*)(R + CR_KS + fr * PS + fq * 16), fK1 = *(const LAS bf16x8*)(R + CR_KS + fr * PS + 64 + fq * 16);
        const bf16x8 fP0 = *(const LAS bf16x8*)(R + CR_P + fr * PA + fq * 16), fP1 = *(const LAS bf16x8*)(R + CR_P + fr * PA + 64 + fq * 16);
        G = MFMA16(fB0, fA0, ZERO4); G = MFMA16(fB1, fA1, G);
        Lm = MFMA16(fA0, fB0, ZERO4); Lm = MFMA16(fA1, fB1, Lm);
        G2 = MFMA16(fK0, fA0, ZERO4); G2 = MFMA16(fK1, fA1, G2);
        H1 = MFMA16(fB0, fP0, ZERO4); H1 = MFMA16(fB1, fP1, H1);
        H2 = MFMA16(fK0, fP0, ZERO4); H2 = MFMA16(fK1, fP1, H2);
#pragma unroll
        for (int r = 0; r < 4; ++r) { const int s = 4 * fq + r, t = fr;
            G[r] = s < t ? G[r] : 0.f; Lm[r] = s > t ? Lm[r] : 0.f; G2[r] = s < t ? G2[r] : 0.f; H1[r] = s <= t ? H1[r] : 0.f; H2[r] = s <= t ? H2[r] : 0.f; }
    }
    f32x4 Tm;
    {
        f32x4 Id;
#pragma unroll
        for (int r = 0; r < 4; ++r) Id[r] = (4 * fq + r == fr) ? 1.f : 0.f;
        const f32x4 Gs = MFMA16(pk4z(Lm), pk4z(G), ZERO4), Ls = MFMA16(pk4z(G), pk4z(Lm), ZERO4);
        const f32x4 Gq = MFMA16(pk4z(Ls), pk4z(Gs), ZERO4), Lq = MFMA16(pk4z(Gs), pk4z(Ls), ZERO4);
        const f32x4 Go = MFMA16(pk4z(Lq), pk4z(Gq), ZERO4);
        const f32x4 M1 = MFMA16(pk4z(Id + Lq), pk4z(Id + Go), ZERO4);
        const f32x4 M2 = MFMA16(pk4z(Id + Ls), pk4z(M1), ZERO4);
        Tm = MFMA16(pk4z(Id - Lm), pk4z(M2), ZERO4);
    }
    {
        const bf16x8 aT = pk4z(Tm), aG2 = pk4z(G2), aH1n = pk4z(-H1), aH2 = pk4z(H2);
        f32x4 Am[4], Pm[4], Vm[4];
#pragma unroll
        for (int r = 0; r < 4; ++r) { Am[r] = up4(*(const LAS v2u*)(R + CR_A + (4 * fq + r) * PA + 8 * fr)); Pm[r] = up4(*(const LAS v2u*)(R + CR_P + (4 * fq + r) * PA + 8 * fr)); Vm[r] = (4 * fq + r < tvalid) ? up4(vkp[r]) : ZERO4; }
        asm volatile("" ::: "memory");
#pragma unroll
        for (int nt = 0; nt < 4; ++nt) {
            const f32x4 amc = {Am[0][nt], Am[1][nt], Am[2][nt], Am[3][nt]}, vmc = {Vm[0][nt], Vm[1][nt], Vm[2][nt], Vm[3][nt]}, pmc = {Pm[0][nt], Pm[1][nt], Pm[2][nt], Pm[3][nt]};
            const f32x4 At = MFMA16(aT, pk4z(amc), ZERO4);
            const f32x4 Q = MFMA16(aG2, pk4z(vmc), ZERO4);
            const f32x4 Yt = MFMA16(aT, pk4z(Q), ZERO4);
            const f32x4 Pt = MFMA16(aH1n, pk4z(At), pmc);
            f32x4 Ol = MFMA16(aH2, pk4z(vmc), ZERO4); Ol = MFMA16(aH1n, pk4z(Yt), Ol);
#pragma unroll
            for (int r = 0; r < 4; ++r) {
                *(LAS unsigned short*)(R + CR_A + (4 * fq + r) * PA + (4 * fr + nt) * 2) = (unsigned short)f2bf(At[r]);
                *(LAS unsigned short*)(R + CR_B + (4 * fq + r) * PA + (4 * fr + nt) * 2) = (unsigned short)f2bf(Pt[r]); }
            *(LAS v2u*)(R + CR_YO + (4 * fr + nt) * PY + 8 * fq) = dn4(Yt); *(LAS v2u*)(R + CR_YO + (4 * fr + nt) * PY + 32 + 8 * fq) = dn4(Ol);
        }
    }
}

struct SeqOps { bf16x8 At0, At1, Pt0, Pt1; v2u yv, ov, vt; };
__device__ __forceinline__ v2u tr_read(const LAS unsigned char* p) { return __builtin_bit_cast(v2u, __builtin_amdgcn_ds_read_tr16_b64_v4i16((LAS s16x4*)p)); }
__device__ __forceinline__ void wkv_seq_load(const LAS unsigned char* R, SeqOps& o, int cb, int fr, int fq) {
    const int ic = 16 * cb + fr;
    const LAS unsigned char* ar = R + CR_A + fr * PA + 8 * fq; const LAS unsigned char* pr = R + CR_B + fr * PA + 8 * fq;
    o.At0 = cat8(*(const LAS v2u*)ar, *(const LAS v2u*)(ar + 32)); o.At1 = cat8(*(const LAS v2u*)(ar + 64), *(const LAS v2u*)(ar + 96));
    o.Pt0 = cat8(*(const LAS v2u*)pr, *(const LAS v2u*)(pr + 32)); o.Pt1 = cat8(*(const LAS v2u*)(pr + 64), *(const LAS v2u*)(pr + 96));
    const LAS unsigned char* yo = R + CR_YO + ic * PY;
    o.yv = *(const LAS v2u*)(yo + 8 * fq); o.ov = *(const LAS v2u*)(yo + 32 + 8 * fq);
    o.vt = tr_read(R + CR_VS + (4 * fq + (fr >> 2)) * PS + (16 * cb + 4 * (fr & 3)) * 2);
}
__device__ __forceinline__ void wkv_seq_step(LAS unsigned char* R, const SeqOps& o, f32x4 (&X)[4], int cb, int fr, int fq) {
    f32x4 gc[4]; bf16x8 Aj[4];
    const LAS unsigned char* trb = R + (4 * fq + (fr >> 2)) * PS + 4 * (fr & 3) * 2;
#pragma unroll
    for (int jt = 0; jt < 4; ++jt) { Aj[jt] = cat8(tr_read(trb + CR_BN + 32 * jt), tr_read(trb + CR_KS + 32 * jt)); gc[jt] = *(const LAS f32x4*)(R + CR_GC + (16 * jt + 4 * fq) * 4); }
    const bf16x8 Bx0 = pack8(X[0], X[1]), Bx1 = pack8(X[2], X[3]);
    const f32x4 U0 = MFMA16(o.At0, Bx0, up4(o.yv)), U1 = MFMA16(o.At1, Bx1, ZERO4);
    f32x4 O = MFMA16(o.Pt0, Bx0, up4(o.ov)); O = MFMA16(o.Pt1, Bx1, O);
    const bf16x8 Bu = cat8(dn4(U0 + U1), o.vt);
#pragma unroll
    for (int jt = 0; jt < 4; ++jt) X[jt] = MFMA16(Aj[jt], Bu, X[jt]) * gc[jt];
    *(LAS v2u*)(R + CR_YO + (16 * cb + fr) * PY + 8 * fq) = dn4(O);
}
__device__ __forceinline__ void wkv_seq(LAS unsigned char* R, f32x4 (&X)[4], int cb, int fr, int fq) { SeqOps o; wkv_seq_load(R, o, cb, fr, fq); asm volatile("" ::: "memory"); wkv_seq_step(R, o, X, cb, fr, fq); }

template <bool WT = false>
__device__ __forceinline__ void wkv_post(const LAS unsigned char* R, const f32x4 lg, const f32x4 lb, const v2u (&vkp)[4], const v2u (&gkp)[4], const float (&bon)[4], int tvalid, bf16* oab_row0, int fr, int fq) {
    f32x4 o[4];
#pragma unroll
    for (int nt = 0; nt < 4; ++nt) { const f32x4 c = up4(*(const LAS v2u*)(R + CR_YO + (4 * fr + nt) * PY + 8 * fq)); o[0][nt] = c[0]; o[1][nt] = c[1]; o[2][nt] = c[2]; o[3][nt] = c[3]; }
#pragma unroll
    for (int r = 0; r < 4; ++r) {
        const float mean = rowsum16((o[r][0] + o[r][1]) + (o[r][2] + o[r][3])) * (1.f / 64.f); const f32x4 d = o[r] - mean;
        const float var = rowsum16((d[0] * d[0] + d[1] * d[1]) + (d[2] * d[2] + d[3] * d[3])) * (1.f / 64.f);
        const f32x4 gv = up4(gkp[r]);
        f32x4 y = d * __builtin_amdgcn_rsqf(var + LNX_EPS) * lg + lb + up4(vkp[r]) * bon[r];
        y = y * gv * sig4(gv);
        if (4 * fq + r < tvalid) { if (WT) ST_AGENT64(oab_row0 + (size_t)(4 * fq + r) * (2 * D) + 4 * fr, dn4(y)); else *(v2u*)(oab_row0 + (size_t)(4 * fq + r) * (2 * D) + 4 * fr) = dn4(y); }
    }
}

__device__ __forceinline__ void wkv_consts(LAS float* CS, const Args& a, int h, int tid, int nthreads, int nrows) {
    const int segcol[6] = {C_R + h * 64, C_K + h * 64, C_V + h * 64, C_G + h * 64, C_WD, C_AD};
    for (int e = tid; e < nrows * 64; e += nthreads) { const int row = e >> 6, c = e & 63; float v;
        if (row < 6) v = a.in[I_MU][segcol[row] + c];
        else { const float* src = row == CS_KK ? a.in[I_KK] : row == CS_KA ? a.in[I_KA] : row == CS_RK ? a.in[I_RK] : row == CS_W0 ? a.in[I_W0] : row == CS_A0 ? a.in[I_A0] : row == CS_LG ? a.in[I_LG] : a.in[I_LB]; v = src[h * 64 + c]; }
        CS[e] = v; }
}

__device__ __forceinline__ void wkv_consts_wave(LAS float* CS, const Args& a, int h, int lane) {
    const int segcol[6] = {C_R + h * 64, C_K + h * 64, C_V + h * 64, C_G + h * 64, C_WD, C_AD};
    float v[11];
#pragma unroll
    for (int i = 0; i < 6; ++i) v[i] = a.in[I_MU][segcol[i] + lane];
    v[CS_KK] = a.in[I_KK][h * 64 + lane]; v[CS_KA] = a.in[I_KA][h * 64 + lane]; v[CS_RK] = a.in[I_RK][h * 64 + lane]; v[CS_W0] = a.in[I_W0][h * 64 + lane]; v[CS_A0] = a.in[I_A0][h * 64 + lane];
#pragma unroll
    for (int i = 0; i < 11; ++i) CS[i * 64 + lane] = v[i];
}

__device__ __forceinline__ void chain_item(Frame& F, const Args& a, int b, int h, int rep) {
    int tidv = FTID(F); asm volatile("" : "+v"(tidv));
    const int tid = tidv, lane = tidv & 63, wave = __builtin_amdgcn_readfirstlane(tidv >> 6), fr = lane & 15, fq = lane >> 4;
    const bf16* Z = (const bf16*)(a.ws + WS_Z); bf16* OAB = (bf16*)(a.ws + WS_OAB);
    const size_t row0 = (size_t)b * SEQ;
    LAS unsigned char* L = F.lds; LAS float* CS = (LAS float*)(L + LC_CS); LAS unsigned char* R = L + wave * CR_BYTES;
    wkv_consts(CS, a, h, tid, NWAVES * 64, 13);
    v2u raw[5][6];
    wkv_load_raw(raw, Z, row0, SEQ, wave * 16, h, false, nullptr, fr, fq);
    if (wave < 4) { LAS f32x4* xs = (LAS f32x4*)(L + LC_XS + wave * 4096) + lane;
#pragma unroll
        for (int jt = 0; jt < 4; ++jt) xs[64 * jt] = ZERO4; }
    __syncthreads();
    for (int grp = 0; grp < SEQ / (16 * NWAVES); ++grp) {
        const int c = grp * NWAVES + wave;
        v2u vk[4], gk[4]; float bon[4];
        int lg_ = lane; asm volatile("" : "+v"(lg_)); const int frg = lg_ & 15, fqg = lg_ >> 4;
        unsigned lb = (unsigned)(size_t)L; asm volatile("" : "+s"(lb));
        LAS unsigned char* Lg = (LAS unsigned char*)(size_t)lb; const LAS float* CSg = (const LAS float*)(Lg + LC_CS); LAS unsigned char* Rg = Lg + wave * CR_BYTES;
        unsigned long long wp_ = (unsigned long long)(size_t)((const bf16*)(a.ws + WS_W2T) + (size_t)h * 64 * 64); asm volatile("" : "+s"(wp_));
        const bf16* w2g = (const bf16*)(size_t)wp_;
        if (!((PROBE_CH & 1) && rep == 1)) wkv_pre<true>(Rg, CSg, nullptr, nullptr, w2g, w2g + (WS_A2T - WS_W2T) / 2, raw, 16, vk, gk, bon, frg, fqg);
        else { for (int r_ = 0; r_ < 4; ++r_) { vk[r_] = raw[r_][0]; gk[r_] = raw[r_][1]; bon[r_] = 0.f; } }
        asm volatile("" ::: "memory");
        if (grp + 1 < SEQ / (16 * NWAVES)) wkv_load_raw(raw, Z, row0, SEQ, (c + NWAVES) * 16, h, false, nullptr, frg, fqg);
        LDS_WAIT(); __builtin_amdgcn_s_barrier(); asm volatile("" ::: "memory");
        if (wave < 4) {
            LAS f32x4* xs = (LAS f32x4*)(Lg + LC_XS + wave * 4096) + lg_;
            f32x4 X[4];
#pragma unroll
            for (int jt = 0; jt < 4; ++jt) X[jt] = xs[64 * jt];
            if (!((PROBE_CH & 2) && rep == 1)) {
                SeqOps oa, ob;
                wkv_seq_load(Lg, oa, wave, frg, fqg);
#pragma unroll 1
                for (int cc = 0; cc < NWAVES; cc += 2) {
                    wkv_seq_load(Lg + (cc + 1) * CR_BYTES, ob, wave, frg, fqg);
                    wkv_seq_step(Lg + cc * CR_BYTES, oa, X, wave, frg, fqg);
                    if (cc + 2 < NWAVES) wkv_seq_load(Lg + (cc + 2) * CR_BYTES, oa, wave, frg, fqg);
                    wkv_seq_step(Lg + (cc + 1) * CR_BYTES, ob, X, wave, frg, fqg);
                }
            }
#pragma unroll
            for (int jt = 0; jt < 4; ++jt) xs[64 * jt] = X[jt];
        }
        LDS_WAIT(); __builtin_amdgcn_s_barrier(); asm volatile("" ::: "memory");
        if (!((PROBE_CH & 4) && rep == 1)) wkv_post(Rg, *(const LAS f32x4*)(CSg + CS_LG * 64 + 4 * frg), *(const LAS f32x4*)(CSg + CS_LB * 64 + 4 * frg), vk, gk, bon, (PROBE_CH && rep == 1) ? 0 : 16, OAB + (row0 + (size_t)c * 16) * (2 * D) + h * 64, frg, fqg);
    }
    if (wave < 4 && !(PROBE_CH && rep == 1)) { float* st = a.out + O_WKVP + ((size_t)(b * 16 + h) * 64 + 16 * wave + fr) * 64 + 4 * fq; const LAS f32x4* xs = (const LAS f32x4*)(L + LC_XS + wave * 4096) + lane;
#pragma unroll
        for (int jt = 0; jt < 4; ++jt) *(f32x4*)(st + 16 * jt) = xs[64 * jt]; }
}

__device__ __forceinline__ void sample_chain_item(Frame& F, const Args& a, int seq, int hh) {
    int tidv = FTID(F); asm volatile("" : "+v"(tidv));
    const int lane = tidv & 63, wave = __builtin_amdgcn_readfirstlane(tidv >> 6), fr = lane & 15, fq = lane >> 4;
    const int h = hh * 8 + wave;
    const bf16* Z = (const bf16*)(a.ws + WS_Z); bf16* OAB = (bf16*)(a.ws + WS_OAB);
    const size_t row0 = (size_t)MP + (size_t)seq * DS;
    LAS unsigned char* R = F.lds + wave * CR_BYTES; LAS float* CS = (LAS float*)(F.lds + LC_CS + wave * CS_SAMPLE);
    const f32x4 lgv = *(const f32x4*)(a.in[I_LG] + h * 64 + 4 * fr), lbv = *(const f32x4*)(a.in[I_LB] + h * 64 + 4 * fr);
    wkv_consts_wave(CS, a, h, lane);
    v2u raw[5][6];
    wkv_load_raw(raw, Z, row0, DS, 0, h, true, a.in[I_SSH] + (size_t)seq * RW_COLS, fr, fq);
    v2u vk[4], gk[4]; float bon[4];
    wkv_pre<true>(R, CS, nullptr, nullptr, (const bf16*)(a.ws + WS_W2T) + (size_t)h * 64 * 64, (const bf16*)(a.ws + WS_A2T) + (size_t)h * 64 * 64, raw, DS, vk, gk, bon, fr, fq);
    {
        const float* si = a.in[I_SWKV] + ((size_t)(seq * 16 + h) * 64 + fr) * 64 + 4 * fq; float* so = a.out + O_WKVS + ((size_t)(seq * 16 + h) * 64 + fr) * 64 + 4 * fq;
        f32x4 X[4][4];
#pragma unroll
        for (int cb = 0; cb < 4; ++cb)
#pragma unroll
            for (int jt = 0; jt < 4; ++jt) X[cb][jt] = *(const f32x4*)(si + (size_t)cb * 16 * 64 + 16 * jt);
#pragma unroll
        for (int cb = 0; cb < 4; ++cb) {
            wkv_seq(R, X[cb], cb, fr, fq);
#pragma unroll
            for (int jt = 0; jt < 4; ++jt) *(f32x4*)(so + (size_t)cb * 16 * 64 + 16 * jt) = X[cb][jt];
        }
    }
    wkv_post<true>(R, lgv, lbv, vk, gk, bon, DS, OAB + row0 * (2 * D) + h * 64, fr, fq);
}


template <bool SAMPLE>
__device__ __forceinline__ void attn_item(Frame& F, const Args& a, int seq, int qb, int rep) {
    int tidv = FTID(F); asm volatile("" : "+v"(tidv));
    const int lane = tidv & 63, wave = __builtin_amdgcn_readfirstlane(tidv >> 6), fr = lane & 15, fq = lane >> 4;
    const bf16* Z = (const bf16*)(a.ws + WS_Z); const bf16* KN = (const bf16*)(a.ws + WS_KN);
    bf16* OAB = (bf16*)(a.ws + WS_OAB);
    LAS int* PT = (LAS int*)(F.lds + L_MISC + 64);
    if (SAMPLE) { if (tidv < NPAGES) PT[tidv] = ((const int*)a.in[I_PT])[seq * NPAGES + tidv]; __syncthreads(); }
    LAS float* S = (LAS float*)(F.lds + L_S); LAS unsigned short* SEL = (LAS unsigned short*)(F.lds + L_SEL); LAS int* CNT = (LAS int*)(F.lds + L_CNT);
    const LAS float* BIAS = (const LAS float*)(F.lds + L_BIAS); const LAS unsigned char* LUT = (const LAS unsigned char*)(F.lds + L_LUT);
    constexpr int NQ = SAMPLE ? DS : 16;
    const size_t qrow0 = SAMPLE ? (size_t)MP + (size_t)seq * DS : (size_t)seq * SEQ + (size_t)qb * 16;
    const size_t krow0 = SAMPLE ? (size_t)MP + (size_t)seq * DS : (size_t)seq * SEQ;
    const int ntiles = SAMPLE ? (PAST + DS + 15) / 16 : qb + 1;
    static_assert(SAMPLE && NQ == 4, "attn_item: the sample form only");
    {
        bf16x8 Bqi[2][2];
        float w01[2];
        { const bf16* zq = Z + (qrow0 + (fr >> 2)) * NZ;
#pragma unroll
          for (int c = 0; c < 2; ++c) { const int hh = 4 * c + (fr & 3);
              Bqi[c][0] = *(const bf16x8*)(zq + C_QI + hh * 64 + fq * 8); Bqi[c][1] = *(const bf16x8*)(zq + C_QI + hh * 64 + fq * 8 + 32);
              w01[c] = bf1(zq[C_WI + hh]) * 0.04419417382f; } }
        constexpr int NF = 6; f32x4 Rp[NF][4];
        auto ld_tile = [&](int kt, f32x4 (&R)[4]) {
            const int key = kt * 16 + fr;
            const int knew = (key - PAST) < DS ? (key - PAST) : DS - 1;
            const float* kp = (key >= PAST ? a.out + O_KIS + ((size_t)seq * DS + knew) * 64 : a.in[I_CKI] + ((size_t)PT[(key < PAST ? key : 0) >> 7] * PAGE + (key & (PAGE - 1))) * 64) + fq * 8;
            R[0] = *(const f32x4*)kp; R[1] = *(const f32x4*)(kp + 4); R[2] = *(const f32x4*)(kp + 32); R[3] = *(const f32x4*)(kp + 36);
        };
#pragma unroll
        for (int i = 0; i < NF; ++i) { const int kt = wave + NWAVES * i; if (kt < ntiles) ld_tile(kt, Rp[i]); }
        if (!((PROBE_SA & 1) && rep == 1))
        for (int kt0 = wave; kt0 < ntiles; kt0 += NF * NWAVES) {
#pragma unroll
            for (int i = 0; i < NF; ++i) { const int kt = kt0 + NWAVES * i;
                if (kt < ntiles) {
                    const bf16x8 Ak0 = pack8(Rp[i][0], Rp[i][1]), Ak1 = pack8(Rp[i][2], Rp[i][3]);
                    if (kt + NF * NWAVES < ntiles) ld_tile(kt + NF * NWAVES, Rp[i]);
                    f32x4 c0 = {0.f, 0.f, 0.f, 0.f}, c1 = {0.f, 0.f, 0.f, 0.f};
                    c0 = __builtin_amdgcn_mfma_f32_16x16x32_bf16(Ak0, Bqi[0][0], c0, 0, 0, 0); c0 = __builtin_amdgcn_mfma_f32_16x16x32_bf16(Ak1, Bqi[0][1], c0, 0, 0, 0);
                    c1 = __builtin_amdgcn_mfma_f32_16x16x32_bf16(Ak0, Bqi[1][0], c1, 0, 0, 0); c1 = __builtin_amdgcn_mfma_f32_16x16x32_bf16(Ak1, Bqi[1][1], c1, 0, 0, 0);
                    f32x4 sc;
#pragma unroll
                    for (int r = 0; r < 4; ++r) { float t = w01[0] * fmaxf(c0[r], 0.f) + w01[1] * fmaxf(c1[r], 0.f);
                        DPP_ADD(t, 0xB1); DPP_ADD(t, 0x4E);
                        sc[r] = t + 0.0f; }
                    if ((fr & 3) == 0) *(LAS f32x4*)(S + (fr >> 2) * SROW + kt * 16 + 4 * fq) = sc;
                } }
        }
    }
    __syncthreads();
    {
        const int nqw = SAMPLE ? (wave < DS ? 1 : 0) : 2;
        for (int qq = 0; qq < nqw; ++qq) {
            const int q = SAMPLE ? wave : 2 * wave + qq;
            const int n = SAMPLE ? PAST + q + 1 : qb * 16 + q + 1;
            LAS unsigned short* sel = SEL + q * TOPK;
            if (n <= TOPK || ((PROBE_SA & 2) && rep == 1)) {
#pragma unroll
                for (int i = 0; i < 4; ++i) { const int idx = lane + 64 * i; if (idx < n) sel[idx] = (unsigned short)idx; }
                if (lane == 0) CNT[q] = n < TOPK ? n : TOPK;
            } else {
                unsigned u[33];
#pragma unroll
                for (int b3 = 0; b3 < 3; ++b3) {
                    float xs[11];
#pragma unroll
                    for (int j = 0; j < 11; ++j) { const int idx = lane + 64 * (11 * b3 + j); xs[j] = S[q * SROW + (idx < SROW ? idx : SROW - 1)]; }
                    asm volatile("" : "+v"(xs[0]), "+v"(xs[1]), "+v"(xs[2]), "+v"(xs[3]), "+v"(xs[4]), "+v"(xs[5]), "+v"(xs[6]), "+v"(xs[7]), "+v"(xs[8]), "+v"(xs[9]), "+v"(xs[10]));
#pragma unroll
                    for (int j = 0; j < 11; ++j) { const int i = 11 * b3 + j, idx = lane + 64 * i; u[i] = idx < n ? sortable(xs[j]) : 0u; }
                }
                unsigned Tv = 0u;
                for (int bit = 31; bit >= 0; --bit) {
                    const unsigned cand = Tv | (1u << bit); int c = 0;
#pragma unroll
                    for (int i = 0; i < 33; ++i) c += __popcll(__ballot(u[i] >= cand));
                    if (c >= TOPK) Tv = cand;
                }
                int G = 0;
#pragma unroll
                for (int i = 0; i < 33; ++i) G += __popcll(__ballot(u[i] > Tv));
                const int need = TOPK - G;
                int base = 0, tb = 0;
#pragma unroll
                for (int i = 0; i < 33; ++i) {
                    const bool gt = u[i] > Tv, eq = u[i] == Tv;
                    const unsigned long long meq = __ballot(eq);
                    const int trank = tb + (int)__builtin_amdgcn_mbcnt_hi((unsigned)(meq >> 32), __builtin_amdgcn_mbcnt_lo((unsigned)meq, 0u));
                    const bool take = gt || (eq && trank < need);
                    const unsigned long long mt = __ballot(take);
                    const int pos = base + (int)__builtin_amdgcn_mbcnt_hi((unsigned)(mt >> 32), __builtin_amdgcn_mbcnt_lo((unsigned)mt, 0u));
                    if (take) sel[pos] = (unsigned short)(lane + 64 * i);
                    base += __popcll(mt); tb += __popcll(meq);
                }
                if (lane == 0) CNT[q] = TOPK;
            }
        }
    }
    __syncthreads();
    LAS unsigned char* VST = F.lds + L_S + wave * 8192;
    if (!((PROBE_SA & 4) && rep == 1))
    for (int un = wave; un < NQ * 2; un += NWAVES) {
        const int q = un >> 1, g = un & 1;
        const int cnt = __builtin_amdgcn_readfirstlane(CNT[q]); const int pos = SAMPLE ? PAST + q : qb * 16 + q;
        const size_t qrow = qrow0 + q;
        const int head = g * 8 + (fr & 7);
        const LAS unsigned short* sel = SEL + q * TOPK;
        bf16x8 Bq0, Bq1;
        { const bf16* qp = Z + qrow * NZ + C_Q + head * 64 + fq * 8; const v4u w0 = *(const v4u*)qp, w1 = *(const v4u*)(qp + 32);
          float x[16] = {bf_lo(w0.x), bf_hi(w0.x), bf_lo(w0.y), bf_hi(w0.y), bf_lo(w0.z), bf_hi(w0.z), bf_lo(w0.w), bf_hi(w0.w),
                         bf_lo(w1.x), bf_hi(w1.x), bf_lo(w1.y), bf_hi(w1.y), bf_lo(w1.z), bf_hi(w1.z), bf_lo(w1.w), bf_hi(w1.w)};
          float ss = 0.f;
#pragma unroll
          for (int j = 0; j < 16; ++j) ss += x[j] * x[j];
          ss += __shfl_xor(ss, 16); ss += __shfl_xor(ss, 32);
          const float rs = (0.125f * 1.44269504089f) / sqrtf(ss * (1.f / 64.f) + NORM_EPS);
          const f32x4 g0 = *(const f32x4*)(a.in[I_QG] + fq * 8), g1 = *(const f32x4*)(a.in[I_QG] + fq * 8 + 4), g2 = *(const f32x4*)(a.in[I_QG] + 32 + fq * 8), g3 = *(const f32x4*)(a.in[I_QG] + 36 + fq * 8);
          Bq0 = pack8((f32x4){x[0] * rs * g0[0], x[1] * rs * g0[1], x[2] * rs * g0[2], x[3] * rs * g0[3]}, (f32x4){x[4] * rs * g1[0], x[5] * rs * g1[1], x[6] * rs * g1[2], x[7] * rs * g1[3]});
          Bq1 = pack8((f32x4){x[8] * rs * g2[0], x[9] * rs * g2[1], x[10] * rs * g2[2], x[11] * rs * g2[3]}, (f32x4){x[12] * rs * g3[0], x[13] * rs * g3[1], x[14] * rs * g3[2], x[15] * rs * g3[3]}); }
        f32x4 RB[16];
        float alpha[4]; bf16x8 Pf[4][2];
        float mrun = -INFINITY, sum = 0.f;
#define SA_FENCE asm volatile("" ::: "memory"); __builtin_amdgcn_sched_barrier(0)
#define SA_LDK(j, s) do { const int slot_ = (j) * 16 + fr; const int key_ = sel[slot_ < cnt ? slot_ : cnt - 1]; \
            const float* kp_ = (key_ >= PAST ? a.out + O_KS + ((size_t)seq * DS + (key_ - PAST)) * 128 : a.in[I_CK] + ((size_t)PT[(key_ < PAST ? key_ : 0) >> 7] * PAGE + (key_ & (PAGE - 1))) * 128) + g * 64 + fq * 8; \
            RB[4 * (s)] = *(const f32x4*)kp_; RB[4 * (s) + 1] = *(const f32x4*)(kp_ + 4); RB[4 * (s) + 2] = *(const f32x4*)(kp_ + 32); RB[4 * (s) + 3] = *(const f32x4*)(kp_ + 36); } while (0)
#define SA_LDV(i, p) do { const int r_ = (lane >> 3) + 8 * ((i) & 7); const int slot_ = ((i) >> 3) * 64 + r_; const int key_ = sel[slot_ < cnt ? slot_ : cnt - 1]; \
            const float* vp_ = (key_ >= PAST ? a.out + O_VS + ((size_t)seq * DS + (key_ - PAST)) * 128 : a.in[I_CV] + ((size_t)PT[(key_ < PAST ? key_ : 0) >> 7] * PAGE + (key_ & (PAGE - 1))) * 128) + g * 64 + (lane & 7) * 8; \
            RB[2 * (p)] = *(const f32x4*)vp_; RB[2 * (p) + 1] = *(const f32x4*)(vp_ + 4); } while (0)
#define SA_VPAIR(i) ((i) & 7)
#pragma unroll
        for (int j = 0; j < 4; ++j) SA_LDK(j, j);
        SA_FENCE;
        {
            float lg[4][4];
#pragma unroll
            for (int j = 0; j < 16; ++j) {
                const int t4 = j & 3, ch = j >> 2, sl = j & 3, sb = j * 16;
                const bf16x8 Ak0 = pack8(RB[4 * sl], RB[4 * sl + 1]), Ak1 = pack8(RB[4 * sl + 2], RB[4 * sl + 3]);
                f32x4 c = {0.f, 0.f, 0.f, 0.f};
                c = __builtin_amdgcn_mfma_f32_16x16x32_bf16(Ak0, Bq0, c, 0, 0, 0); c = __builtin_amdgcn_mfma_f32_16x16x32_bf16(Ak1, Bq1, c, 0, 0, 0);
                SA_FENCE;
                if (j + 4 < 16) SA_LDK(j + 4, sl); else { SA_LDV(2 * (j - 12), 2 * sl); SA_LDV(2 * (j - 12) + 1, 2 * sl + 1); }
                SA_FENCE;
                const v2u kw = *(const LAS v2u*)(sel + sb + 4 * fq);
                const int k4[4] = {(int)(kw.x & 0xffffu), (int)(kw.x >> 16), (int)(kw.y & 0xffffu), (int)(kw.y >> 16)};
                int li4[4]; float bv4[4];
#pragma unroll
                for (int r = 0; r < 4; ++r) { const bool ok = (sb + 4 * fq + r) < cnt; li4[r] = (int)LUT[ok ? pos - k4[r] : 0]; }
#pragma unroll
                for (int r = 0; r < 4; ++r) bv4[r] = BIAS[li4[r] * 16 + head];
                asm volatile("" : "+v"(bv4[0]), "+v"(bv4[1]), "+v"(bv4[2]), "+v"(bv4[3]));
#pragma unroll
                for (int r = 0; r < 4; ++r) { const bool ok = (sb + 4 * fq + r) < cnt; lg[t4][r] = ok ? c[r] + bv4[r] : -INFINITY; }
                if (t4 == 3) {
                    float mx = mrun;
#pragma unroll
                    for (int u4 = 0; u4 < 4; ++u4)
#pragma unroll
                        for (int r = 0; r < 4; ++r) mx = fmaxf(mx, lg[u4][r]);
                    mx = fmaxf(mx, __shfl_xor(mx, 16)); mx = fmaxf(mx, __shfl_xor(mx, 32));
                    alpha[ch] = __builtin_amdgcn_exp2f(mrun - mx); mrun = mx;
                    float ps = 0.f;
#pragma unroll
                    for (int u4 = 0; u4 < 4; ++u4)
#pragma unroll
                        for (int r = 0; r < 4; ++r) { lg[u4][r] = __builtin_amdgcn_exp2f(lg[u4][r] - mx); ps += lg[u4][r]; }
                    sum = sum * alpha[ch] + ps;
#pragma unroll
                    for (int k2 = 0; k2 < 2; ++k2) Pf[ch][k2] = pack8((f32x4){lg[2 * k2][0], lg[2 * k2][1], lg[2 * k2][2], lg[2 * k2][3]}, (f32x4){lg[2 * k2 + 1][0], lg[2 * k2 + 1][1], lg[2 * k2 + 1][2], lg[2 * k2 + 1][3]});
                }
            }
        }
        f32x4 ao[4];
#pragma unroll
        for (int dt = 0; dt < 4; ++dt) ao[dt] = (f32x4){0.f, 0.f, 0.f, 0.f};
#pragma unroll
        for (int i = 0; i < 32; ++i) {
            const int ch = i >> 3, pr = SA_VPAIR(i);
            { const int r = (lane >> 3) + 8 * (i & 7), c16 = lane & 7;
              *(LAS v4u*)(VST + r * 128 + 16 * (c16 ^ (r & 7))) = __builtin_bit_cast(v4u, pack8(RB[2 * pr], RB[2 * pr + 1])); }
            SA_FENCE;
            if (i + 8 < 32) SA_LDV(i + 8, pr);
            SA_FENCE;
            if ((i & 7) == 7) {
#pragma unroll
                for (int dt = 0; dt < 4; ++dt) ao[dt] = ao[dt] * alpha[ch];
#pragma unroll
                for (int k2 = 0; k2 < 2; ++k2) { const int ra = k2 * 32 + 4 * fq + (fr >> 2), rb = ra + 16;
#pragma unroll
                    for (int dt = 0; dt < 4; ++dt) { const int c16 = 2 * dt + ((fr & 3) >> 1), sub = 8 * (fr & 1);
                        const s16x4 va = __builtin_amdgcn_ds_read_tr16_b64_v4i16((LAS s16x4*)(VST + ra * 128 + 16 * (c16 ^ (ra & 7)) + sub));
                        const s16x4 vb = __builtin_amdgcn_ds_read_tr16_b64_v4i16((LAS s16x4*)(VST + rb * 128 + 16 * (c16 ^ (rb & 7)) + sub));
                        const bf16x8 Av = {va[0], va[1], va[2], va[3], vb[0], vb[1], vb[2], vb[3]};
                        ao[dt] = __builtin_amdgcn_mfma_f32_16x16x32_bf16(Av, Pf[ch][k2], ao[dt], 0, 0, 0); } }
                SA_FENCE;
            }
        }
#undef SA_FENCE
#undef SA_LDK
#undef SA_LDV
#undef SA_VPAIR
        sum += __shfl_xor(sum, 16); sum += __shfl_xor(sum, 32);
        if (fr < 8) {
            const float inv = 1.0f / sum;
#pragma unroll
            for (int dt = 0; dt < 4; ++dt) { const int col = head * 64 + dt * 16 + 4 * fq;
                const v2u gw = *(const v2u*)(Z + qrow * NZ + C_AG + col);
                const float g0 = bf_lo(gw.x), g1 = bf_hi(gw.x), g2 = bf_lo(gw.y), g3 = bf_hi(gw.y);
                v2u o; o.x = pk2(ao[dt][0] * inv * g0 * sigmoidf_(g0), ao[dt][1] * inv * g1 * sigmoidf_(g1)); o.y = pk2(ao[dt][2] * inv * g2 * sigmoidf_(g2), ao[dt][3] * inv * g3 * sigmoidf_(g3));
                if (!(PROBE_SA && rep == 1)) ST_AGENT64(OAB + qrow * (2 * D) + D + col, o); }
        }
    }
}

__device__ __forceinline__ int kv_rowpos(int key, int g) { return key * 2 + (g ^ (((key >> 2) ^ (key >> 3)) & 1)); }
__device__ __forceinline__ int kv_sw(int key) { return 2 * (key & 3) + ((key >> 3) & 1); }

__device__ __forceinline__ void glds16_asm(const void* gsrc, unsigned lds_dst) {
    unsigned keep;
    asm volatile("s_mov_b32 %0, m0\n\ts_mov_b32 m0, %2\n\ts_nop 0\n\tglobal_load_lds_dwordx4 %1, off\n\ts_mov_b32 m0, %0" : "=&s"(keep) : "v"(gsrc), "s"(lds_dst) : "memory");
}
__device__ __forceinline__ void att_dma(LAS unsigned char* stw, const bf16* kt, const bf16* vt, const unsigned (&goff)[2]) {
    const unsigned d = (unsigned)__builtin_amdgcn_readfirstlane((int)(unsigned)(size_t)stw);
    const bf16* k0 = kt + goff[0]; const bf16* v0 = vt + goff[0]; const bf16* k1 = kt + goff[1]; const bf16* v1 = vt + goff[1];
    unsigned keep;
    asm volatile("s_mov_b32 %0, m0\n\t"
                 "s_mov_b32 m0, %5\n\ts_nop 0\n\tglobal_load_lds_dwordx4 %1, off\n\t"
                 "s_add_u32 m0, %5, 0x4000\n\ts_nop 0\n\tglobal_load_lds_dwordx4 %2, off\n\t"
                 "s_add_u32 m0, %5, 0x400\n\ts_nop 0\n\tglobal_load_lds_dwordx4 %3, off\n\t"
                 "s_add_u32 m0, %5, 0x4400\n\ts_nop 0\n\tglobal_load_lds_dwordx4 %4, off\n\t"
                 "s_mov_b32 m0, %0"
                 : "=&s"(keep) : "v"(k0), "v"(v0), "v"(k1), "v"(v1), "s"(d) : "memory", "scc");
}
constexpr int BMP = 65, MT_OFFW = 16 * BMP;
static_assert((MT_OFFW * 4) % 32 == 0 && MT_OFFW * 4 + 4096 <= 8192 + 64, "mask images");
__device__ __forceinline__ void att_mask_tile(const LAS unsigned* BM, int kt, int wave, int lane) {
    const int key = wave * 8 + (lane >> 3), qp = lane & 7;
    const unsigned w0 = BM[(2 * qp) * BMP + kt * 2 + (key >> 5)], w1 = BM[(2 * qp + 1) * BMP + kt * 2 + (key >> 5)];
    const unsigned b0 = (w0 >> (key & 31)) & 1u, b1 = (w1 >> (key & 31)) & 1u;
    ((LAS unsigned*)BM)[MT_OFFW + (kt & 1) * 512 + key * 8 + qp] = (b0 ? 0u : 0xC76Au) | (b1 ? 0u : 0xC76A0000u);
}
template <bool FAR>
__device__ __forceinline__ void att_tile(int kt, int nt64, int qb, int g, int qq, int fr, int fq, int head, float bias_far, float m0h, LAS unsigned char* ST, const LAS unsigned* BM, const LAS float* BIAS, const LAS unsigned char* LUT,
                                         const bf16* kt0, const bf16* vt0, const unsigned (&goff)[2], unsigned ldsw,
                                         const bf16x8 (&Bq)[2][2], const bf16x8 (&Bmk)[2], f32x4 (&ao)[2][4], f32x4 (&lsum)[2]) {
    LAS unsigned char* Kb = ST + (kt & 3) * 32768; LAS unsigned char* Vb = Kb + 16384;
    const LAS unsigned char* MTb = (const LAS unsigned char*)(BM + MT_OFFW) + (kt & 1) * 2048;
    f32x4 cq[2][4];
    {
        bf16x8 Ak[4][2], Am[4];
#pragma unroll
        for (int sub = 0; sub < 4; ++sub) { const int krw = sub * 16 + fr; const int rp = kv_rowpos(krw, g) * 128;
            Ak[sub][0] = *(const LAS bf16x8*)(Kb + rp + 16 * (fq ^ kv_sw(krw))); Ak[sub][1] = *(const LAS bf16x8*)(Kb + rp + 16 * ((4 + fq) ^ kv_sw(krw)));
            Am[sub] = *(const LAS bf16x8*)(MTb + krw * 32 + 16 * (fq & 1)); }
        if (kt + 1 < nt64) att_mask_tile(BM, kt + 1, g * 4 + qq, fq * 16 + fr);
        if (kt + 3 < nt64) att_dma(ST + ((kt + 3) & 3) * 32768 + ldsw, kt0 + (size_t)(kt + 3) * 8192, vt0 + (size_t)(kt + 3) * 8192, goff);
        float bvn[2][4][4];
        if (!FAR) {
            int li[2][4][4];
#pragma unroll
            for (int nt = 0; nt < 2; ++nt)
#pragma unroll
                for (int sub = 0; sub < 4; ++sub)
#pragma unroll
                    for (int r = 0; r < 4; ++r) { const int dd = qb * 16 + 4 * qq + 2 * nt + (fr >> 3) - (kt * 64 + sub * 16 + 4 * fq) - r; li[nt][sub][r] = (int)LUT[dd < 0 ? 0 : dd]; }
#pragma unroll
            for (int nt = 0; nt < 2; ++nt)
#pragma unroll
                for (int sub = 0; sub < 4; ++sub)
#pragma unroll
                    for (int r = 0; r < 4; ++r) bvn[nt][sub][r] = BIAS[li[nt][sub][r] * 16 + head] - m0h;
        }
#pragma unroll
        for (int nt = 0; nt < 2; ++nt) {
#pragma unroll
            for (int sub = 0; sub < 4; ++sub) {
                f32x4 cin;
#pragma unroll
                for (int r = 0; r < 4; ++r) cin[r] = FAR ? bias_far : bvn[nt][sub][r];
                cq[nt][sub] = __builtin_amdgcn_mfma_f32_16x16x32_bf16(Am[sub], Bmk[nt], cin, 0, 0, 0);
                cq[nt][sub] = __builtin_amdgcn_mfma_f32_16x16x32_bf16(Ak[sub][0], Bq[nt][0], cq[nt][sub], 0, 0, 0);
            }
        }
#pragma unroll
        for (int sub = 0; sub < 4; ++sub)
#pragma unroll
            for (int nt = 0; nt < 2; ++nt) cq[nt][sub] = __builtin_amdgcn_mfma_f32_16x16x32_bf16(Ak[sub][1], Bq[nt][1], cq[nt][sub], 0, 0, 0);
    }
    bf16x8 Pf[2][2];
#pragma unroll
    for (int nt = 0; nt < 2; ++nt) {
#pragma unroll
        for (int sub = 0; sub < 4; ++sub) {
#pragma unroll
            for (int r = 0; r < 4; ++r) cq[nt][sub][r] = __builtin_amdgcn_exp2f(cq[nt][sub][r]);
            lsum[nt] += cq[nt][sub]; }
#pragma unroll
        for (int k2 = 0; k2 < 2; ++k2) Pf[nt][k2] = pack8(cq[nt][2 * k2], cq[nt][2 * k2 + 1]);
    }
#pragma unroll
    for (int k2 = 0; k2 < 2; ++k2) {
        const int ra = k2 * 32 + 4 * fq + (fr >> 2), rb = ra + 16;
        const int pa = kv_rowpos(ra, g) * 128, pb = kv_rowpos(rb, g) * 128;
#pragma unroll
        for (int dt = 0; dt < 4; ++dt) { const int c16 = 2 * dt + ((fr & 3) >> 1), sub8 = 8 * (fr & 1);
            const s16x4 va = __builtin_amdgcn_ds_read_tr16_b64_v4i16((LAS s16x4*)(Vb + pa + 16 * (c16 ^ kv_sw(ra)) + sub8));
            const s16x4 vb = __builtin_amdgcn_ds_read_tr16_b64_v4i16((LAS s16x4*)(Vb + pb + 16 * (c16 ^ kv_sw(rb)) + sub8));
            const bf16x8 Av = {va[0], va[1], va[2], va[3], vb[0], vb[1], vb[2], vb[3]};
            ao[0][dt] = __builtin_amdgcn_mfma_f32_16x16x32_bf16(Av, Pf[0][k2], ao[0][dt], 0, 0, 0);
            ao[1][dt] = __builtin_amdgcn_mfma_f32_16x16x32_bf16(Av, Pf[1][k2], ao[1][dt], 0, 0, 0); }
    }
    if (kt + 3 < nt64) asm volatile("s_waitcnt vmcnt(8)" ::: "memory"); else if (kt + 2 < nt64) asm volatile("s_waitcnt vmcnt(4)" ::: "memory"); else asm volatile("s_waitcnt vmcnt(0)" ::: "memory");
    LDS_WAIT(); __builtin_amdgcn_s_barrier(); asm volatile("" ::: "memory");
}

constexpr int Q_P2P_ = MP / 256, Q_PCH_ = NB * 16, Q_P2S_ = 8, Q_PA1_ = 56, Q_SAT_ = DB, Q_SCH_ = DB * 2, Q_PAT_ = NB * (SEQ / 16), Q_SG_ = 2 * (NZ / 256);
constexpr int QB_PCH_ = Q_P2P_, QB_P2S_ = QB_PCH_ + Q_PCH_, QB_PA1_ = QB_P2S_ + Q_P2S_, QB_SAT_ = QB_PA1_ + Q_PA1_, QB_SCH_ = QB_SAT_ + Q_SAT_, QB_PA2_ = QB_SCH_ + Q_SCH_, Q_TOTAL_ = QB_PA2_ + Q_PAT_ - Q_PA1_;
__device__ __forceinline__ int q_pa_index(int it) { return (it >= QB_PA1_ && it < QB_SAT_) ? it - QB_PA1_ : ((it >= QB_PA2_ && it < Q_TOTAL_) ? it - QB_PA2_ + Q_PA1_ : -1); }
constexpr int CW_SDONE = 1600  , CW_PIECEQ = 1664  ;
constexpr int CW_MGP = 2048  , CW_MGS = 3072  ;
constexpr int CW_P1A = 1024, CW_P1B = 1088, CW_P2P = 1152, CW_P2S = 1216, CW_P1X = 1280  ;
constexpr int L_WIS = 157248;
constexpr int QI_PITCH = 1040;
__device__ __forceinline__ void attn_prompt_item(Frame& F, const Args& a, int b, int qb, int rep, int staged, unsigned* qctr) {
    int tidv = FTID(F); asm volatile("" : "+v"(tidv));
    const int tid = tidv, lane = tidv & 63, wave = __builtin_amdgcn_readfirstlane(tidv >> 6), fr = lane & 15, fq = lane >> 4;
    const bf16* Z = (const bf16*)(a.ws + WS_Z); const bf16* KN = (const bf16*)(a.ws + WS_KN);
    bf16* OAB = (bf16*)(a.ws + WS_OAB);
    LAS float* S = (LAS float*)(F.lds + L_S); LAS unsigned* BM = (LAS unsigned*)(F.lds + L_SEL);
    const LAS float* BIAS = (const LAS float*)(F.lds + L_BIAS); const LAS unsigned char* LUT = (const LAS unsigned char*)(F.lds + L_LUT);
    const size_t qrow0 = (size_t)b * SEQ + (size_t)qb * 16, krow0 = (size_t)b * SEQ;
    const int ntiles = qb + 1;
    const int g = wave >> 2, qq = wave & 3, head = g * 8 + (fr & 7);
    const int nt64 = (qb * 16 + 16 + 63) >> 6;
    LAS unsigned char* ST = F.lds + L_S;
    unsigned goff[2];
#pragma unroll
    for (int i = 0; i < 2; ++i) { const int o = 2048 * wave + 1024 * i + 16 * lane, row = o >> 7, key = row >> 1, gg = (row & 1) ^ (((key >> 2) ^ (key >> 3)) & 1), c8 = ((o >> 4) & 7) ^ kv_sw(key);
        goff[i] = (unsigned)(key * 128 + gg * 64 + c8 * 8); }
    const unsigned ldsw = 2048u * (unsigned)wave;
    const bf16* kt0 = KN + krow0 * 128; const bf16* vt0 = (const bf16*)(a.ws + WS_VN) + krow0 * 128;
    v4u qraw[2][2]; v2u gwv[2][4];
    const f32x4 g0 = *(const f32x4*)(a.in[I_QG] + fq * 8), g1 = *(const f32x4*)(a.in[I_QG] + fq * 8 + 4), g2 = *(const f32x4*)(a.in[I_QG] + 32 + fq * 8), g3 = *(const f32x4*)(a.in[I_QG] + 36 + fq * 8);
#pragma unroll
    for (int nt = 0; nt < 2; ++nt) { const bf16* zrow = Z + (qrow0 + 4 * qq + 2 * nt + (fr >> 3)) * NZ;
        qraw[nt][0] = *(const v4u*)(zrow + C_Q + head * 64 + fq * 8); qraw[nt][1] = *(const v4u*)(zrow + C_Q + head * 64 + fq * 8 + 32);
#pragma unroll
        for (int dt = 0; dt < 4; ++dt) gwv[nt][dt] = *(const v2u*)(zrow + C_AG + head * 64 + dt * 16 + 4 * fq); }
    {
        bf16x8 Aq[8][2];
        if (staged) { const LAS unsigned char* zq = F.lds + L_HIST + fr * QI_PITCH + fq * 16;
#pragma unroll
          for (int hh = 0; hh < 8; ++hh) { Aq[hh][0] = *(const LAS bf16x8*)(zq + hh * 128); Aq[hh][1] = *(const LAS bf16x8*)(zq + hh * 128 + 64); } }
        else { const bf16* zq = Z + (qrow0 + fr) * NZ + C_QI + fq * 8;
#pragma unroll
          for (int hh = 0; hh < 8; ++hh) { Aq[hh][0] = *(const bf16x8*)(zq + hh * 64); Aq[hh][1] = *(const bf16x8*)(zq + hh * 64 + 32); } }
        float wi[4][8];
#pragma unroll
        for (int r = 0; r < 4; ++r) { v4u w; if (staged) w = *(const LAS v4u*)(F.lds + L_WIS + (4 * fq + r) * 16); else w = *(const v4u*)(Z + (qrow0 + 4 * fq + r) * NZ + C_WI);
            const float sc = 0.04419417382f;
            wi[r][0] = bf_lo(w.x) * sc; wi[r][1] = bf_hi(w.x) * sc; wi[r][2] = bf_lo(w.y) * sc; wi[r][3] = bf_hi(w.y) * sc;
            wi[r][4] = bf_lo(w.z) * sc; wi[r][5] = bf_hi(w.z) * sc; wi[r][6] = bf_lo(w.w) * sc; wi[r][7] = bf_hi(w.w) * sc; }
        const bf16* kbase = (const bf16*)(a.ws + WS_KIN) + krow0 * 64 + (size_t)fr * 64 + fq * 8;
        bf16x8 Bp[4][2];
#pragma unroll
        for (int i = 0; i < 4; ++i) { const int kt = wave + NWAVES * i; if (kt < ntiles) { Bp[i][0] = *(const bf16x8*)(kbase + (size_t)kt * 1024); Bp[i][1] = *(const bf16x8*)(kbase + (size_t)kt * 1024 + 32); } }
        if (!((PROBE_AT & 1) && rep == 1))
        for (int kt0 = wave; kt0 < ntiles; kt0 += 4 * NWAVES) {
#pragma unroll
            for (int i = 0; i < 4; ++i) { const int kt = kt0 + NWAVES * i;
                if (kt < ntiles) {
                    const bf16x8 Bk0 = Bp[i][0], Bk1 = Bp[i][1];
                    const int kn = kt + 4 * NWAVES; if (kn < ntiles) { Bp[i][0] = *(const bf16x8*)(kbase + (size_t)kn * 1024); Bp[i][1] = *(const bf16x8*)(kbase + (size_t)kn * 1024 + 32); }
                    f32x4 sc = {0.f, 0.f, 0.f, 0.f};
#pragma unroll
                    for (int hh = 0; hh < 8; ++hh) { f32x4 c = {0.f, 0.f, 0.f, 0.f};
                        c = __builtin_amdgcn_mfma_f32_16x16x32_bf16(Aq[hh][0], Bk0, c, 0, 0, 0); c = __builtin_amdgcn_mfma_f32_16x16x32_bf16(Aq[hh][1], Bk1, c, 0, 0, 0);
#pragma unroll
                        for (int r = 0; r < 4; ++r) sc[r] += wi[r][hh] * fmaxf(c[r], 0.f); }
#pragma unroll
                    for (int r = 0; r < 4; ++r) S[(4 * fq + r) * SROW + kt * 16 + fr] = sc[r] + 0.0f;
                } }
        }
    }
    __syncthreads();
    unsigned nxt_draw = 0u;
    {
        if (tid == 0) nxt_draw = __hip_atomic_fetch_add(qctr, 1u, RLX_AGENT);
        LAS unsigned* hist = (LAS unsigned*)(F.lds + L_HIST + wave * 2048);
        const int q0 = 2 * wave, n0 = qb * 16 + q0 + 1, n1 = n0 + 1;
        LAS unsigned* bm0 = BM + q0 * BMP; LAS unsigned* bm1 = bm0 + BMP;
        const bool all = n1 <= TOPK;
        unsigned u0[32], u1[32];
        const int nb = (n1 + 511) >> 9;
#pragma unroll
        for (int i = 0; i < 32; ++i) { u0[i] = 0u; u1[i] = 0u; }
        if (!all) {
#pragma unroll
            for (int blk = 0; blk < 4; ++blk) if (blk < nb) {
                float x0[8], x1[8];
#pragma unroll
                for (int j = 0; j < 8; ++j) { const int idx = lane + 64 * (8 * blk + j); x0[j] = S[q0 * SROW + idx]; x1[j] = S[(q0 + 1) * SROW + idx]; }
                asm volatile("" : "+v"(x0[0]), "+v"(x0[1]), "+v"(x0[2]), "+v"(x0[3]), "+v"(x0[4]), "+v"(x0[5]), "+v"(x0[6]), "+v"(x0[7]), "+v"(x1[0]), "+v"(x1[1]), "+v"(x1[2]), "+v"(x1[3]), "+v"(x1[4]), "+v"(x1[5]), "+v"(x1[6]), "+v"(x1[7]));
#pragma unroll
                for (int j = 0; j < 8; ++j) { const int i = 8 * blk + j, idx = lane + 64 * i; u0[i] = idx < n0 ? sortable(x0[j]) : 0u; u1[i] = idx < n1 ? sortable(x1[j]) : 0u; }
            }
        }
        LDS_WAIT(); __builtin_amdgcn_s_barrier(); asm volatile("" ::: "memory");
#pragma unroll
        for (int t = 0; t < 3; ++t) if (t < nt64) att_dma(ST + t * 32768 + ldsw, kt0 + (size_t)t * 8192, vt0 + (size_t)t * 8192, goff);
        if ((PROBE_AT & 2) && rep == 1) {} else
        if (all) {
#pragma unroll
            for (int i = 0; i < 4; ++i) { const unsigned long long m0 = __ballot(lane + 64 * i < n0), m1 = __ballot(lane + 64 * i < n1);
                if (lane == 0) { bm0[2 * i] = (unsigned)m0; bm0[2 * i + 1] = (unsigned)(m0 >> 32); bm1[2 * i] = (unsigned)m1; bm1[2 * i + 1] = (unsigned)(m1 >> 32); } }
            if (lane < 56) { bm0[8 + lane] = 0u; bm1[8 + lane] = 0u; }
        } else {
            unsigned pf0 = 0u, pf1 = 0u; int need0 = TOPK, need1 = TOPK, cb0 = 0, cb1 = 0;
            {
                unsigned d0 = 0u, d1 = 0u;
#pragma unroll 1
                for (int bit = 7; bit >= 0; --bit) {
                    const unsigned c0 = (d0 | (1u << bit)) << 24, c1 = (d1 | (1u << bit)) << 24; int k0 = 0, k1 = 0;
#pragma unroll
                    for (int i = 0; i < 32; ++i) if ((i >> 3) < nb) { k0 += __popcll(__ballot(u0[i] >= c0)); k1 += __popcll(__ballot(u1[i] >= c1)); }
                    if (k0 >= TOPK) d0 |= 1u << bit; if (k1 >= TOPK) d1 |= 1u << bit;
                }
                int a0 = 0, a1 = 0; const unsigned e0 = (d0 + 1u) << 24, e1 = (d1 + 1u) << 24;
#pragma unroll
                for (int i = 0; i < 32; ++i) if ((i >> 3) < nb) { a0 += __popcll(__ballot(u0[i] >= e0)); a1 += __popcll(__ballot(u1[i] >= e1)); }
                need0 -= a0; need1 -= a1; pf0 = d0; pf1 = d1;
            }
#pragma unroll 1
            for (int p = 1; p < 4; ++p) {
                const int sh = 24 - 8 * p;
                *(LAS v4u*)(hist + 4 * lane) = (v4u){0u, 0u, 0u, 0u}; *(LAS v4u*)(hist + 256 + 4 * lane) = (v4u){0u, 0u, 0u, 0u};
#pragma unroll
                for (int i = 0; i < 32; ++i) if ((i >> 3) < nb) {
                    const bool m0 = (u0[i] >> (sh + 8)) == pf0, m1 = (u1[i] >> (sh + 8)) == pf1;
                    if (m0) (void)__hip_atomic_fetch_add(hist + ((u0[i] >> sh) & 255u), 1u, __ATOMIC_RELAXED, __HIP_MEMORY_SCOPE_WORKGROUP);
                    if (m1) (void)__hip_atomic_fetch_add(hist + 256 + ((u1[i] >> sh) & 255u), 1u, __ATOMIC_RELAXED, __HIP_MEMORY_SCOPE_WORKGROUP); }
                const v4u c0 = *(const LAS v4u*)(hist + 4 * lane), c1 = *(const LAS v4u*)(hist + 256 + 4 * lane);
                const int ls0 = (int)(c0.x + c0.y + c0.z + c0.w), ls1 = (int)(c1.x + c1.y + c1.z + c1.w);
                int pr0 = ls0, pr1 = ls1;
#define SCAN_STEP(ctrl, rmask) { pr0 += __builtin_amdgcn_update_dpp(0, pr0, ctrl, rmask, 0xF, false); pr1 += __builtin_amdgcn_update_dpp(0, pr1, ctrl, rmask, 0xF, false); }
                SCAN_STEP(0x111, 0xF) SCAN_STEP(0x112, 0xF) SCAN_STEP(0x114, 0xF) SCAN_STEP(0x118, 0xF) SCAN_STEP(0x142, 0xA) SCAN_STEP(0x143, 0xC)
#undef SCAN_STEP
                const int tot0 = __builtin_amdgcn_readlane(pr0, 63), tot1 = __builtin_amdgcn_readlane(pr1, 63);
                const int exc0 = tot0 - pr0, exc1 = tot1 - pr1, inc0 = exc0 + ls0, inc1 = exc1 + ls1;
                const int hl0 = __builtin_ctzll(__ballot(exc0 < need0 && inc0 >= need0)), hl1 = __builtin_ctzll(__ballot(exc1 < need1 && inc1 >= need1));
                int d0, ab0, d1, ab1;
                { int cum = exc0; if (cum + (int)c0.w >= need0) { d0 = 3; ab0 = cum; } else { cum += (int)c0.w; if (cum + (int)c0.z >= need0) { d0 = 2; ab0 = cum; } else { cum += (int)c0.z; if (cum + (int)c0.y >= need0) { d0 = 1; ab0 = cum; } else { cum += (int)c0.y; d0 = 0; ab0 = cum; } } } }
                { int cum = exc1; if (cum + (int)c1.w >= need1) { d1 = 3; ab1 = cum; } else { cum += (int)c1.w; if (cum + (int)c1.z >= need1) { d1 = 2; ab1 = cum; } else { cum += (int)c1.z; if (cum + (int)c1.y >= need1) { d1 = 1; ab1 = cum; } else { cum += (int)c1.y; d1 = 0; ab1 = cum; } } } }
                { const int k0 = d0 == 3 ? (int)c0.w : d0 == 2 ? (int)c0.z : d0 == 1 ? (int)c0.y : (int)c0.x, k1 = d1 == 3 ? (int)c1.w : d1 == 2 ? (int)c1.z : d1 == 1 ? (int)c1.y : (int)c1.x;
                  cb0 = __builtin_amdgcn_readlane(k0, hl0); cb1 = __builtin_amdgcn_readlane(k1, hl1); }
                d0 = __builtin_amdgcn_readlane(d0 + 4 * lane, hl0); ab0 = __builtin_amdgcn_readlane(ab0, hl0); d1 = __builtin_amdgcn_readlane(d1 + 4 * lane, hl1); ab1 = __builtin_amdgcn_readlane(ab1, hl1);
                need0 -= ab0; pf0 = (pf0 << 8) | (unsigned)d0; need1 -= ab1; pf1 = (pf1 << 8) | (unsigned)d1;
                if (p < 3 && need0 == cb0 && need1 == cb1) { pf0 <<= sh; pf1 <<= sh; break; }
            }
            unsigned w0 = 0u, w1 = 0u;
            if (need0 == cb0 && need1 == cb1) {
#pragma unroll
                for (int i = 0; i < 32; ++i) if ((i >> 3) < nb) { const unsigned long long mt0 = __ballot(u0[i] >= pf0), mt1 = __ballot(u1[i] >= pf1);
                    w0 = lane == 2 * i ? (unsigned)mt0 : (lane == 2 * i + 1 ? (unsigned)(mt0 >> 32) : w0); w1 = lane == 2 * i ? (unsigned)mt1 : (lane == 2 * i + 1 ? (unsigned)(mt1 >> 32) : w1); }
            } else {
                int tb0 = 0, tb1 = 0;
#pragma unroll
                for (int i = 0; i < 32; ++i) if ((i >> 3) < nb) {
                    const bool e0 = u0[i] == pf0, e1 = u1[i] == pf1;
                    const unsigned long long me0 = __ballot(e0), me1 = __ballot(e1);
                    const int r0 = tb0 + (int)__builtin_amdgcn_mbcnt_hi((unsigned)(me0 >> 32), __builtin_amdgcn_mbcnt_lo((unsigned)me0, 0u)), r1 = tb1 + (int)__builtin_amdgcn_mbcnt_hi((unsigned)(me1 >> 32), __builtin_amdgcn_mbcnt_lo((unsigned)me1, 0u));
                    const unsigned long long mt0 = __ballot(u0[i] > pf0 || (e0 && r0 < need0)), mt1 = __ballot(u1[i] > pf1 || (e1 && r1 < need1));
                    w0 = lane == 2 * i ? (unsigned)mt0 : (lane == 2 * i + 1 ? (unsigned)(mt0 >> 32) : w0); w1 = lane == 2 * i ? (unsigned)mt1 : (lane == 2 * i + 1 ? (unsigned)(mt1 >> 32) : w1);
                    tb0 += __popcll(me0); tb1 += __popcll(me1);
                }
            }
            bm0[lane] = w0; bm1[lane] = w1;
        }
    }
    __syncthreads();
    {
        bf16x8 Bq[2][2];
        {
#pragma unroll
          for (int nt = 0; nt < 2; ++nt) { const v4u w0 = qraw[nt][0], w1 = qraw[nt][1];
            float x[16] = {bf_lo(w0.x), bf_hi(w0.x), bf_lo(w0.y), bf_hi(w0.y), bf_lo(w0.z), bf_hi(w0.z), bf_lo(w0.w), bf_hi(w0.w),
                           bf_lo(w1.x), bf_hi(w1.x), bf_lo(w1.y), bf_hi(w1.y), bf_lo(w1.z), bf_hi(w1.z), bf_lo(w1.w), bf_hi(w1.w)};
            float ss = 0.f;
#pragma unroll
            for (int j = 0; j < 16; ++j) ss += x[j] * x[j];
            ss += __shfl_xor(ss, 16); ss += __shfl_xor(ss, 32);
            const float rs = (0.125f * 1.44269504089f) / sqrtf(ss * (1.f / 64.f) + NORM_EPS);
            Bq[nt][0] = pack8((f32x4){x[0] * rs * g0[0], x[1] * rs * g0[1], x[2] * rs * g0[2], x[3] * rs * g0[3]}, (f32x4){x[4] * rs * g1[0], x[5] * rs * g1[1], x[6] * rs * g1[2], x[7] * rs * g1[3]});
            Bq[nt][1] = pack8((f32x4){x[8] * rs * g2[0], x[9] * rs * g2[1], x[10] * rs * g2[2], x[11] * rs * g2[3]}, (f32x4){x[12] * rs * g3[0], x[13] * rs * g3[1], x[14] * rs * g3[2], x[15] * rs * g3[3]}); } }
        bf16x8 Bmk[2];
#pragma unroll
        for (int nt = 0; nt < 2; ++nt) { const int jq = 4 * qq + 2 * nt + (fr >> 3) - 8 * fq; v4u w;
            w.x = (jq == 0 ? 0x3F80u : 0u) | (jq == 1 ? 0x3F800000u : 0u); w.y = (jq == 2 ? 0x3F80u : 0u) | (jq == 3 ? 0x3F800000u : 0u);
            w.z = (jq == 4 ? 0x3F80u : 0u) | (jq == 5 ? 0x3F800000u : 0u); w.w = (jq == 6 ? 0x3F80u : 0u) | (jq == 7 ? 0x3F800000u : 0u);
            Bmk[nt] = __builtin_bit_cast(bf16x8, w); }
        att_mask_tile(BM, 0, wave, lane);
        const float m0h = ((const LAS float*)(F.lds + L_M0))[head];
        const float bias_far = BIAS[31 * 16 + head] - m0h;
        f32x4 ao[2][4];
#pragma unroll
        for (int nt = 0; nt < 2; ++nt)
#pragma unroll
            for (int dt = 0; dt < 4; ++dt) ao[nt][dt] = (f32x4){0.f, 0.f, 0.f, 0.f};
        f32x4 lsum[2] = {(f32x4){0.f, 0.f, 0.f, 0.f}, (f32x4){0.f, 0.f, 0.f, 0.f}};
        if (tid == 0) F.MISC[1] = nxt_draw;
        if (nt64 > 2) asm volatile("s_waitcnt vmcnt(8)" ::: "memory"); else if (nt64 > 1) asm volatile("s_waitcnt vmcnt(4)" ::: "memory"); else asm volatile("s_waitcnt vmcnt(0)" ::: "memory");
        LDS_WAIT(); __builtin_amdgcn_s_barrier(); asm volatile("" ::: "memory");
        {
            const int nx = q_pa_index((int)F.MISC[1]);
            if (nx >= 0) { const size_t nrow = (size_t)(nx & 7) * SEQ + (size_t)((SEQ / 16 - 1) - (nx >> 3)) * 16 + 2 * wave;
#pragma unroll
                for (int i = 0; i < 2; ++i) glds16_asm(Z + (nrow + i) * NZ + C_QI + lane * 8, (unsigned)__builtin_amdgcn_readfirstlane((int)(unsigned)(size_t)(F.lds + L_HIST + (2 * wave + i) * QI_PITCH)));
                if (wave == 0 && lane < 16) glds16_asm(Z + (nrow + lane) * NZ + C_WI, (unsigned)__builtin_amdgcn_readfirstlane((int)(unsigned)(size_t)(F.lds + L_WIS))); }
        }
        int nfar = (qb * 16 - 113 - 63 + 64) >> 6; nfar = nfar < 0 ? 0 : (nfar > nt64 ? nt64 : nfar);
        if (!((PROBE_AT & 4) && rep == 1)) {
#pragma unroll 1
        for (int kt = 0; kt < nfar; ++kt) att_tile<true>(kt, nt64, qb, g, qq, fr, fq, head, bias_far, m0h, ST, BM, BIAS, LUT, kt0, vt0, goff, ldsw, Bq, Bmk, ao, lsum);
#pragma unroll 1
        for (int kt = nfar; kt < nt64; ++kt) att_tile<false>(kt, nt64, qb, g, qq, fr, fq, head, bias_far, m0h, ST, BM, BIAS, LUT, kt0, vt0, goff, ldsw, Bq, Bmk, ao, lsum);
        } else { asm volatile("s_waitcnt vmcnt(0)" ::: "memory"); __syncthreads(); }
#pragma unroll
        for (int nt = 0; nt < 2; ++nt) {
            float l = (lsum[nt][0] + lsum[nt][1]) + (lsum[nt][2] + lsum[nt][3]); l += __shfl_xor(l, 16); l += __shfl_xor(l, 32);
            const float inv = 1.0f / l;
            const size_t qrow = qrow0 + 4 * qq + 2 * nt + (fr >> 3);
#pragma unroll
            for (int dt = 0; dt < 4; ++dt) { const int col = head * 64 + dt * 16 + 4 * fq;
                const v2u gw = gwv[nt][dt];
                const float g0 = bf_lo(gw.x), g1 = bf_hi(gw.x), g2 = bf_lo(gw.y), g3 = bf_hi(gw.y);
                v2u o; o.x = pk2(ao[nt][dt][0] * inv * g0 * sigmoidf_(g0), ao[nt][dt][1] * inv * g1 * sigmoidf_(g1)); o.y = pk2(ao[nt][dt][2] * inv * g2 * sigmoidf_(g2), ao[nt][dt][3] * inv * g3 * sigmoidf_(g3));
                if (!(PROBE_AT && rep == 1)) *(v2u*)(OAB + qrow * (2 * D) + D + col) = o; }
        }
    }
}

template <bool FENCE>
__device__ __forceinline__ void dep_signal(Frame& F, unsigned* ctr) {
    asm volatile("s_waitcnt vmcnt(0)" ::: "memory");
    __syncthreads();
    if (FTID(F) == 0) { if (FENCE) { __builtin_amdgcn_fence(__ATOMIC_RELEASE, "agent"); asm volatile("s_waitcnt vmcnt(0)" ::: "memory"); } (void)xb_add(ctr, 1u); }
}
__device__ __forceinline__ void dep_arrive_xcd(Frame& F, unsigned* xcnt, unsigned* ctr, unsigned x) {
    asm volatile("s_waitcnt vmcnt(0)" ::: "memory");
    __syncthreads();
    if (FTID(F) == 0) { const unsigned nloc = F.MISC[8];
        if (nloc == 0u) { __builtin_amdgcn_fence(__ATOMIC_RELEASE, "agent"); asm volatile("s_waitcnt vmcnt(0)" ::: "memory"); (void)xb_add(ctr, 1u); }
        else if (xb_add(&xcnt[16 * x], 1u) + 1u == nloc) { __builtin_amdgcn_fence(__ATOMIC_RELEASE, "agent"); asm volatile("s_waitcnt vmcnt(0)" ::: "memory"); (void)xb_add(ctr, nloc); } }
}
template <bool ACQ>
__device__ __forceinline__ void dep_wait(Frame& F, unsigned* ctr, unsigned target) {
    if (FTID(F) == 0) { unsigned sp = 0u; while (xb_ld(ctr) < target) { __builtin_amdgcn_s_sleep(2); if (++sp > (1u << 24)) break; }
        if (ACQ) __builtin_amdgcn_fence(__ATOMIC_ACQUIRE, "agent"); }
    __syncthreads();
    asm volatile("" ::: "memory");
}
template <bool MERGE> __device__ __forceinline__ void sample_rows_piece(Frame& F, const Args& a, int p);
__device__ __forceinline__ void p3_queue(Frame& F, const Args& a, int rep) {
    { const int tid0 = FTID(F);
    { LAS float* BIAS = (LAS float*)(F.lds + L_BIAS); LAS unsigned char* LUT = (LAS unsigned char*)(F.lds + L_LUT);
      for (int i = tid0; i < 512; i += NWAVES * 64) BIAS[i] = a.in[I_RB][i] * 1.44269504089f;
      for (int d = tid0; d < 2112; d += NWAVES * 64) {
          int b = d;
          if (d >= 16) b = d < 19 ? 16 : d < 21 ? 17 : d < 24 ? 18 : d < 27 ? 19 : d < 31 ? 20 : d < 35 ? 21 : d < 40 ? 22 : d < 46 ? 23 : d < 52 ? 24 : d < 59 ? 25 : d < 67 ? 26 : d < 77 ? 27 : d < 87 ? 28 : d < 99 ? 29 : d < 113 ? 30 : 31;
          LUT[d] = (unsigned char)b; } }
    __syncthreads();
    if (tid0 < 16) {
        float gq = 0.f, gk = 0.f, mb = -INFINITY;
        for (int i = 0; i < 64; ++i) { gq = fmaxf(gq, fabsf(a.in[I_QG][i])); gk = fmaxf(gk, fabsf(a.in[I_KG][i])); }
        for (int b = 0; b < 32; ++b) mb = fmaxf(mb, ((const LAS float*)(F.lds + L_BIAS))[b * 16 + tid0]);
        ((LAS float*)(F.lds + L_M0))[tid0] = 8.f * 1.44269504089f * 1.02f * gq * gk + mb;
    }
    }
    unsigned* qctr = (unsigned*)(F.ctl + CW_QUEUE + 64 * rep);
    unsigned* p1b = (unsigned*)(F.ctl + CW_P1B); unsigned* p2p = (unsigned*)(F.ctl + CW_P2P); unsigned* p2s = (unsigned*)(F.ctl + CW_P2S);
    unsigned* sdone = (unsigned*)(F.ctl + CW_SDONE);
    int okp = 0, oks = 0;
    int pf = -1, staged = 0;
    for (;;) {
        __syncthreads();
        int it;
        if (pf >= 0) it = pf;
        else { if (FTID(F) == 0) F.MISC[0] = __hip_atomic_fetch_add(qctr, 1u, RLX_AGENT);
            __syncthreads();
            it = (int)F.MISC[0]; }
        const int st = staged; pf = -1; staged = 0;
        if (it >= Q_TOTAL_) break;
        const int sub = rep == 0 ? 15 : PROBE_SUB;
        if (it < QB_PCH_) {
            if (rep == 0) { p2_rows(a, it * 256, it * 256 + 256, (it & 7) == 7 ? (it >> 3) : 0, (it & 7) == 7 ? (it >> 3) + 1 : 0, F.wave, NWAVES, FLANE()); dep_signal<false>(F, p2p); } }
        else if (it < QB_P2S_) { if (sub & 1) chain_item(F, a, (it - QB_PCH_) >> 4, (it - QB_PCH_) & 15, rep); }
        else if (it < QB_PA1_) {
            if (rep == 0) { const int j = it - QB_P2S_;
                dep_wait<false>(F, p1b, Q_SG_);
                p2_rows(a, MP + 64 * j, MP + 64 * j + 64, NB + 16 * j, NB + 16 * j + 16, F.wave, NWAVES, FLANE());
                dep_signal<false>(F, p2s); } }
        else if (it >= QB_SAT_ && it < QB_SCH_) { if (sub & 2) { if (!oks) { dep_wait<false>(F, p2s, Q_P2S_); oks = 1; } attn_item<true>(F, a, it - QB_SAT_, 0, rep); if (rep == 0) dep_signal<false>(F, sdone); } }
        else if (it >= QB_SCH_ && it < QB_PA2_) { const int k = it - QB_SCH_; if (sub & 8) { if (!oks) { dep_wait<false>(F, p2s, Q_P2S_); oks = 1; } sample_chain_item(F, a, k >> 1, k & 1); if (rep == 0) dep_signal<false>(F, sdone); } }
        else { const int k = q_pa_index(it);
            if (sub & 4) { if (!okp) { dep_wait<false>(F, p2p, Q_P2P_); okp = 1; }
                attn_prompt_item(F, a, k & 7, (SEQ / 16 - 1) - (k >> 3), rep, st, qctr);
                pf = (int)F.MISC[1]; staged = q_pa_index(pf) >= 0 ? 1 : 0; } }
    }
    if (rep == 0) {
        unsigned* pq = (unsigned*)(F.ctl + CW_PIECEQ); int first = 1;
        for (;;) {
            __syncthreads();
            if (FTID(F) == 0) F.MISC[0] = __hip_atomic_fetch_add(pq, 1u, RLX_AGENT);
            __syncthreads();
            const int p = __builtin_amdgcn_readfirstlane((int)F.MISC[0]);
            if (p >= 256) break;
            if (first) { dep_wait<false>(F, sdone, (unsigned)(Q_SAT_ + Q_SCH_)); first = 0; }
            sample_rows_piece<true>(F, a, p);
            dep_signal<false>(F, (unsigned*)(F.ctl + CW_MGS + 16 * (p >> 4)));
        }
    }
}

template <bool MERGE>
__device__ __forceinline__ void sample_rows_piece(Frame& F, const Args& a, int p) {
    const int lane = FLANE(), wave = F.wave, fr = lane & 15, fq = lane >> 4, tid = wave * 64 + lane;
    const int rt = p >> 4, ct = p & 15, r0 = MP + rt * 32, c0 = ct * 64;
    constexpr int LDA = MERGE ? 2 * D : D, KW = MERGE ? 256 : 128, NKS = KW / 32;
    const bf16* A = (const bf16*)(a.ws + (MERGE ? WS_OAB : WS_MG)) + (size_t)(r0 + fr) * LDA + wave * KW + fq * 8;
    const bf16* B = (const bf16*)(a.ws + (MERGE ? WS_WPAB : WS_WOUT)) + (size_t)(c0 + fr) * LDA + wave * KW + fq * 8;
    bf16x8 Af[2][NKS], Bf[4][NKS];
#pragma unroll
    for (int ks = 0; ks < NKS; ++ks) {
#pragma unroll
        for (int m = 0; m < 2; ++m) Af[m][ks] = *(const bf16x8*)(A + (size_t)m * 16 * LDA + ks * 32);
#pragma unroll
        for (int n = 0; n < 4; ++n) Bf[n][ks] = *(const bf16x8*)(B + (size_t)n * 16 * LDA + ks * 32); }
    f32x4 acc[2][4];
#pragma unroll
    for (int m = 0; m < 2; ++m)
#pragma unroll
        for (int n = 0; n < 4; ++n) acc[m][n] = (f32x4){0.f, 0.f, 0.f, 0.f};
#pragma unroll
    for (int ks = 0; ks < NKS; ++ks)
#pragma unroll
        for (int m = 0; m < 2; ++m)
#pragma unroll
            for (int n = 0; n < 4; ++n) acc[m][n] = __builtin_amdgcn_mfma_f32_16x16x32_bf16(Af[m][ks], Bf[n][ks], acc[m][n], 0, 0, 0);
    LAS float* P = (LAS float*)(F.lds + RING_OFF);
#pragma unroll
    for (int m = 0; m < 2; ++m)
#pragma unroll
        for (int n = 0; n < 4; ++n)
#pragma unroll
            for (int r = 0; r < 4; ++r) P[wave * 2048 + (m * 16 + 4 * fq + r) * 64 + n * 16 + fr] = acc[m][n][r];
    __syncthreads();
    const int row = tid >> 4, c4 = (tid & 15) * 4;
    f32x4 s0 = {0.f, 0.f, 0.f, 0.f}, s1 = {0.f, 0.f, 0.f, 0.f};
#pragma unroll
    for (int w = 0; w < 4; ++w) { s0 += *(const LAS f32x4*)(P + w * 2048 + row * 64 + c4); s1 += *(const LAS f32x4*)(P + (4 + w) * 2048 + row * 64 + c4); }
    if (MERGE) {
        const bf16* zr = (const bf16*)(a.ws + WS_Z) + (size_t)(r0 + row) * NZ + c0 + c4;
        const f32x4 ga = up4(*(const v2u*)(zr + C_GA)), gb = up4(*(const v2u*)(zr + C_GB));
        ST_AGENT64((bf16*)(a.ws + WS_MG) + (size_t)(r0 + row) * D + c0 + c4, dn4(s0 * ga + s1 * gb));
    } else {
        const f32x4 xv = *(const f32x4*)(a.in[I_XS] + (size_t)(r0 - MP + row) * D + c0 + c4);
        *(f32x4*)(a.out + O_Y + (size_t)(r0 + row) * D + c0 + c4) = xv + s0 + s1;
    }
    __syncthreads();
}

__global__ void __launch_bounds__(NWAVES * 64, 2) hybrid_fwd(Args args) {
    extern __shared__ __attribute__((aligned(16))) unsigned char lds[];
    Frame F;
    F.lds = (LAS unsigned char*)lds;
    F.MISC = (volatile LAS unsigned*)(F.lds + L_MISC);
    F.wave = __builtin_amdgcn_readfirstlane((int)threadIdx.x >> 6);
    F.G = gridDim.x; { const int bx = blockIdx.x; F.vcu = (F.G % 8 == 0) ? (bx % 8) * (F.G / 8) + bx / 8 : bx; }
    unsigned char* ws = args.ws;
    F.ctl = (gu32*)(ws + WS_CTL);
    { const int t0 = FTID(F); if (t0 < 32) F.MISC[t0] = 0u; }
    __syncthreads();
    XcdBarrier bar; bar.bar = (unsigned*)(F.ctl + CW_BAR) + args.li * XCD_BAR_WORDS; bar.x = 0; bar.st = nullptr; bar.wave = F.wave;
    if (MK_N_LAUNCHES == 1) bar = xcd_barrier_post((unsigned*)(F.ctl + CW_BAR) + args.li * XCD_BAR_WORDS, F.MISC + 8, F.wave);
    const int lo = args.ph_lo, hi = args.ph_hi;
#define IN(k) (lo <= (k) && (k) < hi)
#define BOTH(k) (IN(k) && IN((k) + 1))
#define GRID_BAR() xcd_barrier<true, false>(bar)

    for (int rep = 0; rep < REPS(0); ++rep)
    if (IN(0)) { p0_prologue(F, args); if (BOTH(0)) GRID_BAR(); }
    for (int rep = 0; rep < REPS(1); ++rep)
    if (IN(1)) {
        pg8::Gemm g{(const bf16*)(ws + WS_XN), (const bf16*)(ws + WS_WIN), M, NZ, D, D, D, nullptr, nullptr}; pg8::StaticOrder S; S.init(MP, NZ, F.G, (int)blockIdx.x);
        EpiZ E{(bf16*)(ws + WS_Z)};
        pg8::gemm_phase<EpiZ, pg8::StaticOrder>(F.lds + RING_OFF, g, S, E, F.wave);
        dep_arrive_xcd(F, (unsigned*)(F.ctl + CW_P1X), (unsigned*)(F.ctl + CW_P1A), bar.x);
        for (int j = (int)blockIdx.x; j < Q_SG_; j += F.G) {
            pg8::OneUnit S1{MP / 256 + j / (NZ / 256), j % (NZ / 256)}; EpiZT<true> E1{(bf16*)(ws + WS_Z)};
            pg8::gemm_phase<EpiZT<true>, pg8::OneUnit>(F.lds + RING_OFF, g, S1, E1, F.wave);
            dep_signal<false>(F, (unsigned*)(F.ctl + CW_P1B));
        }
    }
    for (int rep = 0; rep < REPS(3); ++rep)
    if (IN(3)) { if (rep == 0) dep_wait<false>(F, (unsigned*)(F.ctl + CW_P1A), (unsigned)F.G); p3_queue(F, args, rep); if (BOTH(3)) GRID_BAR(); }
    for (int rep = 0; rep < REPS(4); ++rep)
    if (IN(4)) {
        pg8::Gemm g{(const bf16*)(ws + WS_OAB), (const bf16*)(ws + WS_WPAB), MP, D, D, 2 * D, 2 * D, (const bf16*)(ws + WS_OAB) + D, (const bf16*)(ws + WS_WPAB) + D}; pg8::TwoHalfOrder S; S.init(MP, D, F.G, (int)blockIdx.x);
        EpiMerge E{(const bf16*)(ws + WS_Z), (bf16*)(ws + WS_MG)};
        pg8::gemm_phase<EpiMerge, pg8::TwoHalfOrder>(F.lds + RING_OFF, g, S, E, F.wave);
        {
            asm volatile("s_waitcnt vmcnt(0)" ::: "memory"); __syncthreads();
            if (FTID(F) == 0) { pg8::Unit u; for (int i = 0; S.next(2 * i, u); ++i) (void)xb_add((unsigned*)(F.ctl + CW_MGP) + 16 * u.pm, 1u); } }
        if (rep + 1 < REPS(4)) GRID_BAR();
    }
    for (int rep = 0; rep < REPS(6); ++rep)
    if (IN(6)) {
        pg8::Gemm g{(const bf16*)(ws + WS_MG), (const bf16*)(ws + WS_WOUT), MP, D, D, D, D, nullptr, nullptr}; pg8::WaitStatic S; S.init(MP, D, F.G, (int)blockIdx.x);
        S.ctr = (unsigned*)(F.ctl + CW_MGP); S.wave = F.wave; S.target = (unsigned)(D / 256) * (unsigned)REPS(4);
        EpiOut E{args.in[I_XP], args.in[I_XS], args.out + O_Y};
        pg8::gemm_phase<EpiOut, pg8::WaitStatic>(F.lds + RING_OFF, g, S, E, F.wave);
        for (int p = blockIdx.x; p < 256; p += F.G) { dep_wait<false>(F, (unsigned*)(F.ctl + CW_MGS + 16 * (p >> 4)), 16u * (unsigned)REPS(4)); sample_rows_piece<false>(F, args, p); }
        if (rep + 1 < REPS(6)) GRID_BAR();
    }
#undef IN
#undef BOTH
}

extern "C" void kernel_launch(void* const* d_in, const int* in_sizes, int n_in, void* d_out, int out_size, void* d_ws, size_t ws_size, hipStream_t stream) {
    static int grid = 0;
    if (grid == 0) {
        if (n_in != 26 || in_sizes[0] != MP * D || (size_t)out_size != O_END || ws_size < WS_END) {
            fprintf(stderr, "kernel_launch: unexpected shapes: n_in %d in0 %d out %d ws %zu (need %zu)\n", n_in, n_in > 0 ? in_sizes[0] : -1, out_size, ws_size, (size_t)WS_END); grid = -1; return; }
        int dev = 0, cus = 0, per_cu = 0;
        if (hipGetDevice(&dev) != hipSuccess || hipDeviceGetAttribute(&cus, hipDeviceAttributeMultiprocessorCount, dev) != hipSuccess) { grid = -1; return; }
        if (hipFuncSetAttribute((const void*)hybrid_fwd, hipFuncAttributeMaxDynamicSharedMemorySize, LDS_BYTES) != hipSuccess) { fprintf(stderr, "kernel_launch: hipFuncSetAttribute failed\n"); grid = -1; return; }
        if (hipOccupancyMaxActiveBlocksPerMultiprocessor(&per_cu, (const void*)hybrid_fwd, NWAVES * 64, LDS_BYTES) != hipSuccess || per_cu < 1) { fprintf(stderr, "kernel_launch: occupancy query says %d blocks per CU\n", per_cu); (void)hipGetLastError(); grid = -1; return; }
        grid = cus;
    }
    if (grid < 0) return;
    (void)hipMemsetAsync((char*)d_ws + WS_CTL, 0, CTL_ZERO_BYTES, stream);
    Args a{};
    for (int i = 0; i < 26; ++i) a.in[i] = (const float*)d_in[i];
    a.out = (float*)d_out; a.ws = (unsigned char*)d_ws;
    constexpr int NPH = 7;
#if MK_N_LAUNCHES == 1
#if defined(PROBE_PRELAUNCH_LO)
    a.ph_lo = PROBE_PRELAUNCH_LO; a.ph_hi = PROBE_PRELAUNCH_HI; a.li = 1;
    hipLaunchKernelGGL(hybrid_fwd, dim3(grid), dim3(NWAVES * 64), LDS_BYTES, stream, a);
#endif
    a.ph_lo = 0; a.ph_hi = NPH; a.li = 0;
    hipLaunchKernelGGL(hybrid_fwd, dim3(grid), dim3(NWAVES * 64), LDS_BYTES, stream, a);
#else
    for (int li = 0; li < NPH; ++li) { a.ph_lo = li; a.ph_hi = li + 1; a.li = 0; hipLaunchKernelGGL(hybrid_fwd, dim3(grid), dim3(NWAVES * 64), LDS_BYTES, stream, a); }
#endif
}
```
